# Optimizing an MI355X kernel written in HIP

```python
import jax, jax.numpy as jnp
from jax import lax
import numpy as np

D_MODEL = 1024
BATCH = 4
SEQ = 4096
DEPTH = 2

MLA_HEADS = 8
MLA_NOPE = 64
MLA_ROPE = 32
MLA_QK = MLA_NOPE + MLA_ROPE
MLA_V = 64
MLA_Q_RANK = 256
MLA_KV_RANK = 128
ROPE_BASE = 10000.0
ATTN_BLOCK = 128
SG_WIDTH = 512
SG_GROUPS = 8
SG_CHUNK = 128
RW_HEADS = 8
RW_HEAD = 64
RW_WIDTH = RW_HEADS * RW_HEAD
RW_DECAY_RANK = 64
RW_A_RANK = 64
RW_MV_RANK = 32
RW_GATE_RANK = 128
RW_GN_EPS = 64e-5
D_FF = 2816
N_BRANCH = 3
EPS = 1e-6

MLA_COLS = MLA_Q_RANK + MLA_KV_RANK + MLA_ROPE
SG_COLS = 2 * SG_WIDTH
RW_COLS = 3 * RW_WIDTH + RW_DECAY_RANK + RW_A_RANK + RW_GATE_RANK
GATE_COLS = N_BRANCH * D_MODEL
IN_COLS = MLA_COLS + SG_COLS + RW_COLS + GATE_COLS

kernel_name = "hybrid_mla_sgu_rwkv7_block"


def rms_norm(x, g, eps=EPS):
    xf = x.astype(jnp.float32)
    y = xf * lax.rsqrt(jnp.mean(xf * xf, axis=-1, keepdims=True) + eps)
    return (y * g.astype(jnp.float32)).astype(x.dtype)


def swiglu(x, w_gate, w_up, w_down):
    return (jax.nn.silu(x @ w_gate) * (x @ w_up)) @ w_down


def split_cols(p, sizes):
    out, off = [], 0
    for s in sizes:
        out.append(p[..., off:off + s])
        off += s
    return out


def rope_tables(positions):
    inv_freq = ROPE_BASE ** (-jnp.arange(0, MLA_ROPE, 2, dtype=jnp.float32) / MLA_ROPE)
    ang = positions.astype(jnp.float32)[..., None] * inv_freq
    return jnp.cos(ang)[:, :, None, :], jnp.sin(ang)[:, :, None, :]


def apply_rope(x, cos, sin):
    half = x.shape[-1] // 2
    x1, x2 = x[..., :half], x[..., half:]
    c, s = cos.astype(x.dtype), sin.astype(x.dtype)
    return jnp.concatenate([x1 * c - x2 * s, x2 * c + x1 * s], axis=-1)


def causal_block_attention(q, k, v):
    B, S, H, Dq = q.shape
    nb = S // ATTN_BLOCK
    scale = Dq ** -0.5
    qb = q.reshape(B, nb, ATTN_BLOCK, H, Dq).transpose(1, 0, 2, 3, 4)
    kpos = jnp.arange(S)

    def one_block(args):
        q_i, b_i = args
        qpos = b_i * ATTN_BLOCK + jnp.arange(ATTN_BLOCK)
        s = jnp.einsum('bqhd,bkhd->bhqk', q_i, k).astype(jnp.float32) * scale
        s = jnp.where(kpos[None, :] <= qpos[:, None], s, -jnp.inf)
        pr = jax.nn.softmax(s, axis=-1).astype(v.dtype)
        return jnp.einsum('bhqk,bkhd->bqhd', pr, v)

    out = lax.map(one_block, (qb, jnp.arange(nb)))
    return out.transpose(1, 0, 2, 3, 4).reshape(B, S, H, v.shape[-1])


def mla_branch(c_q, c_kv, k_pe, cos, sin, q_a_norm, w_uq, kv_a_norm, w_ukv, q_norm, k_norm):
    B, S, _ = c_q.shape
    q = (rms_norm(c_q, q_a_norm) @ w_uq).reshape(B, S, MLA_HEADS, MLA_QK)
    kv = (rms_norm(c_kv, kv_a_norm) @ w_ukv).reshape(B, S, MLA_HEADS, MLA_NOPE + MLA_V)
    k_nope, v = kv[..., :MLA_NOPE], kv[..., MLA_NOPE:]
    k_rope = jnp.broadcast_to(k_pe[:, :, None, :], (B, S, MLA_HEADS, MLA_ROPE))
    k = jnp.concatenate([k_nope, k_rope], axis=-1)
    q = rms_norm(q, q_norm)
    k = rms_norm(k, k_norm)
    q = jnp.concatenate([q[..., :MLA_NOPE], apply_rope(q[..., MLA_NOPE:], cos, sin)], axis=-1)
    k = jnp.concatenate([k[..., :MLA_NOPE], apply_rope(k[..., MLA_NOPE:], cos, sin)], axis=-1)
    o = causal_block_attention(q, k, v)
    return o.reshape(B, S, MLA_HEADS * MLA_V)


def sgu_branch(p, v_norm, w_s, b_s):
    B, S, _ = p.shape
    p = jax.nn.gelu(p)
    u, v = p[..., :SG_WIDTH], p[..., SG_WIDTH:]
    v = rms_norm(v, v_norm)
    v = v.reshape(B, S // SG_CHUNK, SG_CHUNK, SG_GROUPS, SG_WIDTH // SG_GROUPS)
    mask = jnp.tril(jnp.ones((SG_CHUNK, SG_CHUNK), dtype=bool))
    w = jnp.where(mask[None], w_s, jnp.zeros_like(w_s))
    mixed = jnp.einsum('gts,bnsgc->bntgc', w, v) + b_s.T[None, None, :, :, None]
    return u * mixed.reshape(B, S, SG_WIDTH)


def token_shift(p, mu):
    prev = jnp.pad(p[:, :-1], ((0, 0), (1, 0), (0, 0)))
    return p + (prev - p) * mu


def rwkv7_scan(r, decay, k, v, a, b):
    B, S, H, N = r.shape
    xs = tuple(t.astype(jnp.float32).transpose(1, 0, 2, 3) for t in (r, decay, k, v, a, b))

    def step(state, inp):
        r_t, w_t, k_t, v_t, a_t, b_t = inp
        sa = jnp.einsum('bhvk,bhk->bhv', state, a_t)
        state = (state * w_t[:, :, None, :] + sa[..., None] * b_t[:, :, None, :]
                 + v_t[..., None] * k_t[:, :, None, :])
        return state, jnp.einsum('bhvk,bhk->bhv', state, r_t)

    s0 = jnp.zeros((B, H, N, N), jnp.float32)
    _, ys = lax.scan(step, s0, xs)
    return ys.transpose(1, 0, 2, 3)


def rwkv7_branch(p_rw, mu, w0, w2, a0, a2, g2, k_k, k_a, r_k, ln_g, ln_b, v_first, vres):
    B, S, _ = p_rw.shape
    dt = p_rw.dtype
    p_rw = token_shift(p_rw, mu)
    r, k, v, xw, xa, xg = split_cols(p_rw, [RW_WIDTH, RW_WIDTH, RW_WIDTH,
                                            RW_DECAY_RANK, RW_A_RANK, RW_GATE_RANK])
    w = -jax.nn.softplus(-(w0 + jnp.tanh(xw) @ w2).astype(jnp.float32)) - 0.5
    decay = jnp.exp(-jnp.exp(w))
    a = jax.nn.sigmoid(a0 + xa @ a2)
    g = jax.nn.sigmoid(xg) @ g2
    if vres is None:
        v_first = v
    else:
        v0, v1, v2 = vres
        v = v + (v_first - v) * jax.nn.sigmoid(v0 + (v @ v1) @ v2)
    hs = (B, S, RW_HEADS, RW_HEAD)
    kk = (k * k_k).reshape(hs).astype(jnp.float32)
    kk = kk * lax.rsqrt(jnp.maximum(jnp.sum(kk * kk, axis=-1, keepdims=True), 1e-24))
    k = k * (1.0 + (a - 1.0) * k_a)
    a_h = a.reshape(hs).astype(jnp.float32)
    r_h, k_h, v_h = r.reshape(hs), k.reshape(hs), v.reshape(hs)
    y = rwkv7_scan(r_h, decay.reshape(hs), k_h, v_h, -kk, kk * a_h)
    mean = jnp.mean(y, axis=-1, keepdims=True)
    var = jnp.mean(jnp.square(y - mean), axis=-1, keepdims=True)
    y = ((y - mean) * lax.rsqrt(var + RW_GN_EPS)).reshape(B, S, RW_WIDTH)
    y = (y * ln_g.astype(jnp.float32) + ln_b.astype(jnp.float32)).astype(dt)
    bonus = jnp.sum(r_h * k_h * r_k, axis=-1, keepdims=True) * v_h
    y = (y + bonus.reshape(B, S, RW_WIDTH)) * g
    return y, v_first


def setup_inputs(seed: int = 0) -> dict:
    key = jax.random.key(seed)
    ks = iter(jax.random.split(key, 64))
    f32 = jnp.float32

    def nrm(shape, scale):
        return jax.random.normal(next(ks), shape, f32) * scale

    def gain(shape):
        return 1.0 + 0.02 * jax.random.normal(next(ks), shape, f32)

    L = DEPTH
    x = jax.random.normal(next(ks), (BATCH, SEQ, D_MODEL), f32)
    offs = jax.random.randint(next(ks), (BATCH, 1), 0, 1024, dtype=jnp.int32)
    positions = offs + jnp.arange(SEQ, dtype=jnp.int32)[None, :]
    return {
        "x": x,
        "positions": positions,
        "ffn1_norm": gain((L, D_MODEL)),
        "ffn1_w_gate": nrm((L, D_MODEL, D_FF), D_MODEL ** -0.5),
        "ffn1_w_up": nrm((L, D_MODEL, D_FF), D_MODEL ** -0.5),
        "ffn1_w_down": nrm((L, D_FF, D_MODEL), D_FF ** -0.5),
        "mix_norm": gain((L, D_MODEL)),
        "w_in": nrm((L, D_MODEL, IN_COLS), D_MODEL ** -0.5),
        "mla_q_a_norm": gain((L, MLA_Q_RANK)),
        "mla_w_uq": nrm((L, MLA_Q_RANK, MLA_HEADS * MLA_QK), MLA_Q_RANK ** -0.5),
        "mla_kv_a_norm": gain((L, MLA_KV_RANK)),
        "mla_w_ukv": nrm((L, MLA_KV_RANK, MLA_HEADS * (MLA_NOPE + MLA_V)), MLA_KV_RANK ** -0.5),
        "mla_q_norm": gain((L, MLA_QK)),
        "mla_k_norm": gain((L, MLA_QK)),
        "sg_v_norm": gain((L, SG_WIDTH)),
        "sg_w_s": nrm((L, SG_GROUPS, SG_CHUNK, SG_CHUNK), SG_CHUNK ** -0.5),
        "sg_b_s": gain((L, SG_GROUPS, SG_CHUNK)),
        "rw_mu": jax.random.uniform(next(ks), (L, RW_COLS), f32),
        "rw_w0": jax.random.uniform(next(ks), (L, RW_WIDTH), f32, -6.5, -1.5),
        "rw_w2": nrm((L, RW_DECAY_RANK, RW_WIDTH), 0.1),
        "rw_a0": nrm((L, RW_WIDTH), 0.1),
        "rw_a2": nrm((L, RW_A_RANK, RW_WIDTH), 0.5 * RW_A_RANK ** -0.5),
        "rw_g2": nrm((L, RW_GATE_RANK, RW_WIDTH), RW_GATE_RANK ** -0.5),
        "rw_k_k": 0.85 + 0.02 * jax.random.normal(next(ks), (L, RW_WIDTH), f32),
        "rw_k_a": gain((L, RW_WIDTH)),
        "rw_r_k": nrm((L, RW_HEADS, RW_HEAD), 0.1),
        "rw_ln_g": gain((L, RW_WIDTH)),
        "rw_ln_b": nrm((L, RW_WIDTH), 0.02),
        "rw_v0": gain((L - 1, RW_WIDTH)),
        "rw_v1": nrm((L - 1, RW_WIDTH, RW_MV_RANK), RW_WIDTH ** -0.5),
        "rw_v2": nrm((L - 1, RW_MV_RANK, RW_WIDTH), RW_MV_RANK ** -0.5),
        "w_out_mla": nrm((L, MLA_HEADS * MLA_V, D_MODEL), (MLA_HEADS * MLA_V) ** -0.5),
        "w_out_sg": nrm((L, SG_WIDTH, D_MODEL), SG_WIDTH ** -0.5),
        "w_out_rw": nrm((L, RW_WIDTH, D_MODEL), RW_WIDTH ** -0.5),
        "w_o": nrm((L, D_MODEL, D_MODEL), D_MODEL ** -0.5),
        "ffn2_norm": gain((L, D_MODEL)),
        "ffn2_w_gate": nrm((L, D_MODEL, D_FF), D_MODEL ** -0.5),
        "ffn2_w_up": nrm((L, D_MODEL, D_FF), D_MODEL ** -0.5),
        "ffn2_w_down": nrm((L, D_FF, D_MODEL), D_FF ** -0.5),
    }


def reference(x, positions, ffn1_norm, ffn1_w_gate, ffn1_w_up, ffn1_w_down, mix_norm, w_in,
              mla_q_a_norm, mla_w_uq, mla_kv_a_norm, mla_w_ukv, mla_q_norm, mla_k_norm,
              sg_v_norm, sg_w_s, sg_b_s,
              rw_mu, rw_w0, rw_w2, rw_a0, rw_a2, rw_g2, rw_k_k, rw_k_a, rw_r_k, rw_ln_g, rw_ln_b,
              rw_v0, rw_v1, rw_v2,
              w_out_mla, w_out_sg, w_out_rw, w_o,
              ffn2_norm, ffn2_w_gate, ffn2_w_up, ffn2_w_down):
    B, S, D = x.shape
    cos, sin = rope_tables(positions)
    h = x
    v_first = None
    for i in range(DEPTH):
        h = h + 0.5 * swiglu(rms_norm(h, ffn1_norm[i]), ffn1_w_gate[i], ffn1_w_up[i], ffn1_w_down[i])
        z = rms_norm(h, mix_norm[i])
        p = z @ w_in[i]
        c_q, c_kv, k_pe, p_sg, p_rw, p_gate = split_cols(
            p, [MLA_Q_RANK, MLA_KV_RANK, MLA_ROPE, SG_COLS, RW_COLS, GATE_COLS])
        y_a = mla_branch(c_q, c_kv, k_pe, cos, sin, mla_q_a_norm[i], mla_w_uq[i],
                         mla_kv_a_norm[i], mla_w_ukv[i], mla_q_norm[i], mla_k_norm[i])
        y_b = sgu_branch(p_sg, sg_v_norm[i], sg_w_s[i], sg_b_s[i])
        vres = None if i == 0 else (rw_v0[i - 1], rw_v1[i - 1], rw_v2[i - 1])
        y_c, v_first = rwkv7_branch(p_rw, rw_mu[i], rw_w0[i], rw_w2[i], rw_a0[i], rw_a2[i], rw_g2[i],
                                    rw_k_k[i], rw_k_a[i], rw_r_k[i], rw_ln_g[i], rw_ln_b[i],
                                    v_first, vres)
        gates = jax.nn.sigmoid(p_gate).reshape(B, S, N_BRANCH, D)
        merged = (gates[:, :, 0] * (y_a @ w_out_mla[i])
                  + gates[:, :, 1] * (y_b @ w_out_sg[i])
                  + gates[:, :, 2] * (y_c @ w_out_rw[i]))
        h = h + merged @ w_o[i]
        h = h + 0.5 * swiglu(rms_norm(h, ffn2_norm[i]), ffn2_w_gate[i], ffn2_w_up[i], ffn2_w_down[i])
    return h
```

```cpp
#include <hip/hip_runtime.h>
#include <hip/hip_cooperative_groups.h>
#include <cstdio>
#include <cstdint>
#include <cmath>
namespace cg = cooperative_groups;
__device__ __forceinline__ int tid_opaque() { int t = threadIdx.x; asm volatile("" : "+v"(t)); return t; }
namespace pg8 {
#define PG8_LAS __attribute__((address_space(3)))
typedef unsigned short bf16_t;
typedef short bf16x8 __attribute__((ext_vector_type(8)));
typedef float f32x4 __attribute__((ext_vector_type(4)));
typedef float f32x2 __attribute__((ext_vector_type(2)));
typedef unsigned u32x4 __attribute__((ext_vector_type(4)));
typedef unsigned u32x2 __attribute__((ext_vector_type(2)));
constexpr int BM = 256, BK = 64, HALF = 128, HTB = HALF * BK * 2, STAGE_BYTES = 8 * HTB, NXCD = 8, WGM = 8;

__host__ __device__ __forceinline__ int lds_byte(int r, int c) { const int st = (r >> 4) * 2 + (c >> 5), rr = r & 15, cc = c & 31, ob = rr * 64 + cc * 2; return st * 1024 + (ob ^ (((ob >> 9) & 1) << 5)); }
__host__ __device__ __forceinline__ void stage_rc(int b, int& R, int& C) { const int st = b / 1024, sb = b % 1024, swz = sb ^ (((sb >> 9) & 1) << 5); R = (st >> 1) * 16 + swz / 64; C = (st & 1) * 32 + (swz % 64) / 2; }
__host__ __device__ __forceinline__ int perm32(int rho) { const int n = rho >> 4, i = rho & 15; return 8 * (i >> 2) + 4 * n + (i & 3); }

struct Unit { int pm, pn; };
struct Gemm { const bf16_t* A; const bf16_t* Bt; int lda, ldb; int M, N, K; };

struct StaticOrder {
    int nM, nN, nwg, G, c;
    __host__ __device__ void init(int M, int N, int G_, int c_) { nM = M / BM; nN = N / BM; nwg = nM * nN; G = G_; c = c_; }
    __host__ __device__ bool next(int i, Unit& u) const {
        const long L = (long)i * G + c; if (L >= nwg) return false;
        int wgid = (int)L; { const int q = nwg / NXCD, r = nwg % NXCD, xcd = wgid % NXCD, off = wgid / NXCD; wgid = (xcd < r ? xcd * (q + 1) : r * (q + 1) + (xcd - r) * q) + off; }
        const int nig = WGM * nN, gid = wgid / nig, fm = gid * WGM, gsz = (nM - fm) < WGM ? (nM - fm) : WGM;
        u.pm = fm + ((wgid % nig) % gsz); u.pn = (wgid % nig) / gsz; return true;
    }
    __device__ __forceinline__ void a_ready(const Unit&) const {}
    __device__ __forceinline__ void done(const Unit&) const {}
};

typedef __bf16 bf16x2_t __attribute__((ext_vector_type(2)));
__device__ __forceinline__ unsigned cvt_pk_bf16(float lo, float hi) { f32x2 v = {lo, hi}; bf16x2_t b = __builtin_convertvector(v, bf16x2_t); return __builtin_bit_cast(unsigned, b); }

template <class Epi, class Sched, bool ALIGN_EPI = false, bool SP2 = false>
__device__ __forceinline__ void gemm_phase(PG8_LAS unsigned char* lds, const Gemm g, const Sched& S, const Epi& E) {
    const int tid = tid_opaque(), wid = __builtin_amdgcn_readfirstlane(tid >> 6), lane = tid & 63, wr = wid >> 2, wc = wid & 3, fr = lane & 15, fq = lane >> 4;
    const int K = g.K, nt = K / BK;
    unsigned voffA[2], voffB[2];
#pragma unroll
    for (int i = 0; i < 2; ++i) { int R, C; stage_rc(tid * 16 + i * 8192, R, C); const int Rb = Epi::PERM ? ((R & ~31) + perm32(R & 31)) : R;
        voffA[i] = (unsigned)(R * g.lda + C) * 2u; voffB[i] = (unsigned)(Rb * g.ldb + C) * 2u; }
    const size_t kstep = (size_t)(BK * 2);
    const size_t hstepA = (size_t)HALF * g.lda * 2, hstepB = (size_t)HALF * g.ldb * 2;
    const size_t tstepA = 2 * hstepA, tstepB = 2 * hstepB;
    const unsigned ldsw = (unsigned)wid * 1024u;
    const int aoff = lds_byte(wr * 64 + fr, fq * 8), boff = lds_byte(wc * 32 + fr, fq * 8);
#define PG8_SA(b, h) (((b) * 2 + (h)) * HTB)
#define PG8_SB(b, h) ((4 + (b) * 2 + (h)) * HTB)
#define PG8_STAGE(bufoff, gbase, voff) do { _Pragma("unroll") for (int _i = 0; _i < 2; ++_i) \
        __builtin_amdgcn_global_load_lds((const unsigned*)((const char*)(gbase) + (voff)[_i]), (PG8_LAS unsigned*)(lds + (bufoff) + ldsw + _i * 8192), 16, 0, 0); } while (0)
#define PG8_LDA(dst, b, h) do { _Pragma("unroll") for (int m = 0; m < 4; ++m) _Pragma("unroll") for (int k = 0; k < 2; ++k) dst[m][k] = *(const PG8_LAS bf16x8*)(lds + PG8_SA(b, h) + aoff + m * 2048 + k * 1024); } while (0)
#define PG8_LDB(dst, b, h) do { _Pragma("unroll") for (int n = 0; n < 2; ++n) _Pragma("unroll") for (int k = 0; k < 2; ++k) dst[n][k] = *(const PG8_LAS bf16x8*)(lds + PG8_SB(b, h) + boff + n * 2048 + k * 1024); } while (0)
#define PG8_MMA(ai, bj, At, Bt) do { __builtin_amdgcn_s_setprio(1); _Pragma("unroll") for (int m = 0; m < 4; ++m) _Pragma("unroll") for (int n = 0; n < 2; ++n) _Pragma("unroll") for (int k = 0; k < 2; ++k) \
        acc[ai][bj][m][n] = __builtin_amdgcn_mfma_f32_16x16x32_bf16(Bt[n][k], At[m][k], acc[ai][bj][m][n], 0, 0, 0); __builtin_amdgcn_s_setprio(0); } while (0)
#define PG8_WAIT_V(n) asm volatile("s_waitcnt vmcnt(" #n ")" ::: "memory")
#define PG8_WAIT_L(n) asm volatile("s_waitcnt lgkmcnt(" #n ")" ::: "memory")
#define PG8_BAR __builtin_amdgcn_s_barrier()
#define PG8_SCHED __builtin_amdgcn_sched_barrier(0)
    Unit cur, nxt; int ui = 0;
    if (!S.next(0, cur)) return;
    f32x4 acc[2][2][4][2];
#pragma unroll
    for (int a = 0; a < 2; ++a)
#pragma unroll
        for (int b = 0; b < 2; ++b)
#pragma unroll
            for (int m = 0; m < 4; ++m)
#pragma unroll
                for (int n = 0; n < 2; ++n) acc[a][b][m][n] = (f32x4){0.f, 0.f, 0.f, 0.f};
    bf16x8 At[4][2], B0[2][2], B1[2][2];
    const char* cA = (const char*)g.A + (size_t)cur.pm * tstepA; const char* cB = (const char*)g.Bt + (size_t)cur.pn * tstepB;
    S.a_ready(cur);
    if constexpr (SP2) {
        PG8_STAGE(PG8_SB(0, 0), cB, voffB); PG8_STAGE(PG8_SB(0, 1), cB + hstepB, voffB); PG8_STAGE(PG8_SA(0, 0), cA, voffA); PG8_STAGE(PG8_SA(0, 1), cA + hstepA, voffA);
        if (wr == 1) PG8_BAR;
        PG8_WAIT_V(2); PG8_BAR;
        PG8_STAGE(PG8_SB(1, 0), cB + kstep, voffB); PG8_STAGE(PG8_SA(1, 0), cA + kstep, voffA); PG8_STAGE(PG8_SB(1, 1), cB + hstepB + kstep, voffB);
        PG8_WAIT_V(6); PG8_BAR;
    } else {
        PG8_STAGE(PG8_SB(0, 0), cB, voffB); PG8_STAGE(PG8_SA(0, 0), cA, voffA); PG8_STAGE(PG8_SB(0, 1), cB + hstepB, voffB); PG8_STAGE(PG8_SA(0, 1), cA + hstepA, voffA);
        if (wr == 1) PG8_BAR;
        PG8_WAIT_V(4); PG8_BAR;
        PG8_STAGE(PG8_SB(1, 0), cB + kstep, voffB); PG8_STAGE(PG8_SA(1, 0), cA + kstep, voffA); PG8_STAGE(PG8_SB(1, 1), cB + hstepB + kstep, voffB);
        PG8_WAIT_V(6); PG8_BAR;
    }
    for (;;) {
        const bool has_next = S.next(ui + 1, nxt);
        const char* nA = has_next ? (const char*)g.A + (size_t)nxt.pm * tstepA : cA; const char* nB = has_next ? (const char*)g.Bt + (size_t)nxt.pn * tstepB : cB;
        for (int t = 0; t < nt; t += 2) {
            const bool last = (t == nt - 2);
            const char* a1 = cA + (size_t)(t + 1) * kstep;
            const char* a2 = last ? nA : cA + (size_t)(t + 2) * kstep; const char* b2 = last ? nB : cB + (size_t)(t + 2) * kstep;
            const char* a3 = a2 + kstep; const char* b3 = b2 + kstep;
            if (last && has_next) S.a_ready(nxt);
            if constexpr (SP2) {
            PG8_LDB(B0, 0, 0); PG8_LDB(B1, 0, 1); PG8_SCHED; PG8_LDA(At, 0, 0); PG8_STAGE(PG8_SA(1, 1), a1 + hstepA, voffA);
            PG8_WAIT_V(8); PG8_WAIT_L(0); PG8_BAR; PG8_MMA(0, 0, At, B0); PG8_MMA(0, 1, At, B1); PG8_BAR; PG8_SCHED;
            PG8_LDA(At, 0, 1); PG8_STAGE(PG8_SB(0, 0), b2, voffB); PG8_STAGE(PG8_SB(0, 1), b2 + hstepB, voffB); PG8_STAGE(PG8_SA(0, 0), a2, voffA);
            PG8_WAIT_V(8); PG8_WAIT_L(0); PG8_BAR; PG8_MMA(1, 0, At, B0); PG8_MMA(1, 1, At, B1); PG8_BAR; PG8_SCHED;
            PG8_LDB(B0, 1, 0); PG8_LDB(B1, 1, 1); PG8_SCHED; PG8_LDA(At, 1, 0); PG8_STAGE(PG8_SA(0, 1), a2 + hstepA, voffA);
            PG8_WAIT_V(8); PG8_WAIT_L(0); PG8_BAR; PG8_MMA(0, 0, At, B0); PG8_MMA(0, 1, At, B1); PG8_BAR; PG8_SCHED;
            PG8_LDA(At, 1, 1); PG8_STAGE(PG8_SB(1, 0), b3, voffB); PG8_STAGE(PG8_SB(1, 1), b3 + hstepB, voffB); PG8_STAGE(PG8_SA(1, 0), a3, voffA);
            PG8_WAIT_V(8); PG8_WAIT_L(0); PG8_BAR; PG8_MMA(1, 0, At, B0); PG8_MMA(1, 1, At, B1); PG8_BAR; PG8_SCHED;
            } else {
            PG8_LDB(B0, 0, 0); PG8_SCHED; PG8_LDA(At, 0, 0); PG8_STAGE(PG8_SA(1, 1), a1 + hstepA, voffA);
            PG8_WAIT_L(8); PG8_BAR; PG8_WAIT_L(0); PG8_MMA(0, 0, At, B0); PG8_BAR; PG8_SCHED;
            PG8_LDB(B1, 0, 1); PG8_STAGE(PG8_SB(0, 0), b2, voffB);
            PG8_BAR; PG8_WAIT_L(0); PG8_MMA(0, 1, At, B1); PG8_BAR;
            PG8_LDA(At, 0, 1); PG8_STAGE(PG8_SA(0, 0), a2, voffA);
            PG8_BAR; PG8_WAIT_L(0); PG8_MMA(1, 0, At, B0); PG8_BAR; PG8_SCHED;
            PG8_STAGE(PG8_SB(0, 1), b2 + hstepB, voffB);
            PG8_WAIT_V(6); PG8_BAR; PG8_MMA(1, 1, At, B1); PG8_BAR;
            PG8_LDB(B0, 1, 0); PG8_SCHED; PG8_LDA(At, 1, 0); PG8_STAGE(PG8_SA(0, 1), a2 + hstepA, voffA);
            PG8_WAIT_L(8); PG8_BAR; PG8_WAIT_L(0); PG8_MMA(0, 0, At, B0); PG8_BAR; PG8_SCHED;
            PG8_LDB(B1, 1, 1); PG8_STAGE(PG8_SB(1, 0), b3, voffB);
            PG8_BAR; PG8_WAIT_L(0); PG8_MMA(0, 1, At, B1); PG8_BAR;
            PG8_LDA(At, 1, 1); PG8_STAGE(PG8_SA(1, 0), a3, voffA);
            PG8_BAR; PG8_WAIT_L(0); PG8_MMA(1, 0, At, B0); PG8_BAR; PG8_SCHED;
            PG8_STAGE(PG8_SB(1, 1), b3 + hstepB, voffB);
            PG8_WAIT_V(6); PG8_BAR; PG8_MMA(1, 1, At, B1); PG8_BAR;
            }
        }
        if constexpr (ALIGN_EPI) { if (wr == 0) PG8_BAR; }
        E(acc, cur, wr, wc, fr, fq); S.done(cur);
        if (!has_next) break;
#pragma unroll
        for (int a = 0; a < 2; ++a)
#pragma unroll
            for (int b = 0; b < 2; ++b)
#pragma unroll
                for (int m = 0; m < 4; ++m)
#pragma unroll
                    for (int n = 0; n < 2; ++n) acc[a][b][m][n] = (f32x4){0.f, 0.f, 0.f, 0.f};
        cur = nxt; cA = nA; cB = nB; ++ui;
        if constexpr (ALIGN_EPI) { if (wr == 1) PG8_BAR; }
    }
    PG8_WAIT_V(0);
    if constexpr (!ALIGN_EPI) { if (wr == 0) PG8_BAR; }
    PG8_BAR;
#undef PG8_SA
#undef PG8_SB
#undef PG8_STAGE
#undef PG8_LDA
#undef PG8_LDB
#undef PG8_MMA
#undef PG8_WAIT_V
#undef PG8_WAIT_L
#undef PG8_BAR
#undef PG8_SCHED
}
}
constexpr int BATCH = 4, SEQ = 4096, T = BATCH * SEQ, DM = 1024, FF = 2816, DEPTH = 2;
constexpr int NH = 8, QK = 96, NOPE = 64, ROPE = 32, VD = 64, QR = 256, KVR = 128;
constexpr int NPC = 3328;
constexpr int NGC = 3072;
constexpr int RWC = 1792;
constexpr float EPS = 1e-6f;

typedef unsigned short bf16_t;
typedef float f32x4 __attribute__((ext_vector_type(4)));
typedef float f32x2 __attribute__((ext_vector_type(2)));
typedef unsigned u32x4 __attribute__((ext_vector_type(4)));
typedef unsigned u32x2 __attribute__((ext_vector_type(2)));
#define LAS __attribute__((address_space(3)))

__device__ __forceinline__ float bf2f(unsigned short b) { return __uint_as_float(((unsigned)b) << 16); }
__device__ __forceinline__ float bflo(unsigned w) { return __uint_as_float(w << 16); }
__device__ __forceinline__ float bfhi(unsigned w) { return __uint_as_float(w & 0xffff0000u); }
__device__ __forceinline__ unsigned f2bf(float f) { unsigned u = __builtin_bit_cast(unsigned, f); return (u + 0x7fffu + ((u >> 16) & 1u)) >> 16; }
__device__ __forceinline__ unsigned pk2(float lo, float hi) { return f2bf(lo) | (f2bf(hi) << 16); }
__device__ __forceinline__ float wave_sum(float v) {
#pragma unroll
    for (int o = 1; o < 64; o <<= 1) v += __shfl_xor(v, o);
    return v;
}
__device__ __forceinline__ float sigmoidf_(float x) { return __builtin_amdgcn_rcpf(1.f + __expf(-x)); }
__device__ __forceinline__ float gelu_tanh(float x) {
    const float u = 0.7978845608028654f * (x + 0.044715f * x * x * x);
    return x * sigmoidf_(2.f * u);
}
__device__ __forceinline__ float rstd16(const float* ssq, int row) {
    const f32x4* p = (const f32x4*)(ssq + (size_t)row * 16);
    const f32x4 a = p[0], b = p[1], c = p[2], d = p[3];
    const float s = ((a[0] + a[1]) + (a[2] + a[3])) + ((b[0] + b[1]) + (b[2] + b[3])) + ((c[0] + c[1]) + (c[2] + c[3])) + ((d[0] + d[1]) + (d[2] + d[3]));
    return __builtin_amdgcn_rsqf(s * (1.f / DM) + EPS);
}

using pg8::Unit; using pg8::cvt_pk_bf16;
struct EpiUp {
    static constexpr bool PERM = true;
    bf16_t* O; const float* ssq;
    __device__ __forceinline__ void operator()(const f32x4 (&acc)[2][2][4][2], const Unit& u, int wr, int wc, int fr, int fq) const {
        const int row0 = u.pm * 256 + wr * 64 + fr, col0 = u.pn * 128 + wc * 32 + 8 * fq;
#pragma unroll
        for (int ai = 0; ai < 2; ++ai)
#pragma unroll
            for (int m = 0; m < 4; ++m) {
                const int row = row0 + ai * 128 + m * 16; const float rs = rstd16(ssq, row);
                float o[8];
#pragma unroll
                for (int n = 0; n < 2; ++n)
#pragma unroll
                    for (int j = 0; j < 4; ++j) { const float gg = acc[ai][0][m][n][j] * rs, uu = acc[ai][1][m][n][j] * rs; o[n * 4 + j] = gg * sigmoidf_(gg) * uu; }
                u32x4 w; w.x = cvt_pk_bf16(o[0], o[1]); w.y = cvt_pk_bf16(o[2], o[3]); w.z = cvt_pk_bf16(o[4], o[5]); w.w = cvt_pk_bf16(o[6], o[7]);
                *(u32x4*)(O + (size_t)row * FF + col0) = w;
            }
    }
};
struct EpiRes {
    static constexpr bool PERM = false;
    bf16_t* hi; bf16_t* lo; float* ssq; float scale; float* outf;
    __device__ __forceinline__ void operator()(const f32x4 (&acc)[2][2][4][2], const Unit& u, int wr, int wc, int fr, int fq) const {
        const int row0 = u.pm * 256 + wr * 64 + fr, col0 = u.pn * 256 + wc * 32 + 4 * fq;
#pragma unroll
        for (int ai = 0; ai < 2; ++ai)
#pragma unroll
            for (int m = 0; m < 4; ++m) {
                const int row = row0 + ai * 128 + m * 16; float ss = 0.f;
#pragma unroll
                for (int bj = 0; bj < 2; ++bj)
#pragma unroll
                    for (int n = 0; n < 2; ++n) {
                        const size_t off = (size_t)row * DM + col0 + bj * 128 + n * 16;
                        const u32x2 wh = *(const u32x2*)(hi + off), wl = *(const u32x2*)(lo + off);
                        f32x4 h; h[0] = bflo(wh.x) + bflo(wl.x); h[1] = bfhi(wh.x) + bfhi(wl.x); h[2] = bflo(wh.y) + bflo(wl.y); h[3] = bfhi(wh.y) + bfhi(wl.y);
                        h = h + acc[ai][bj][m][n] * scale;
                        ss += (h[0] * h[0] + h[1] * h[1]) + (h[2] * h[2] + h[3] * h[3]);
                        if (outf) { *(f32x4*)(outf + off) = h; }
                        else {
                            u32x2 nh; nh.x = cvt_pk_bf16(h[0], h[1]); nh.y = cvt_pk_bf16(h[2], h[3]);
                            u32x2 nl; nl.x = cvt_pk_bf16(h[0] - bflo(nh.x), h[1] - bfhi(nh.x)); nl.y = cvt_pk_bf16(h[2] - bflo(nh.y), h[3] - bfhi(nh.y));
                            *(u32x2*)(hi + off) = nh; *(u32x2*)(lo + off) = nl;
                        }
                    }
                ss += __shfl_xor(ss, 16); ss += __shfl_xor(ss, 32);
                if (fq == 0) ssq[(size_t)row * 16 + u.pn * 4 + wc] = ss;
            }
    }
};
struct EpiP {
    static constexpr bool PERM = false;
    float* P; int ldp; const float* ssq;
    __device__ __forceinline__ void operator()(const f32x4 (&acc)[2][2][4][2], const Unit& u, int wr, int wc, int fr, int fq) const {
        const int row0 = u.pm * 256 + wr * 64 + fr, col0 = u.pn * 256 + wc * 32 + 4 * fq;
#pragma unroll
        for (int ai = 0; ai < 2; ++ai)
#pragma unroll
            for (int m = 0; m < 4; ++m) {
                const int row = row0 + ai * 128 + m * 16; const float rs = rstd16(ssq, row);
#pragma unroll
                for (int bj = 0; bj < 2; ++bj)
#pragma unroll
                    for (int n = 0; n < 2; ++n) *(f32x4*)(P + (size_t)row * ldp + col0 + bj * 128 + n * 16) = acc[ai][bj][m][n] * rs;
            }
    }
};
struct EpiG {
    static constexpr bool PERM = true;
    bf16_t* G; const float* ssq;
    __device__ __forceinline__ void operator()(const f32x4 (&acc)[2][2][4][2], const Unit& u, int wr, int wc, int fr, int fq) const {
        const int row0 = u.pm * 256 + wr * 64 + fr, col0 = u.pn * 256 + wc * 32 + 8 * fq;
#pragma unroll
        for (int ai = 0; ai < 2; ++ai)
#pragma unroll
            for (int m = 0; m < 4; ++m) {
                const int row = row0 + ai * 128 + m * 16; const float rs = rstd16(ssq, row);
#pragma unroll
                for (int bj = 0; bj < 2; ++bj) {
                    float o[8];
#pragma unroll
                    for (int n = 0; n < 2; ++n)
#pragma unroll
                        for (int j = 0; j < 4; ++j) o[n * 4 + j] = sigmoidf_(acc[ai][bj][m][n][j] * rs);
                    u32x4 w; w.x = cvt_pk_bf16(o[0], o[1]); w.y = cvt_pk_bf16(o[2], o[3]); w.z = cvt_pk_bf16(o[4], o[5]); w.w = cvt_pk_bf16(o[6], o[7]);
                    *(u32x4*)(G + (size_t)row * NGC + col0 + bj * 128) = w;
                }
            }
    }
};
constexpr size_t MF_STRIDE = (size_t)4096 * 1024;
struct EpiMerge {
    static constexpr bool PERM = true;
    const bf16_t* G; float* Mf; bf16_t* Mb; int mode;
    __device__ __forceinline__ void operator()(const f32x4 (&acc)[2][2][4][2], const Unit& u, int wr, int wc, int fr, int fq) const {
        const int row0 = u.pm * 256 + wr * 64 + fr, col0 = u.pn * 256 + wc * 32 + 8 * fq;
#pragma unroll
        for (int ai = 0; ai < 2; ++ai)
#pragma unroll
            for (int m = 0; m < 4; ++m) {
                const int row = row0 + ai * 128 + m * 16;
#pragma unroll
                for (int bj = 0; bj < 2; ++bj) {
                    const int col = col0 + bj * 128;
                    const u32x4 gw = *(const u32x4*)(G + (size_t)row * NGC + col);
                    f32x4 v0, v1;
                    v0[0] = bflo(gw.x) * acc[ai][bj][m][0][0]; v0[1] = bfhi(gw.x) * acc[ai][bj][m][0][1]; v0[2] = bflo(gw.y) * acc[ai][bj][m][0][2]; v0[3] = bfhi(gw.y) * acc[ai][bj][m][0][3];
                    v1[0] = bflo(gw.z) * acc[ai][bj][m][1][0]; v1[1] = bfhi(gw.z) * acc[ai][bj][m][1][1]; v1[2] = bflo(gw.w) * acc[ai][bj][m][1][2]; v1[3] = bfhi(gw.w) * acc[ai][bj][m][1][3];
                    float* mp = Mf + (size_t)row * DM + col;
                    if (mode > 0) { const float* rp = mp + (mode == 2 ? MF_STRIDE : 0); v0 = v0 + *(const f32x4*)rp; v1 = v1 + *(const f32x4*)(rp + 4); }
                    if (mode < 2) { float* wp = mp + (mode == 1 ? MF_STRIDE : 0); *(f32x4*)wp = v0; *(f32x4*)(wp + 4) = v1; }
                    else { u32x4 w; w.x = cvt_pk_bf16(v0[0], v0[1]); w.y = cvt_pk_bf16(v0[2], v0[3]); w.z = cvt_pk_bf16(v1[0], v1[1]); w.w = cvt_pk_bf16(v1[2], v1[3]);
                           *(u32x4*)(Mb + (size_t)row * DM + col) = w; }
                }
            }
    }
};
constexpr size_t MiB = 1u << 20;
constexpr size_t WS_W = 0;
constexpr size_t WS_HHI = 54 * MiB, WS_HLO = 86 * MiB;
constexpr size_t WS_VF = 118 * MiB;
constexpr size_t WS_SSQ = 150 * MiB;
constexpr size_t WS_ROPE = 151 * MiB;
constexpr size_t WS_ACT = 153 * MiB;
constexpr size_t WS_P = 153 * MiB;
constexpr size_t WS_G = 205 * MiB;
constexpr size_t WS_Q = 229 * MiB;
constexpr size_t WS_K = 241 * MiB;
constexpr size_t WS_V = 253 * MiB;
constexpr size_t WS_YA = 261 * MiB, WS_YB = 265 * MiB;
constexpr size_t WS_MISC = 269 * MiB;
constexpr size_t WS_END = 270 * MiB;
constexpr size_t OW_W1GU1 = 0, OW_W2_1 = OW_W1GU1 + (size_t)2 * FF * DM, OW_W1GU2 = OW_W2_1 + (size_t)DM * FF, OW_W2_2 = OW_W1GU2 + (size_t)2 * FF * DM,
                 OW_WIN = OW_W2_2 + (size_t)DM * FF, OW_WOUT = OW_WIN + (size_t)6400 * DM, OW_WO = OW_WOUT + (size_t)DM * 1536, OW_END = OW_WO + (size_t)DM * DM;
static_assert(OW_END * 2 <= 54 * MiB, "weights fit");
constexpr int TB = SEQ;

__device__ __forceinline__ void conv_item(const float* src  , int ld_src, int sn0  , const float* scale  ,
                                          bf16_t* dst  , int ldd, LAS float* scr, int lane) {
    if (sn0 >= 0) {
#pragma unroll 8
        for (int i = 0; i < 32; ++i) { const int kk = 2 * i + (lane >> 5); float v = src[(size_t)kk * ld_src + sn0 + (lane & 31)]; if (scale) v *= scale[kk]; scr[kk * 33 + (lane & 31)] = v; }
    } else {
#pragma unroll 8
        for (int i = 0; i < 32; ++i) { const int kk = 2 * i + (lane >> 5); scr[kk * 33 + (lane & 31)] = 0.f; }
    }
    asm volatile("s_waitcnt lgkmcnt(0)" ::: "memory");
    const int c = lane & 7;
#pragma unroll
    for (int j = 0; j < 4; ++j) { const int n = (lane >> 3) + 8 * j; const LAS float* s = scr + (8 * c) * 33 + n;
        u32x4 o; o.x = pk2(s[0 * 33], s[1 * 33]); o.y = pk2(s[2 * 33], s[3 * 33]); o.z = pk2(s[4 * 33], s[5 * 33]); o.w = pk2(s[6 * 33], s[7 * 33]);
        *(u32x4*)(dst + (size_t)n * ldd + 8 * c) = o; }
    asm volatile("s_waitcnt lgkmcnt(0)" ::: "memory");
}

struct Args { const void* in[39]; float* out; unsigned char* ws; int ph_lo, ph_hi; };
typedef __attribute__((address_space(4))) const Args CArgs;
struct LayerW {
    CArgs* ap; int L;
#define FI(i) ((const float*)ap->in[i])
#define ACC(name, expr) __device__ __forceinline__ const float* name() const { return expr; }
    ACC(n1, FI(2) + (size_t)L * DM) ACC(g1, FI(3) + (size_t)L * DM * FF) ACC(u1, FI(4) + (size_t)L * DM * FF) ACC(d1, FI(5) + (size_t)L * FF * DM)
    ACC(mixn, FI(6) + (size_t)L * DM) ACC(win, FI(7) + (size_t)L * DM * 6304)
    ACC(qan, FI(8) + L * 256) ACC(wuq, FI(9) + (size_t)L * 256 * 768) ACC(kvan, FI(10) + L * 128) ACC(wukv, FI(11) + (size_t)L * 128 * 1024)
    ACC(qn, FI(12) + L * 96) ACC(kn, FI(13) + L * 96) ACC(sgvn, FI(14) + L * 512) ACC(sgws, FI(15) + (size_t)L * 8 * 128 * 128) ACC(sgbs, FI(16) + L * 8 * 128)
    ACC(mu, FI(17) + L * RWC) ACC(w0, FI(18) + L * 512) ACC(w2, FI(19) + (size_t)L * 64 * 512) ACC(a0, FI(20) + L * 512) ACC(a2, FI(21) + (size_t)L * 64 * 512)
    ACC(g2, FI(22) + (size_t)L * 128 * 512) ACC(kk, FI(23) + L * 512) ACC(ka, FI(24) + L * 512) ACC(rk, FI(25) + L * 512) ACC(lng, FI(26) + L * 512) ACC(lnb, FI(27) + L * 512)
    ACC(v0, FI(28) + (L > 0 ? L - 1 : 0) * 512) ACC(v1, FI(29) + (size_t)(L > 0 ? L - 1 : 0) * 512 * 32) ACC(v2, FI(30) + (size_t)(L > 0 ? L - 1 : 0) * 32 * 512)
    ACC(womla, FI(31) + (size_t)L * 512 * DM) ACC(wosg, FI(32) + (size_t)L * 512 * DM) ACC(worw, FI(33) + (size_t)L * 512 * DM) ACC(wo, FI(34) + (size_t)L * DM * DM)
    ACC(n2, FI(35) + (size_t)L * DM) ACC(g2f, FI(36) + (size_t)L * DM * FF) ACC(u2, FI(37) + (size_t)L * DM * FF) ACC(d2, FI(38) + (size_t)L * FF * DM)
#undef ACC
#undef FI
};

__device__ __forceinline__ void conv_weights(const LayerW& w, bf16_t* W, LAS float* scr, int gw, int NGW, int lane) {
    constexpr int I_GU = 16 * 176, I_D = 44 * 32, I_IN = 16 * 200, I_OUT = 24 * 32, I_O = 16 * 32;
    constexpr int NIT = 2 * I_GU + 2 * I_D + I_IN + I_OUT + I_O;
    for (int it = gw; it < NIT; it += NGW) {
        int r = it;
        if (r < 2 * I_GU) {
            const int f = r / I_GU; r -= f * I_GU; const int kb = r / 176, nb = r % 176, dn0 = 32 * nb, pn = dn0 >> 8, bj = (dn0 >> 7) & 1, c = dn0 & 127;
            const float* src = (f == 0 ? (bj ? w.u1() : w.g1()) : (bj ? w.u2() : w.g2f())) + (size_t)(64 * kb) * FF;
            conv_item(src, FF, 128 * pn + c, (f == 0 ? w.n1() : w.n2()) + 64 * kb, W + (f == 0 ? OW_W1GU1 : OW_W1GU2) + (size_t)dn0 * DM + 64 * kb, DM, scr, lane);
            continue; }
        r -= 2 * I_GU;
        if (r < 2 * I_D) {
            const int f = r / I_D; r -= f * I_D; const int kb = r / 32, nb = r % 32;
            conv_item((f == 0 ? w.d1() : w.d2()) + (size_t)(64 * kb) * DM, DM, 32 * nb, nullptr, W + (f == 0 ? OW_W2_1 : OW_W2_2) + (size_t)(32 * nb) * FF + 64 * kb, FF, scr, lane);
            continue; }
        r -= 2 * I_D;
        if (r < I_IN) {
            const int kb = r / 200, nb = r % 200, dn0 = 32 * nb; const int sn0 = dn0 < 416 ? dn0 : (dn0 < 512 ? -1 : dn0 - 96);
            conv_item(w.win() + (size_t)(64 * kb) * 6304, 6304, sn0, w.mixn() + 64 * kb, W + OW_WIN + (size_t)dn0 * DM + 64 * kb, DM, scr, lane);
            continue; }
        r -= I_IN;
        if (r < I_OUT) {
            const int kb = r / 32, nb = r % 32, br = kb >> 3, kl = kb & 7;
            const float* src = (br == 0 ? w.womla() : br == 1 ? w.wosg() : w.worw()) + (size_t)(64 * kl) * DM;
            conv_item(src, DM, 32 * nb, nullptr, W + OW_WOUT + (size_t)(32 * nb) * 1536 + 64 * kb, 1536, scr, lane);
            continue; }
        r -= I_OUT;
        { const int kb = r / 32, nb = r % 32;
          conv_item(w.wo() + (size_t)(64 * kb) * DM, DM, 32 * nb, nullptr, W + OW_WO + (size_t)(32 * nb) * DM + 64 * kb, DM, scr, lane); }
    }
}

__device__ __forceinline__ void init_rows(const float* x, bf16_t* hi, bf16_t* lo, float* ssq, int gw, int NGW, int lane) {
    for (int r = gw; r < T; r += NGW) {
        const f32x4* xr = (const f32x4*)(x + (size_t)r * DM) + lane; float s = 0.f;
#pragma unroll
        for (int j = 0; j < 4; ++j) { const f32x4 v = xr[64 * j]; s += (v[0] * v[0] + v[1] * v[1]) + (v[2] * v[2] + v[3] * v[3]);
            u32x2 h; h.x = pk2(v[0], v[1]); h.y = pk2(v[2], v[3]);
            u32x2 l; l.x = pk2(v[0] - bflo(h.x), v[1] - bfhi(h.x)); l.y = pk2(v[2] - bflo(h.y), v[3] - bfhi(h.y));
            const size_t off = (size_t)r * DM + 4 * (lane + 64 * j);
            *(u32x2*)(hi + off) = h; *(u32x2*)(lo + off) = l; }
        s = wave_sum(s);
        if (lane < 16) ssq[(size_t)r * 16 + lane] = lane == 0 ? s : 0.f;
    }
}
__device__ __forceinline__ void init_rope(const int* pos, float* cosT, float* sinT, int gtid, int NT) {
    for (int i = gtid; i < T * 16; i += NT) { const int t = i >> 4, f = i & 15;
        const float inv = powf(10000.f, -(float)f * (1.f / 16.f)); const float ang = (float)pos[t] * inv;
        cosT[i] = cosf(ang); sinT[i] = sinf(ang); }
}

constexpr float ATT_SC = 0.10206207261596577f * 1.4426950408889634f;

__device__ __forceinline__ void mla_unit(const LayerW& w, const float* P, const float* cosT, const float* sinT, float* Q, float* K, float* V, int tb, int rb, LAS float* sm) {
    const int tid = tid_opaque(), lane = tid & 63, wv = tid >> 6;
    LAS float* a = sm; LAS float* kpe = sm + 3072; LAS float* out = sm + 3328;
    __syncthreads();
    { const float* row = P + (size_t)(tb + wv) * NPC;
      const f32x4 v = *(const f32x4*)(row + lane * 4); float ss = wave_sum((v[0] * v[0] + v[1] * v[1]) + (v[2] * v[2] + v[3] * v[3]));
      float rs = __builtin_amdgcn_rsqf(ss * (1.f / 256.f) + EPS);
#pragma unroll
      for (int i = 0; i < 4; ++i) a[wv * 384 + lane * 4 + i] = v[i] * rs * w.qan()[lane * 4 + i];
      const f32x2 v2 = *(const f32x2*)(row + 256 + lane * 2); ss = wave_sum(v2[0] * v2[0] + v2[1] * v2[1]);
      rs = __builtin_amdgcn_rsqf(ss * (1.f / 128.f) + EPS);
      a[wv * 384 + 256 + lane * 2] = v2[0] * rs * w.kvan()[lane * 2]; a[wv * 384 + 256 + lane * 2 + 1] = v2[1] * rs * w.kvan()[lane * 2 + 1];
      if (lane < 32) kpe[wv * 32 + lane] = row[384 + lane]; }
    __syncthreads();
    for (int n = tid; n < 1792; n += 512) {
        float acc[8];
#pragma unroll
        for (int j = 0; j < 8; ++j) acc[j] = 0.f;
        if (n < 768) { for (int k = 0; k < 256; ++k) { const float ww = w.wuq()[(size_t)k * 768 + n];
#pragma unroll
                for (int j = 0; j < 8; ++j) acc[j] += a[j * 384 + k] * ww; } }
        else { for (int k = 0; k < 128; ++k) { const float ww = w.wukv()[(size_t)k * 1024 + (n - 768)];
#pragma unroll
                for (int j = 0; j < 8; ++j) acc[j] += a[j * 384 + 256 + k] * ww; } }
#pragma unroll
        for (int j = 0; j < 8; ++j) out[j * 1792 + n] = acc[j];
    }
    __syncthreads();
    if (tid < 64) {
        const int j = tid >> 3, h = tid & 7, t = tb + j; const size_t gr = (size_t)(rb + t);
        const LAS float* q = out + j * 1792 + h * 96; float ss = 0.f;
        for (int d = 0; d < 96; ++d) ss += q[d] * q[d];
        float rs = __builtin_amdgcn_rsqf(ss * (1.f / 96.f) + EPS);
        float* qo = Q + (size_t)t * 768 + h * 96;
        for (int d = 0; d < 64; ++d) qo[d] = q[d] * rs * w.qn()[d] * ATT_SC;
        for (int i = 0; i < 16; ++i) { const float x1 = q[64 + i] * rs * w.qn()[64 + i], x2 = q[80 + i] * rs * w.qn()[80 + i], c = cosT[gr * 16 + i], s = sinT[gr * 16 + i];
            qo[64 + i] = (x1 * c - x2 * s) * ATT_SC; qo[80 + i] = (x2 * c + x1 * s) * ATT_SC; }
        const LAS float* kn = out + j * 1792 + 768 + h * 128; const LAS float* kp = kpe + j * 32; ss = 0.f;
        for (int d = 0; d < 64; ++d) ss += kn[d] * kn[d];
        for (int i = 0; i < 32; ++i) ss += kp[i] * kp[i];
        rs = __builtin_amdgcn_rsqf(ss * (1.f / 96.f) + EPS);
        float* ko = K + (size_t)t * 768 + h * 96;
        for (int d = 0; d < 64; ++d) ko[d] = kn[d] * rs * w.kn()[d];
        for (int i = 0; i < 16; ++i) { const float x1 = kp[i] * rs * w.kn()[64 + i], x2 = kp[16 + i] * rs * w.kn()[80 + i], c = cosT[gr * 16 + i], s = sinT[gr * 16 + i];
            ko[64 + i] = x1 * c - x2 * s; ko[80 + i] = x2 * c + x1 * s; }
        float* vo = V + (size_t)t * 512 + h * 64;
        for (int d = 0; d < 64; ++d) vo[d] = kn[64 + d];
    }
}

__device__ __forceinline__ void attn_naive_unit(const float* Q, const float* K, const float* V, bf16_t* YA, int h, int qb, LAS float* sm) {
    const int tid = tid_opaque(); const int row = qb * 512 + tid; const int wmax = qb * 512 + (tid | 63);
    LAS float* Ks = sm; LAS float* Vs = sm + 6144;
    float q[96], o[64];
#pragma unroll
    for (int d = 0; d < 96; d += 4) { const f32x4 v = *(const f32x4*)(Q + (size_t)row * 768 + h * 96 + d); q[d] = v[0]; q[d + 1] = v[1]; q[d + 2] = v[2]; q[d + 3] = v[3]; }
#pragma unroll
    for (int d = 0; d < 64; ++d) o[d] = 0.f;
    float m = -INFINITY, l = 0.f;
    const int ntile = 8 * (qb + 1);
    for (int kt = 0; kt < ntile; ++kt) {
        __syncthreads();
        for (int i = tid; i < 6144; i += 512) { const int j = i / 96, d = i - j * 96; Ks[i] = K[(size_t)(kt * 64 + j) * 768 + h * 96 + d]; }
        for (int i = tid; i < 4096; i += 512) { const int j = i >> 6, d = i & 63; Vs[i] = V[(size_t)(kt * 64 + j) * 512 + h * 64 + d]; }
        __syncthreads();
        if (kt * 64 <= wmax) {
            for (int j = 0; j < 64; ++j) {
                const int key = kt * 64 + j; if (key > wmax) break;
                float s = 0.f;
#pragma unroll
                for (int d = 0; d < 96; d += 4) { const f32x4 kv = *(const LAS f32x4*)(Ks + j * 96 + d); s += q[d] * kv[0] + q[d + 1] * kv[1] + q[d + 2] * kv[2] + q[d + 3] * kv[3]; }
                if (key <= row) {
                    const float mn = fmaxf(m, s), c = exp2f(m - mn), p = exp2f(s - mn); l = l * c + p; m = mn;
#pragma unroll
                    for (int d = 0; d < 64; d += 4) { const f32x4 vv = *(const LAS f32x4*)(Vs + j * 64 + d);
                        o[d] = o[d] * c + p * vv[0]; o[d + 1] = o[d + 1] * c + p * vv[1]; o[d + 2] = o[d + 2] * c + p * vv[2]; o[d + 3] = o[d + 3] * c + p * vv[3]; }
                }
            }
        }
    }
    const float il = 1.f / l;
#pragma unroll
    for (int d = 0; d < 64; d += 8) { u32x4 wq; wq.x = pk2(o[d] * il, o[d + 1] * il); wq.y = pk2(o[d + 2] * il, o[d + 3] * il); wq.z = pk2(o[d + 4] * il, o[d + 5] * il); wq.w = pk2(o[d + 6] * il, o[d + 7] * il);
        *(u32x4*)(YA + (size_t)row * 512 + h * 64 + d) = wq; }
}

__device__ __forceinline__ void sg_rstd_rows(const float* P, float* SGR, int gw, int NGW, int lane) {
    for (int t = gw; t < TB; t += NGW) { const float* row = P + (size_t)t * NPC + 1024; float ss = 0.f;
#pragma unroll
        for (int j = 0; j < 8; ++j) { const float g = gelu_tanh(row[lane + 64 * j]); ss += g * g; }
        ss = wave_sum(ss); if (lane == 0) SGR[t] = __builtin_amdgcn_rsqf(ss * (1.f / 512.f) + EPS); }
}
__device__ __forceinline__ void sg_mix_unit(const LayerW& w, const float* P, const float* SGR, bf16_t* YB, int c, int g, LAS float* sm) {
    const int tid = tid_opaque(); LAS float* Wl = sm; LAS float* vn = sm + 16384;
    __syncthreads();
    for (int i = tid; i < 16384; i += 512) Wl[i] = w.sgws()[(size_t)g * 16384 + i];
    for (int i = tid; i < 8192; i += 512) { const int s = i >> 6, cc = i & 63; const int t = c * 128 + s;
        vn[i] = gelu_tanh(P[(size_t)t * NPC + 1024 + g * 64 + cc]) * SGR[t] * w.sgvn()[g * 64 + cc]; }
    __syncthreads();
    const int cc = tid & 63, tq = tid >> 6;
    for (int tt = 0; tt < 16; ++tt) { const int tl = tq + 8 * tt; float acc = 0.f;
        for (int s = 0; s <= tl; ++s) acc += Wl[tl * 128 + s] * vn[s * 64 + cc];
        const int t = c * 128 + tl; const float mixed = acc + w.sgbs()[g * 128 + tl]; const float uu = gelu_tanh(P[(size_t)t * NPC + 512 + g * 64 + cc]);
        YB[(size_t)t * 512 + g * 64 + cc] = (bf16_t)f2bf(uu * mixed); }
}

struct RwArr { float *R, *W, *KX, *VV, *A, *B, *GG, *BN; };
__device__ __forceinline__ void rw_prep_unit(const LayerW& w, int L, const float* P, float* VF, const RwArr& ar, int tb, int rb, LAS float* sm) {
    const int tid = tid_opaque();
    LAS float* xs = sm; LAS float* t1 = sm + 14336; LAS float* kkp = sm + 14592; LAS float* rkp = sm + 18688; LAS float* hs = sm + 22784;
    __syncthreads();
    for (int i = tid; i < 8 * RWC; i += 512) { const int j = i / RWC, c = i - j * RWC, t = tb + j;
        const float cur = P[(size_t)t * NPC + 1536 + c], prev = t > 0 ? P[(size_t)(t - 1) * NPC + 1536 + c] : 0.f;
        xs[i] = cur + (prev - cur) * w.mu()[c]; }
    __syncthreads();
    { const int j = tid >> 6, ii = tid & 63; xs[j * RWC + 1536 + ii] = tanhf(xs[j * RWC + 1536 + ii]);
      xs[j * RWC + 1664 + ii] = sigmoidf_(xs[j * RWC + 1664 + ii]); xs[j * RWC + 1728 + ii] = sigmoidf_(xs[j * RWC + 1728 + ii]); }
    if (L > 0 && tid < 256) { const int j = tid >> 5, r = tid & 31; float acc = 0.f;
        for (int c = 0; c < 512; ++c) acc += xs[j * RWC + 1024 + c] * w.v1()[c * 32 + r];
        t1[j * 32 + r] = acc; }
    __syncthreads();
    const int n = tid; float aw[8], aa[8], ag[8];
#pragma unroll
    for (int j = 0; j < 8; ++j) { aw[j] = 0.f; aa[j] = 0.f; ag[j] = 0.f; }
    for (int i = 0; i < 64; ++i) { const float x2 = w.w2()[i * 512 + n], y2 = w.a2()[i * 512 + n];
#pragma unroll
        for (int j = 0; j < 8; ++j) { aw[j] += xs[j * RWC + 1536 + i] * x2; aa[j] += xs[j * RWC + 1600 + i] * y2; } }
    for (int i = 0; i < 128; ++i) { const float z2 = w.g2()[i * 512 + n];
#pragma unroll
        for (int j = 0; j < 8; ++j) ag[j] += xs[j * RWC + 1664 + i] * z2; }
    float av[8], vv[8];
#pragma unroll
    for (int j = 0; j < 8; ++j) {
        const int t = tb + j; const size_t gr = (size_t)(rb + t), o = (size_t)t * 512 + n;
        const float wpre = w.w0()[n] + aw[j]; const float xn = -wpre; const float sp = fmaxf(xn, 0.f) + log1pf(__expf(-fabsf(xn)));
        const float wl = -sp - 0.5f; const float decay = __expf(-__expf(wl));
        const float a = sigmoidf_(w.a0()[n] + aa[j]);
        const float r = xs[j * RWC + n], k = xs[j * RWC + 512 + n]; float v = xs[j * RWC + 1024 + n];
        if (L == 0) VF[gr * 512 + n] = v;
        else { float acc = w.v0()[n];
#pragma unroll 8
            for (int q = 0; q < 32; ++q) acc += t1[j * 32 + q] * w.v2()[q * 512 + n];
            const float vf = VF[gr * 512 + n]; v = v + (vf - v) * sigmoidf_(acc); }
        const float kx = k * (1.f + (a - 1.f) * w.ka()[n]);
        kkp[j * 512 + n] = k * w.kk()[n]; rkp[j * 512 + n] = r * kx * w.rk()[n];
        ar.R[o] = r; ar.W[o] = decay; ar.KX[o] = kx; ar.VV[o] = v; ar.GG[o] = ag[j];
        av[j] = a; vv[j] = v;
    }
    __syncthreads();
    if (tid < 64) { const int j = tid >> 3, h = tid & 7; float s1 = 0.f, s2 = 0.f;
        for (int c = 0; c < 64; ++c) { const float x = kkp[j * 512 + h * 64 + c]; s1 += x * x; s2 += rkp[j * 512 + h * 64 + c]; }
        hs[(j * 8 + h) * 2] = s1; hs[(j * 8 + h) * 2 + 1] = s2; }
    __syncthreads();
#pragma unroll
    for (int j = 0; j < 8; ++j) { const int h = n >> 6; const size_t o = (size_t)(tb + j) * 512 + n;
        const float rinv = __builtin_amdgcn_rsqf(fmaxf(hs[(j * 8 + h) * 2], 1e-24f)); const float kk = kkp[j * 512 + n] * rinv;
        ar.A[o] = -kk; ar.B[o] = kk * av[j]; ar.BN[o] = hs[(j * 8 + h) * 2 + 1] * vv[j]; }
}

__device__ __forceinline__ void rw_scan_row(const RwArr& ar, float* YR, int h, int i, int lane) {
    float S = 0.f; const int cb = h * 64;
    for (int t0 = 0; t0 < TB; t0 += 8) {
        float a[8], b[8], wd[8], kx[8], r[8], v[8];
#pragma unroll
        for (int j = 0; j < 8; ++j) { const size_t o = (size_t)(t0 + j) * 512 + cb;
            a[j] = ar.A[o + lane]; b[j] = ar.B[o + lane]; wd[j] = ar.W[o + lane]; kx[j] = ar.KX[o + lane]; r[j] = ar.R[o + lane]; v[j] = ar.VV[o + i]; }
#pragma unroll
        for (int j = 0; j < 8; ++j) {
            const float sa = wave_sum(S * a[j]);
            S = S * wd[j] + sa * b[j] + v[j] * kx[j];
            const float y = wave_sum(S * r[j]);
            if (lane == 0) YR[(size_t)(t0 + j) * 512 + cb + i] = y;
        }
    }
}
__device__ __forceinline__ void rw_out_unit(const LayerW& w, const float* YR, const RwArr& ar, bf16_t* YC, int tb, LAS float* sm) {
    const int tid = tid_opaque(), n = tid;
    __syncthreads();
    for (int j = 0; j < 8; ++j) sm[j * 512 + n] = YR[(size_t)(tb + j) * 512 + n];
    __syncthreads();
    const int hb = n & ~63;
    for (int j = 0; j < 8; ++j) { float mean = 0.f;
        for (int c = 0; c < 64; ++c) mean += sm[j * 512 + hb + c];
        mean *= (1.f / 64.f); float var = 0.f;
        for (int c = 0; c < 64; ++c) { const float d = sm[j * 512 + hb + c] - mean; var += d * d; }
        var *= (1.f / 64.f);
        const size_t o = (size_t)(tb + j) * 512 + n;
        const float y = (sm[j * 512 + n] - mean) * __builtin_amdgcn_rsqf(var + 64e-5f) * w.lng()[n] + w.lnb()[n];
        YC[o] = (bf16_t)f2bf((y + ar.BN[o]) * ar.GG[o]); }
}
constexpr int LDS_BYTES = 147456;
constexpr int PH_PER_LAYER = 33, N_PHASES = DEPTH * PH_PER_LAYER;

#define WSP(T_, off) ((T_*)(ap->ws + (off)))
__device__ __forceinline__ RwArr rw_arr(float* o) { RwArr ar; const size_t st = (size_t)TB * 512; ar.R = o; ar.W = o + st; ar.KX = o + 2 * st; ar.VV = o + 3 * st; ar.A = o + 4 * st; ar.B = o + 5 * st; ar.GG = o + 6 * st; ar.BN = o + 7 * st; return ar; }
__device__ __forceinline__ void run_phase(CArgs* ap, int ph, unsigned char* lds_g) {
    LAS unsigned char* lds = (LAS unsigned char*)lds_g; LAS float* smf = (LAS float*)lds_g;
    const int tid = tid_opaque(), lane = tid & 63, wave = __builtin_amdgcn_readfirstlane(tid >> 6);
    const int G = gridDim.x, bid = blockIdx.x; const int gw = bid * 8 + wave, NGW = G * 8;
    const int L = ph / PH_PER_LAYER, s = ph % PH_PER_LAYER;
    pg8::StaticOrder S;
    if (s == 0) {
        const LayerW w{ap, L};
        conv_weights(w, WSP(bf16_t, WS_W), smf + wave * 2112, gw, NGW, lane);
        if (L == 0) { init_rows((const float*)ap->in[0], WSP(bf16_t, WS_HHI), WSP(bf16_t, WS_HLO), WSP(float, WS_SSQ), gw, NGW, lane);
                      init_rope((const int*)ap->in[1], WSP(float, WS_ROPE), WSP(float, WS_ROPE) + (size_t)T * 16, bid * 512 + tid, G * 512); }
    } else if (s == 1 || s == 31) {
        pg8::Gemm g{WSP(bf16_t, WS_HHI), WSP(bf16_t, WS_W) + (s == 1 ? OW_W1GU1 : OW_W1GU2), DM, DM, T, 2 * FF, DM}; S.init(T, 2 * FF, G, bid);
        EpiUp E{WSP(bf16_t, WS_ACT), WSP(float, WS_SSQ)}; pg8::gemm_phase<EpiUp, pg8::StaticOrder, true, true>(lds, g, S, E);
    } else if (s == 2 || s == 32) {
        pg8::Gemm g{WSP(bf16_t, WS_ACT), WSP(bf16_t, WS_W) + (s == 2 ? OW_W2_1 : OW_W2_2), FF, FF, T, DM, FF}; S.init(T, DM, G, bid);
        EpiRes E{WSP(bf16_t, WS_HHI), WSP(bf16_t, WS_HLO), WSP(float, WS_SSQ), 0.5f, (s == 32 && L == DEPTH - 1) ? ap->out : nullptr}; pg8::gemm_phase<EpiRes, pg8::StaticOrder, true, true>(lds, g, S, E);
    } else {
        const int b = (s - 3) / 7, st = (s - 3) % 7, rb = b * TB;
        if (st == 0) {
#ifndef MK_SKIP_P
            { pg8::Gemm g{WSP(bf16_t, WS_HHI) + (size_t)rb * DM, WSP(bf16_t, WS_W) + OW_WIN, DM, DM, TB, NPC, DM}; S.init(TB, NPC, G, bid);
              EpiP E{WSP(float, WS_P), NPC, WSP(float, WS_SSQ) + (size_t)rb * 16}; pg8::gemm_phase<EpiP, pg8::StaticOrder, true, true>(lds, g, S, E); }
#endif
#ifndef MK_SKIP_G
            { pg8::Gemm g{WSP(bf16_t, WS_HHI) + (size_t)rb * DM, WSP(bf16_t, WS_W) + OW_WIN + (size_t)NPC * DM, DM, DM, TB, NGC, DM}; S.init(TB, NGC, G, bid);
              EpiG E{WSP(bf16_t, WS_G), WSP(float, WS_SSQ) + (size_t)rb * 16}; pg8::gemm_phase<EpiG, pg8::StaticOrder, true, true>(lds, g, S, E); }
#endif
        } else if (st == 1) {
            { const LayerW w{ap, L};
              for (int u = bid; u < TB / 8; u += G) mla_unit(w, WSP(float, WS_P), WSP(float, WS_ROPE), WSP(float, WS_ROPE) + (size_t)T * 16, WSP(float, WS_Q), WSP(float, WS_K), WSP(float, WS_V), u * 8, rb, smf); }
            sg_rstd_rows(WSP(float, WS_P), WSP(float, WS_MISC), gw, NGW, lane);
            { const LayerW w{ap, L}; const RwArr ar = rw_arr(ap->out);
              for (int u = bid; u < TB / 8; u += G) rw_prep_unit(w, L, WSP(float, WS_P), WSP(float, WS_VF), ar, u * 8, rb, smf); }
        } else if (st == 2) {
            for (int u = bid; u < 64; u += G) attn_naive_unit(WSP(float, WS_Q), WSP(float, WS_K), WSP(float, WS_V), WSP(bf16_t, WS_YA), u >> 3, 7 - (u & 7), smf);
            { const LayerW w{ap, L};
              for (int u = bid; u < 256; u += G) sg_mix_unit(w, WSP(float, WS_P), WSP(float, WS_MISC), WSP(bf16_t, WS_YB), u >> 3, u & 7, smf); }
        } else if (st == 3) {
            const RwArr ar = rw_arr(ap->out);
            for (int r = gw; r < 512; r += NGW) rw_scan_row(ar, WSP(float, WS_Q), r >> 6, r & 63, lane);
        } else if (st == 4) {
            const LayerW w{ap, L}; const RwArr ar = rw_arr(ap->out);
            for (int u = bid; u < TB / 8; u += G) rw_out_unit(w, WSP(float, WS_Q), ar, WSP(bf16_t, WS_K), u * 8, smf);
        } else if (st == 5) {
            for (int i = 0; i < 3; ++i) {
                const bf16_t* Y = i == 0 ? WSP(bf16_t, WS_YA) : i == 1 ? WSP(bf16_t, WS_YB) : WSP(bf16_t, WS_K);
                pg8::Gemm g{Y, WSP(bf16_t, WS_W) + OW_WOUT + i * 512, 512, 1536, TB, DM, 512}; S.init(TB, DM, G, bid);
                EpiMerge E{WSP(bf16_t, WS_G) + i * DM, WSP(float, WS_P), WSP(bf16_t, WS_P + 32 * MiB), i}; pg8::gemm_phase<EpiMerge, pg8::StaticOrder, true, true>(lds, g, S, E);
            }
        } else {
            pg8::Gemm g{WSP(bf16_t, WS_P + 32 * MiB), WSP(bf16_t, WS_W) + OW_WO, DM, DM, TB, DM, DM}; S.init(TB, DM, G, bid);
            EpiRes E{WSP(bf16_t, WS_HHI) + (size_t)rb * DM, WSP(bf16_t, WS_HLO) + (size_t)rb * DM, WSP(float, WS_SSQ) + (size_t)rb * 16, 1.0f, nullptr}; pg8::gemm_phase<EpiRes, pg8::StaticOrder, true, true>(lds, g, S, E);
        }
    }
}

#ifdef MK_STOP
__device__ __forceinline__ void dump_phase(CArgs* ap, int which) {
    const int gt = blockIdx.x * 512 + tid_opaque(), NT = gridDim.x * 512;
    const bf16_t* HHI = WSP(bf16_t, WS_HHI); const bf16_t* HLO = WSP(bf16_t, WS_HLO);
    float* chk = WSP(float, WS_SSQ);
    if (which == 0) {
        const RwArr ar = rw_arr(ap->out);
        for (int i = gt; i < TB * 16; i += NT) { const int row = i >> 4, c = i & 15; float s = 0.f;
            for (int k = 0; k < 32; ++k) { const size_t o = (size_t)row * 512 + c * 32 + k; s += ar.R[o] + ar.W[o] + ar.KX[o] + ar.VV[o] + ar.A[o] + ar.B[o] + ar.GG[o] + ar.BN[o]; }
            chk[i] = s; }
    } else {
        const float* P = WSP(float, WS_P); const bf16_t* G = WSP(bf16_t, WS_G); const float* Q = WSP(float, WS_Q); const float* K = WSP(float, WS_K); const float* V = WSP(float, WS_V);
        const bf16_t* YA = WSP(bf16_t, WS_YA); const bf16_t* YB = WSP(bf16_t, WS_YB);
        for (size_t i = gt; i < (size_t)T * DM; i += NT) { const int row = (int)(i >> 10), c = (int)(i & 1023);
            float v = bf2f(HHI[i]) + bf2f(HLO[i]);
#if MK_DUMP_MASK & 16
            v += chk[row * 16 + (c & 15)] * 1e-3f;
            if (i < (size_t)6400 * 1024) v += bf2f(WSP(bf16_t, WS_W)[OW_WIN + i]);
#endif
            if (row < TB) {
#if MK_DUMP_MASK & 1
#ifndef MK_SKIP_P
                v += P[(size_t)row * NPC + c] + P[(size_t)row * NPC + 1024 + c] + P[(size_t)row * NPC + 2048 + c] + (c < 256 ? P[(size_t)row * NPC + 3072 + c] : 0.f);
#endif
#ifndef MK_SKIP_G
                v += bf2f(G[(size_t)row * NGC + c]) + bf2f(G[(size_t)row * NGC + 1024 + c]) + bf2f(G[(size_t)row * NGC + 2048 + c]);
#endif
#endif
#if MK_DUMP_MASK & 2
                v += Q[(size_t)row * 768 + (c % 768)] + K[(size_t)row * 768 + (c % 768)] + V[(size_t)row * 512 + (c & 511)];
#endif
#if MK_DUMP_MASK & 4
                v += bf2f(YA[(size_t)row * 512 + (c & 511)]) + bf2f(YB[(size_t)row * 512 + (c & 511)]);
#endif
#if MK_DUMP_MASK & 8
                v += chk[row * 16 + (c & 15)];
#endif
            }
            ap->out[i] = v; }
    }
}
#endif
__global__ void __launch_bounds__(512, 2) mk_fwd(Args a) {
    extern __shared__ __attribute__((aligned(16))) unsigned char lds[];
    cg::grid_group grid = cg::this_grid();
    CArgs* ap0 = (CArgs*)__builtin_amdgcn_kernarg_segment_ptr();
    const int ph_lo = ap0->ph_lo, ph_hi = ap0->ph_hi;
    for (int ph = ph_lo; ph < ph_hi; ++ph) {
        CArgs* ap = ap0; asm volatile("" : "+s"(ap));
#ifdef MK_STOP
        if (ph >= 1000) dump_phase(ap, ph - 1000); else
#endif
        run_phase(ap, ph, lds);
        if (ph + 1 < ph_hi) grid.sync();
    }
}

#ifndef MK_ONE_LAUNCH
#define MK_ONE_LAUNCH 0
#endif
extern "C" void kernel_launch(void* const* d_in, const int* in_sizes, int n_in, void* d_out, int out_size, void* d_ws, size_t ws_size, hipStream_t stream) {
    static int grid = 0;
    if (grid == 0) {
        if (n_in != 39 || out_size != T * DM || ws_size < WS_END) { fprintf(stderr, "kernel_launch: unexpected shapes (n_in %d out %d ws %zu)\n", n_in, out_size, ws_size); grid = -1; return; }
        int dev = 0, cus = 0, per_cu = 0;
        hipGetDevice(&dev); hipDeviceGetAttribute(&cus, hipDeviceAttributeMultiprocessorCount, dev);
        hipFuncSetAttribute((const void*)mk_fwd, hipFuncAttributeMaxDynamicSharedMemorySize, LDS_BYTES);
        hipOccupancyMaxActiveBlocksPerMultiprocessor(&per_cu, (const void*)mk_fwd, 512, LDS_BYTES);
        if (per_cu < 1) { fprintf(stderr, "kernel_launch: occupancy query says %d blocks per CU\n", per_cu); per_cu = 1; }
        (void)hipGetLastError();
        grid = cus * 1;
    }
    if (grid < 0) return;
    Args a{};
    for (int i = 0; i < 39; ++i) a.in[i] = d_in[i];
    a.out = (float*)d_out; a.ws = (unsigned char*)d_ws;
#if MK_ONE_LAUNCH
    a.ph_lo = 0; a.ph_hi = N_PHASES;
    void* args[] = {&a};
    hipError_t e = hipLaunchCooperativeKernel((const void*)mk_fwd, dim3(grid), dim3(512), args, LDS_BYTES, stream);
    if (e != hipSuccess) fprintf(stderr, "cooperative launch failed: %s (grid %d)\n", hipGetErrorString(e), grid);
#else
#ifdef MK_STOP
    for (int ph = 0; ph < MK_STOP; ++ph) { a.ph_lo = ph; a.ph_hi = ph + 1; hipLaunchKernelGGL(mk_fwd, dim3(grid), dim3(512), LDS_BYTES, stream, a); }
    if (MK_DUMP_MASK & 8) { a.ph_lo = 1000; a.ph_hi = 1001; hipLaunchKernelGGL(mk_fwd, dim3(grid), dim3(512), LDS_BYTES, stream, a); }
    a.ph_lo = 1001; a.ph_hi = 1002; hipLaunchKernelGGL(mk_fwd, dim3(grid), dim3(512), LDS_BYTES, stream, a);
#else
    for (int ph = 0; ph < N_PHASES; ++ph) { a.ph_lo = ph; a.ph_hi = ph + 1; hipLaunchKernelGGL(mk_fwd, dim3(grid), dim3(512), LDS_BYTES, stream, a); }
#endif
#endif
}
```

```cpp
#include <hip/hip_runtime.h>
#include <hip/hip_cooperative_groups.h>
#include <cstdio>
#include <cstdint>
#include <cmath>
namespace cg = cooperative_groups;
__device__ __forceinline__ int tid_opaque() { int t = threadIdx.x; asm volatile("" : "+v"(t)); return t; }
namespace pg8 {
#define PG8_LAS __attribute__((address_space(3)))
typedef unsigned short bf16_t;
typedef short bf16x8 __attribute__((ext_vector_type(8)));
typedef float f32x4 __attribute__((ext_vector_type(4)));
typedef float f32x2 __attribute__((ext_vector_type(2)));
typedef unsigned u32x4 __attribute__((ext_vector_type(4)));
typedef unsigned u32x2 __attribute__((ext_vector_type(2)));
constexpr int BM = 256, BK = 64, HALF = 128, HTB = HALF * BK * 2, STAGE_BYTES = 8 * HTB, NXCD = 8, WGM = 8;

__host__ __device__ __forceinline__ int lds_byte(int r, int c) { const int st = (r >> 4) * 2 + (c >> 5), rr = r & 15, cc = c & 31, ob = rr * 64 + cc * 2; return st * 1024 + (ob ^ (((ob >> 9) & 1) << 5)); }
__host__ __device__ __forceinline__ void stage_rc(int b, int& R, int& C) { const int st = b / 1024, sb = b % 1024, swz = sb ^ (((sb >> 9) & 1) << 5); R = (st >> 1) * 16 + swz / 64; C = (st & 1) * 32 + (swz % 64) / 2; }
__host__ __device__ __forceinline__ int perm32(int rho) { const int n = rho >> 4, i = rho & 15; return 8 * (i >> 2) + 4 * n + (i & 3); }

struct Unit { int pm, pn; };
struct Gemm { const bf16_t* A; const bf16_t* Bt; int lda, ldb; int M, N, K; };

struct StaticOrder {
    int nM, nN, nwg, G, c;
    __host__ __device__ void init(int M, int N, int G_, int c_) { nM = M / BM; nN = N / BM; nwg = nM * nN; G = G_; c = c_; }
    __host__ __device__ bool next(int i, Unit& u) const {
        const long L = (long)i * G + c; if (L >= nwg) return false;
        int wgid = (int)L; { const int q = nwg / NXCD, r = nwg % NXCD, xcd = wgid % NXCD, off = wgid / NXCD; wgid = (xcd < r ? xcd * (q + 1) : r * (q + 1) + (xcd - r) * q) + off; }
        const int nig = WGM * nN, gid = wgid / nig, fm = gid * WGM, gsz = (nM - fm) < WGM ? (nM - fm) : WGM;
        u.pm = fm + ((wgid % nig) % gsz); u.pn = (wgid % nig) / gsz; return true;
    }
    __device__ __forceinline__ void a_ready(const Unit&) const {}
    __device__ __forceinline__ void done(const Unit&) const {}
};

typedef __bf16 bf16x2_t __attribute__((ext_vector_type(2)));
__device__ __forceinline__ unsigned cvt_pk_bf16(float lo, float hi) { f32x2 v = {lo, hi}; bf16x2_t b = __builtin_convertvector(v, bf16x2_t); return __builtin_bit_cast(unsigned, b); }

template <class Epi, class Sched, bool ALIGN_EPI = false, bool SP2 = false>
__device__ __forceinline__ void gemm_phase(PG8_LAS unsigned char* lds, const Gemm g, const Sched& S, const Epi& E) {
    const int tid = tid_opaque(), wid = __builtin_amdgcn_readfirstlane(tid >> 6), lane = tid & 63, wr = wid >> 2, wc = wid & 3, fr = lane & 15, fq = lane >> 4;
    const int K = g.K, nt = K / BK;
    unsigned voffA[2], voffB[2];
#pragma unroll
    for (int i = 0; i < 2; ++i) { int R, C; stage_rc(tid * 16 + i * 8192, R, C); const int Rb = Epi::PERM ? ((R & ~31) + perm32(R & 31)) : R;
        voffA[i] = (unsigned)(R * g.lda + C) * 2u; voffB[i] = (unsigned)(Rb * g.ldb + C) * 2u; }
    const size_t kstep = (size_t)(BK * 2);
    const size_t hstepA = (size_t)HALF * g.lda * 2, hstepB = (size_t)HALF * g.ldb * 2;
    const size_t tstepA = 2 * hstepA, tstepB = 2 * hstepB;
    const unsigned ldsw = (unsigned)wid * 1024u;
    const int aoff = lds_byte(wr * 64 + fr, fq * 8), boff = lds_byte(wc * 32 + fr, fq * 8);
#define PG8_SA(b, h) (((b) * 2 + (h)) * HTB)
#define PG8_SB(b, h) ((4 + (b) * 2 + (h)) * HTB)
#define PG8_STAGE(bufoff, gbase, voff) do { _Pragma("unroll") for (int _i = 0; _i < 2; ++_i) \
        __builtin_amdgcn_global_load_lds((const unsigned*)((const char*)(gbase) + (voff)[_i]), (PG8_LAS unsigned*)(lds + (bufoff) + ldsw + _i * 8192), 16, 0, 0); } while (0)
#define PG8_LDA(dst, b, h) do { _Pragma("unroll") for (int m = 0; m < 4; ++m) _Pragma("unroll") for (int k = 0; k < 2; ++k) dst[m][k] = *(const PG8_LAS bf16x8*)(lds + PG8_SA(b, h) + aoff + m * 2048 + k * 1024); } while (0)
#define PG8_LDB(dst, b, h) do { _Pragma("unroll") for (int n = 0; n < 2; ++n) _Pragma("unroll") for (int k = 0; k < 2; ++k) dst[n][k] = *(const PG8_LAS bf16x8*)(lds + PG8_SB(b, h) + boff + n * 2048 + k * 1024); } while (0)
#define PG8_MMA(ai, bj, At, Bt) do { __builtin_amdgcn_s_setprio(1); _Pragma("unroll") for (int m = 0; m < 4; ++m) _Pragma("unroll") for (int n = 0; n < 2; ++n) _Pragma("unroll") for (int k = 0; k < 2; ++k) \
        acc[ai][bj][m][n] = __builtin_amdgcn_mfma_f32_16x16x32_bf16(Bt[n][k], At[m][k], acc[ai][bj][m][n], 0, 0, 0); __builtin_amdgcn_s_setprio(0); } while (0)
#define PG8_WAIT_V(n) asm volatile("s_waitcnt vmcnt(" #n ")" ::: "memory")
#define PG8_WAIT_L(n) asm volatile("s_waitcnt lgkmcnt(" #n ")" ::: "memory")
#define PG8_BAR __builtin_amdgcn_s_barrier()
#define PG8_SCHED __builtin_amdgcn_sched_barrier(0)
    Unit cur, nxt; int ui = 0;
    if (!S.next(0, cur)) return;
    f32x4 acc[2][2][4][2];
#pragma unroll
    for (int a = 0; a < 2; ++a)
#pragma unroll
        for (int b = 0; b < 2; ++b)
#pragma unroll
            for (int m = 0; m < 4; ++m)
#pragma unroll
                for (int n = 0; n < 2; ++n) acc[a][b][m][n] = (f32x4){0.f, 0.f, 0.f, 0.f};
    bf16x8 At[4][2], B0[2][2], B1[2][2];
    const char* cA = (const char*)g.A + (size_t)cur.pm * tstepA; const char* cB = (const char*)g.Bt + (size_t)cur.pn * tstepB;
    S.a_ready(cur);
    if constexpr (SP2) {
        PG8_STAGE(PG8_SB(0, 0), cB, voffB); PG8_STAGE(PG8_SB(0, 1), cB + hstepB, voffB); PG8_STAGE(PG8_SA(0, 0), cA, voffA); PG8_STAGE(PG8_SA(0, 1), cA + hstepA, voffA);
        if (wr == 1) PG8_BAR;
        PG8_WAIT_V(2); PG8_BAR;
        PG8_STAGE(PG8_SB(1, 0), cB + kstep, voffB); PG8_STAGE(PG8_SA(1, 0), cA + kstep, voffA); PG8_STAGE(PG8_SB(1, 1), cB + hstepB + kstep, voffB);
        PG8_WAIT_V(6); PG8_BAR;
    } else {
        PG8_STAGE(PG8_SB(0, 0), cB, voffB); PG8_STAGE(PG8_SA(0, 0), cA, voffA); PG8_STAGE(PG8_SB(0, 1), cB + hstepB, voffB); PG8_STAGE(PG8_SA(0, 1), cA + hstepA, voffA);
        if (wr == 1) PG8_BAR;
        PG8_WAIT_V(4); PG8_BAR;
        PG8_STAGE(PG8_SB(1, 0), cB + kstep, voffB); PG8_STAGE(PG8_SA(1, 0), cA + kstep, voffA); PG8_STAGE(PG8_SB(1, 1), cB + hstepB + kstep, voffB);
        PG8_WAIT_V(6); PG8_BAR;
    }
    for (;;) {
        const bool has_next = S.next(ui + 1, nxt);
        const char* nA = has_next ? (const char*)g.A + (size_t)nxt.pm * tstepA : cA; const char* nB = has_next ? (const char*)g.Bt + (size_t)nxt.pn * tstepB : cB;
        for (int t = 0; t < nt; t += 2) {
            const bool last = (t == nt - 2);
            const char* a1 = cA + (size_t)(t + 1) * kstep;
            const char* a2 = last ? nA : cA + (size_t)(t + 2) * kstep; const char* b2 = last ? nB : cB + (size_t)(t + 2) * kstep;
            const char* a3 = a2 + kstep; const char* b3 = b2 + kstep;
            if (last && has_next) S.a_ready(nxt);
            if constexpr (SP2) {
            PG8_LDB(B0, 0, 0); PG8_LDB(B1, 0, 1); PG8_SCHED; PG8_LDA(At, 0, 0); PG8_STAGE(PG8_SA(1, 1), a1 + hstepA, voffA);
            PG8_WAIT_V(8); PG8_WAIT_L(0); PG8_BAR; PG8_MMA(0, 0, At, B0); PG8_MMA(0, 1, At, B1); PG8_BAR; PG8_SCHED;
            PG8_LDA(At, 0, 1); PG8_STAGE(PG8_SB(0, 0), b2, voffB); PG8_STAGE(PG8_SB(0, 1), b2 + hstepB, voffB); PG8_STAGE(PG8_SA(0, 0), a2, voffA);
            PG8_WAIT_V(8); PG8_WAIT_L(0); PG8_BAR; PG8_MMA(1, 0, At, B0); PG8_MMA(1, 1, At, B1); PG8_BAR; PG8_SCHED;
            PG8_LDB(B0, 1, 0); PG8_LDB(B1, 1, 1); PG8_SCHED; PG8_LDA(At, 1, 0); PG8_STAGE(PG8_SA(0, 1), a2 + hstepA, voffA);
            PG8_WAIT_V(8); PG8_WAIT_L(0); PG8_BAR; PG8_MMA(0, 0, At, B0); PG8_MMA(0, 1, At, B1); PG8_BAR; PG8_SCHED;
            PG8_LDA(At, 1, 1); PG8_STAGE(PG8_SB(1, 0), b3, voffB); PG8_STAGE(PG8_SB(1, 1), b3 + hstepB, voffB); PG8_STAGE(PG8_SA(1, 0), a3, voffA);
            PG8_WAIT_V(8); PG8_WAIT_L(0); PG8_BAR; PG8_MMA(1, 0, At, B0); PG8_MMA(1, 1, At, B1); PG8_BAR; PG8_SCHED;
            } else {
            PG8_LDB(B0, 0, 0); PG8_SCHED; PG8_LDA(At, 0, 0); PG8_STAGE(PG8_SA(1, 1), a1 + hstepA, voffA);
            PG8_WAIT_L(8); PG8_BAR; PG8_WAIT_L(0); PG8_MMA(0, 0, At, B0); PG8_BAR; PG8_SCHED;
            PG8_LDB(B1, 0, 1); PG8_STAGE(PG8_SB(0, 0), b2, voffB);
            PG8_BAR; PG8_WAIT_L(0); PG8_MMA(0, 1, At, B1); PG8_BAR;
            PG8_LDA(At, 0, 1); PG8_STAGE(PG8_SA(0, 0), a2, voffA);
            PG8_BAR; PG8_WAIT_L(0); PG8_MMA(1, 0, At, B0); PG8_BAR; PG8_SCHED;
            PG8_STAGE(PG8_SB(0, 1), b2 + hstepB, voffB);
            PG8_WAIT_V(6); PG8_BAR; PG8_MMA(1, 1, At, B1); PG8_BAR;
            PG8_LDB(B0, 1, 0); PG8_SCHED; PG8_LDA(At, 1, 0); PG8_STAGE(PG8_SA(0, 1), a2 + hstepA, voffA);
            PG8_WAIT_L(8); PG8_BAR; PG8_WAIT_L(0); PG8_MMA(0, 0, At, B0); PG8_BAR; PG8_SCHED;
            PG8_LDB(B1, 1, 1); PG8_STAGE(PG8_SB(1, 0), b3, voffB);
            PG8_BAR; PG8_WAIT_L(0); PG8_MMA(0, 1, At, B1); PG8_BAR;
            PG8_LDA(At, 1, 1); PG8_STAGE(PG8_SA(1, 0), a3, voffA);
            PG8_BAR; PG8_WAIT_L(0); PG8_MMA(1, 0, At, B0); PG8_BAR; PG8_SCHED;
            PG8_STAGE(PG8_SB(1, 1), b3 + hstepB, voffB);
            PG8_WAIT_V(6); PG8_BAR; PG8_MMA(1, 1, At, B1); PG8_BAR;
            }
        }
        if constexpr (ALIGN_EPI) { if (wr == 0) PG8_BAR; }
        E(acc, cur, wr, wc, fr, fq); S.done(cur);
        if (!has_next) break;
#pragma unroll
        for (int a = 0; a < 2; ++a)
#pragma unroll
            for (int b = 0; b < 2; ++b)
#pragma unroll
                for (int m = 0; m < 4; ++m)
#pragma unroll
                    for (int n = 0; n < 2; ++n) acc[a][b][m][n] = (f32x4){0.f, 0.f, 0.f, 0.f};
        cur = nxt; cA = nA; cB = nB; ++ui;
        if constexpr (ALIGN_EPI) { if (wr == 1) PG8_BAR; }
    }
    PG8_WAIT_V(0);
    if constexpr (!ALIGN_EPI) { if (wr == 0) PG8_BAR; }
    PG8_BAR;
#undef PG8_SA
#undef PG8_SB
#undef PG8_STAGE
#undef PG8_LDA
#undef PG8_LDB
#undef PG8_MMA
#undef PG8_WAIT_V
#undef PG8_WAIT_L
#undef PG8_BAR
#undef PG8_SCHED
}
struct MUnit { int pm, pn, kind; };
__device__ __forceinline__ const char* uni64(const void* p) { const unsigned long long v = (unsigned long long)p; const unsigned lo = __builtin_amdgcn_readfirstlane((unsigned)v), hi = __builtin_amdgcn_readfirstlane((unsigned)(v >> 32)); return (const char*)(((unsigned long long)hi << 32) | lo); }
__device__ __forceinline__ int uni32(int v) { return __builtin_amdgcn_readfirstlane(v); }
struct MDesc { const bf16_t* A; const bf16_t* Bt; int lda, ldb, nt; };
template <class Epi, class Sched, bool ALIGN_EPI = false>
__device__ __forceinline__ void gemm_multi(PG8_LAS unsigned char* lds, const Sched& S, const Epi& E) {
    const int tid = tid_opaque(), wid = __builtin_amdgcn_readfirstlane(tid >> 6), lane = tid & 63, wr = wid >> 2, wc = wid & 3, fr = lane & 15, fq = lane >> 4;
    unsigned vA1[2], sA[2], sB[2];
#define PG8_SETV(vA, vB, lda_, ldb_) do { _Pragma("unroll") for (int _i = 0; _i < 2; ++_i) { int _R, _C; stage_rc(tid * 16 + _i * 8192, _R, _C); const int _Rb = Epi::PERM ? ((_R & ~31) + perm32(_R & 31)) : _R; \
        vA[_i] = (unsigned)(_R * (lda_) + _C) * 2u; vB[_i] = (unsigned)(_Rb * (ldb_) + _C) * 2u; } } while (0)
    const size_t kstep = (size_t)(BK * 2);
    const unsigned ldsw = (unsigned)wid * 1024u;
    const int aoff = lds_byte(wr * 64 + fr, fq * 8), boff = lds_byte(wc * 32 + fr, fq * 8);
#define PG8_SA(b, h) (((b) * 2 + (h)) * HTB)
#define PG8_SB(b, h) ((4 + (b) * 2 + (h)) * HTB)
#define PG8_STG(bufoff, gbase, voff) do { _Pragma("unroll") for (int _i = 0; _i < 2; ++_i) \
        __builtin_amdgcn_global_load_lds((const unsigned*)((const char*)(gbase) + (voff)[_i]), (PG8_LAS unsigned*)(lds + (bufoff) + ldsw + _i * 8192), 16, 0, 0); } while (0)
#define PG8_LDA(dst, b, h) do { _Pragma("unroll") for (int m = 0; m < 4; ++m) _Pragma("unroll") for (int k = 0; k < 2; ++k) dst[m][k] = *(const PG8_LAS bf16x8*)(lds + PG8_SA(b, h) + aoff + m * 2048 + k * 1024); } while (0)
#define PG8_LDB(dst, b, h) do { _Pragma("unroll") for (int n = 0; n < 2; ++n) _Pragma("unroll") for (int k = 0; k < 2; ++k) dst[n][k] = *(const PG8_LAS bf16x8*)(lds + PG8_SB(b, h) + boff + n * 2048 + k * 1024); } while (0)
#define PG8_MMA(ai, bj, At, Bt) do { __builtin_amdgcn_s_setprio(1); _Pragma("unroll") for (int m = 0; m < 4; ++m) _Pragma("unroll") for (int n = 0; n < 2; ++n) _Pragma("unroll") for (int k = 0; k < 2; ++k) \
        acc[ai][bj][m][n] = __builtin_amdgcn_mfma_f32_16x16x32_bf16(Bt[n][k], At[m][k], acc[ai][bj][m][n], 0, 0, 0); __builtin_amdgcn_s_setprio(0); } while (0)
#define PG8_WAIT_V(n) asm volatile("s_waitcnt vmcnt(" #n ")" ::: "memory")
#define PG8_WAIT_L(n) asm volatile("s_waitcnt lgkmcnt(" #n ")" ::: "memory")
#define PG8_BAR __builtin_amdgcn_s_barrier()
#define PG8_SCHED __builtin_amdgcn_sched_barrier(0)
    MUnit cur, nxt; int ui = 0;
    if (!S.next(0, cur)) return;
    MDesc dc = S.desc(cur.kind);
    PG8_SETV(sA, sB, dc.lda, dc.ldb); vA1[0] = sA[0]; vA1[1] = sA[1];
    f32x4 acc[2][2][4][2];
#pragma unroll
    for (int a = 0; a < 2; ++a)
#pragma unroll
        for (int b = 0; b < 2; ++b)
#pragma unroll
            for (int m = 0; m < 4; ++m)
#pragma unroll
                for (int n = 0; n < 2; ++n) acc[a][b][m][n] = (f32x4){0.f, 0.f, 0.f, 0.f};
    bf16x8 At[4][2], B0[2][2], B1[2][2];
    dc.lda = uni32(dc.lda); dc.ldb = uni32(dc.ldb); dc.nt = uni32(dc.nt);
    const char* cA = uni64((const char*)dc.A + (size_t)cur.pm * BM * dc.lda * 2); const char* cB = uni64((const char*)dc.Bt + (size_t)cur.pn * BM * dc.ldb * 2);
    { const size_t hA = (size_t)HALF * dc.lda * 2, hB = (size_t)HALF * dc.ldb * 2;
      PG8_STG(PG8_SB(0, 0), cB, sB); PG8_STG(PG8_SB(0, 1), cB + hB, sB); PG8_STG(PG8_SA(0, 0), cA, sA); PG8_STG(PG8_SA(0, 1), cA + hA, sA);
      if (wr == 1) PG8_BAR;
      PG8_WAIT_V(2); PG8_BAR;
      PG8_STG(PG8_SB(1, 0), cB + kstep, sB); PG8_STG(PG8_SA(1, 0), cA + kstep, sA); PG8_STG(PG8_SB(1, 1), cB + hB + kstep, sB);
      PG8_WAIT_V(6); PG8_BAR; }
    for (;;) {
        const bool has_next = S.next(ui + 1, nxt);
        MDesc dn = has_next ? S.desc(nxt.kind) : dc; dn.lda = uni32(dn.lda); dn.ldb = uni32(dn.ldb); dn.nt = uni32(dn.nt);
        const char* nA = uni64(has_next ? (const char*)dn.A + (size_t)nxt.pm * BM * dn.lda * 2 : cA); const char* nB = uni64(has_next ? (const char*)dn.Bt + (size_t)nxt.pn * BM * dn.ldb * 2 : cB);
        const size_t hA = (size_t)HALF * dc.lda * 2, hB = (size_t)HALF * dc.ldb * 2;
        const int nt = dc.nt;
        for (int t = 0; t < nt; t += 2) {
            const bool last = (t == nt - 2);
            const char* a1 = cA + (size_t)(t + 1) * kstep;
            const char* a2 = last ? nA : cA + (size_t)(t + 2) * kstep; const char* b2 = last ? nB : cB + (size_t)(t + 2) * kstep;
            const char* a3 = a2 + kstep; const char* b3 = b2 + kstep;
            const size_t hA2 = (size_t)HALF * (last ? dn.lda : dc.lda) * 2, hB2 = (size_t)HALF * (last ? dn.ldb : dc.ldb) * 2;
            if (last) PG8_SETV(sA, sB, dn.lda, dn.ldb);
            if (last && has_next) S.a_ready(nxt);
            PG8_LDB(B0, 0, 0); PG8_LDB(B1, 0, 1); PG8_SCHED; PG8_LDA(At, 0, 0); PG8_STG(PG8_SA(1, 1), a1 + hA, vA1);
            PG8_WAIT_V(8); PG8_WAIT_L(0); PG8_BAR; PG8_MMA(0, 0, At, B0); PG8_MMA(0, 1, At, B1); PG8_BAR; PG8_SCHED;
            PG8_LDA(At, 0, 1); PG8_STG(PG8_SB(0, 0), b2, sB); PG8_STG(PG8_SB(0, 1), b2 + hB2, sB); PG8_STG(PG8_SA(0, 0), a2, sA);
            PG8_WAIT_V(8); PG8_WAIT_L(0); PG8_BAR; PG8_MMA(1, 0, At, B0); PG8_MMA(1, 1, At, B1); PG8_BAR; PG8_SCHED;
            PG8_LDB(B0, 1, 0); PG8_LDB(B1, 1, 1); PG8_SCHED; PG8_LDA(At, 1, 0); PG8_STG(PG8_SA(0, 1), a2 + hA2, sA);
            PG8_WAIT_V(8); PG8_WAIT_L(0); PG8_BAR; PG8_MMA(0, 0, At, B0); PG8_MMA(0, 1, At, B1); PG8_BAR; PG8_SCHED;
            PG8_LDA(At, 1, 1); PG8_STG(PG8_SB(1, 0), b3, sB); PG8_STG(PG8_SB(1, 1), b3 + hB2, sB); PG8_STG(PG8_SA(1, 0), a3, sA);
            PG8_WAIT_V(8); PG8_WAIT_L(0); PG8_BAR; PG8_MMA(1, 0, At, B0); PG8_MMA(1, 1, At, B1); PG8_BAR; PG8_SCHED;
        }
        if constexpr (ALIGN_EPI) { if (wr == 0) PG8_BAR; }
        E(acc, cur, wr, wc, fr, fq); S.done(cur);
        if (!has_next) break;
#pragma unroll
        for (int a = 0; a < 2; ++a)
#pragma unroll
            for (int b = 0; b < 2; ++b)
#pragma unroll
                for (int m = 0; m < 4; ++m)
#pragma unroll
                    for (int n = 0; n < 2; ++n) acc[a][b][m][n] = (f32x4){0.f, 0.f, 0.f, 0.f};
        cur = nxt; cA = nA; cB = nB; ++ui; dc = dn; vA1[0] = sA[0]; vA1[1] = sA[1];
        if constexpr (ALIGN_EPI) { if (wr == 1) PG8_BAR; }
    }
    PG8_WAIT_V(0);
    if constexpr (!ALIGN_EPI) { if (wr == 0) PG8_BAR; }
    PG8_BAR;
#undef PG8_SA
#undef PG8_SB
#undef PG8_STG
#undef PG8_SETV
#undef PG8_LDA
#undef PG8_LDB
#undef PG8_MMA
#undef PG8_WAIT_V
#undef PG8_WAIT_L
#undef PG8_BAR
#undef PG8_SCHED
}
}
constexpr int BATCH = 4, SEQ = 4096, T = BATCH * SEQ, DM = 1024, FF = 2816, DEPTH = 2;
constexpr int NH = 8, QK = 96, NOPE = 64, ROPE = 32, VD = 64, QR = 256, KVR = 128;
constexpr int NPC = 3328;
constexpr int NGC = 3072;
constexpr int RWC = 1792;
constexpr float EPS = 1e-6f;

typedef unsigned short bf16_t;
typedef float f32x4 __attribute__((ext_vector_type(4)));
typedef float f32x2 __attribute__((ext_vector_type(2)));
typedef unsigned u32x4 __attribute__((ext_vector_type(4)));
typedef unsigned u32x2 __attribute__((ext_vector_type(2)));
#define LAS __attribute__((address_space(3)))

__device__ __forceinline__ float bf2f(unsigned short b) { return __uint_as_float(((unsigned)b) << 16); }
__device__ __forceinline__ float bflo(unsigned w) { return __uint_as_float(w << 16); }
__device__ __forceinline__ float bfhi(unsigned w) { return __uint_as_float(w & 0xffff0000u); }
__device__ __forceinline__ unsigned f2bf(float f) { unsigned u = __builtin_bit_cast(unsigned, f); return (u + 0x7fffu + ((u >> 16) & 1u)) >> 16; }
__device__ __forceinline__ unsigned pk2(float lo, float hi) { return f2bf(lo) | (f2bf(hi) << 16); }
typedef __bf16 bf16x2h __attribute__((ext_vector_type(2)));
__device__ __forceinline__ unsigned pk2h(float lo, float hi) { f32x2 v = {lo, hi}; bf16x2h b = __builtin_convertvector(v, bf16x2h); return __builtin_bit_cast(unsigned, b); }
__device__ __forceinline__ unsigned short f2bfh(float f) { return (unsigned short)(pk2h(f, f) & 0xffffu); }
__device__ __forceinline__ float wave_sum_dpp(float v) {
    v += __builtin_bit_cast(float, __builtin_amdgcn_update_dpp(0, __builtin_bit_cast(int, v), 0xB1, 0xF, 0xF, false));
    v += __builtin_bit_cast(float, __builtin_amdgcn_update_dpp(0, __builtin_bit_cast(int, v), 0x4E, 0xF, 0xF, false));
    v += __builtin_bit_cast(float, __builtin_amdgcn_update_dpp(0, __builtin_bit_cast(int, v), 0x141, 0xF, 0xF, false));
    v += __builtin_bit_cast(float, __builtin_amdgcn_update_dpp(0, __builtin_bit_cast(int, v), 0x140, 0xF, 0xF, false));
    v += __builtin_bit_cast(float, __builtin_amdgcn_update_dpp(0, __builtin_bit_cast(int, v), 0x142, 0xA, 0xF, false));
    v += __builtin_bit_cast(float, __builtin_amdgcn_update_dpp(0, __builtin_bit_cast(int, v), 0x143, 0xC, 0xF, false));
    return __builtin_bit_cast(float, __builtin_amdgcn_readlane(__builtin_bit_cast(int, v), 63));
}
__device__ __forceinline__ float tanh_fast(float x) { return 1.f - 2.f * __builtin_amdgcn_rcpf(1.f + __expf(2.f * x)); }
__device__ __forceinline__ float softplus_fast(float x) { return fmaxf(x, 0.f) + __logf(1.f + __expf(-fabsf(x))); }
__device__ __forceinline__ float wave_sum(float v) {
#pragma unroll
    for (int o = 1; o < 64; o <<= 1) v += __shfl_xor(v, o);
    return v;
}
__device__ __forceinline__ float sigmoidf_(float x) { return __builtin_amdgcn_rcpf(1.f + __expf(-x)); }
__device__ __forceinline__ float gelu_tanh(float x) {
    const float u = 0.7978845608028654f * (x + 0.044715f * x * x * x);
    return x * sigmoidf_(2.f * u);
}
__device__ __forceinline__ float rstd16(const float* ssq, int row, int fq) {
    const f32x4 a = *(const f32x4*)(ssq + (size_t)row * 16 + 4 * fq);
    float s = (a[0] + a[1]) + (a[2] + a[3]); s += __shfl_xor(s, 16); s += __shfl_xor(s, 32);
    return __builtin_amdgcn_rsqf(s * (1.f / DM) + EPS);
}

using pg8::Unit; using pg8::cvt_pk_bf16;
struct EpiUp {
    static constexpr bool PERM = true;
    bf16_t* O; const float* ssq;
    __device__ __forceinline__ void operator()(const f32x4 (&acc)[2][2][4][2], const Unit& u, int wr, int wc, int fr, int fq) const {
        const int row0 = u.pm * 256 + wr * 64 + fr, col0 = u.pn * 128 + wc * 32 + 8 * fq;
#pragma unroll
        for (int ai = 0; ai < 2; ++ai)
#pragma unroll
            for (int m = 0; m < 4; ++m) {
                const int row = row0 + ai * 128 + m * 16; const float rs = rstd16(ssq, row, fq);
                float o[8];
#pragma unroll
                for (int n = 0; n < 2; ++n)
#pragma unroll
                    for (int j = 0; j < 4; ++j) { const float gg = acc[ai][0][m][n][j] * rs, uu = acc[ai][1][m][n][j] * rs; o[n * 4 + j] = gg * sigmoidf_(gg) * uu; }
                u32x4 w; w.x = cvt_pk_bf16(o[0], o[1]); w.y = cvt_pk_bf16(o[2], o[3]); w.z = cvt_pk_bf16(o[4], o[5]); w.w = cvt_pk_bf16(o[6], o[7]);
                *(u32x4*)(O + (size_t)row * FF + col0) = w;
            }
    }
};
struct EpiRes {
    static constexpr bool PERM = true;
    bf16_t* hi; bf16_t* lo; float* ssq; float scale; float* outf;
    __device__ __forceinline__ void operator()(const f32x4 (&acc)[2][2][4][2], const Unit& u, int wr, int wc, int fr, int fq) const {
        const int row0 = u.pm * 256 + wr * 64 + fr, col0 = u.pn * 256 + wc * 32 + 8 * fq;
#pragma unroll
        for (int ai = 0; ai < 2; ++ai)
#pragma unroll
            for (int m = 0; m < 4; ++m) {
                const int row = row0 + ai * 128 + m * 16; float ss = 0.f;
#pragma unroll
                for (int bj = 0; bj < 2; ++bj) {
                    const size_t off = (size_t)row * DM + col0 + bj * 128;
                    const u32x4 wh = *(const u32x4*)(hi + off), wl = *(const u32x4*)(lo + off);
                    f32x4 h0, h1;
                    h0[0] = bflo(wh.x) + bflo(wl.x); h0[1] = bfhi(wh.x) + bfhi(wl.x); h0[2] = bflo(wh.y) + bflo(wl.y); h0[3] = bfhi(wh.y) + bfhi(wl.y);
                    h1[0] = bflo(wh.z) + bflo(wl.z); h1[1] = bfhi(wh.z) + bfhi(wl.z); h1[2] = bflo(wh.w) + bflo(wl.w); h1[3] = bfhi(wh.w) + bfhi(wl.w);
                    h0 = h0 + acc[ai][bj][m][0] * scale; h1 = h1 + acc[ai][bj][m][1] * scale;
                    ss += ((h0[0] * h0[0] + h0[1] * h0[1]) + (h0[2] * h0[2] + h0[3] * h0[3])) + ((h1[0] * h1[0] + h1[1] * h1[1]) + (h1[2] * h1[2] + h1[3] * h1[3]));
                    if (outf) { *(f32x4*)(outf + off) = h0; *(f32x4*)(outf + off + 4) = h1; }
                    else {
                        u32x4 nh; nh.x = cvt_pk_bf16(h0[0], h0[1]); nh.y = cvt_pk_bf16(h0[2], h0[3]); nh.z = cvt_pk_bf16(h1[0], h1[1]); nh.w = cvt_pk_bf16(h1[2], h1[3]);
                        u32x4 nl; nl.x = cvt_pk_bf16(h0[0] - bflo(nh.x), h0[1] - bfhi(nh.x)); nl.y = cvt_pk_bf16(h0[2] - bflo(nh.y), h0[3] - bfhi(nh.y));
                        nl.z = cvt_pk_bf16(h1[0] - bflo(nh.z), h1[1] - bfhi(nh.z)); nl.w = cvt_pk_bf16(h1[2] - bflo(nh.w), h1[3] - bfhi(nh.w));
                        *(u32x4*)(hi + off) = nh; *(u32x4*)(lo + off) = nl;
                    }
                }
                ss += __shfl_xor(ss, 16); ss += __shfl_xor(ss, 32);
                if (fq == 0) ssq[(size_t)row * 16 + u.pn * 4 + wc] = ss;
            }
    }
};
struct EpiP {
    static constexpr bool PERM = false;
    float* P; int ldp; const float* ssq;
    __device__ __forceinline__ void operator()(const f32x4 (&acc)[2][2][4][2], const Unit& u, int wr, int wc, int fr, int fq) const {
        const int row0 = u.pm * 256 + wr * 64 + fr, col0 = u.pn * 256 + wc * 32 + 4 * fq;
#pragma unroll
        for (int ai = 0; ai < 2; ++ai)
#pragma unroll
            for (int m = 0; m < 4; ++m) {
                const int row = row0 + ai * 128 + m * 16; const float rs = rstd16(ssq, row, fq);
#pragma unroll
                for (int bj = 0; bj < 2; ++bj)
#pragma unroll
                    for (int n = 0; n < 2; ++n) *(f32x4*)(P + (size_t)row * ldp + col0 + bj * 128 + n * 16) = acc[ai][bj][m][n] * rs;
            }
    }
};
struct EpiG {
    static constexpr bool PERM = true;
    bf16_t* G; const float* ssq;
    __device__ __forceinline__ void operator()(const f32x4 (&acc)[2][2][4][2], const Unit& u, int wr, int wc, int fr, int fq) const {
        const int row0 = u.pm * 256 + wr * 64 + fr, col0 = u.pn * 256 + wc * 32 + 8 * fq;
#pragma unroll
        for (int ai = 0; ai < 2; ++ai)
#pragma unroll
            for (int m = 0; m < 4; ++m) {
                const int row = row0 + ai * 128 + m * 16; const float rs = rstd16(ssq, row, fq);
#pragma unroll
                for (int bj = 0; bj < 2; ++bj) {
                    float o[8];
#pragma unroll
                    for (int n = 0; n < 2; ++n)
#pragma unroll
                        for (int j = 0; j < 4; ++j) o[n * 4 + j] = sigmoidf_(acc[ai][bj][m][n][j] * rs);
                    u32x4 w; w.x = cvt_pk_bf16(o[0], o[1]); w.y = cvt_pk_bf16(o[2], o[3]); w.z = cvt_pk_bf16(o[4], o[5]); w.w = cvt_pk_bf16(o[6], o[7]);
                    *(u32x4*)(G + (size_t)row * NGC + col0 + bj * 128) = w;
                }
            }
    }
};
constexpr size_t MF_STRIDE = (size_t)4096 * 1024;
struct EpiMerge {
    static constexpr bool PERM = true;
    const bf16_t* G; float* Mf; bf16_t* Mb; int mode;
    __device__ __forceinline__ void operator()(const f32x4 (&acc)[2][2][4][2], const Unit& u, int wr, int wc, int fr, int fq) const {
        const int row0 = u.pm * 256 + wr * 64 + fr, col0 = u.pn * 256 + wc * 32 + 8 * fq;
#pragma unroll
        for (int ai = 0; ai < 2; ++ai)
#pragma unroll
            for (int m = 0; m < 4; ++m) {
                const int row = row0 + ai * 128 + m * 16;
#pragma unroll
                for (int bj = 0; bj < 2; ++bj) {
                    const int col = col0 + bj * 128;
                    const u32x4 gw = *(const u32x4*)(G + (size_t)row * NGC + col);
                    f32x4 v0, v1;
                    v0[0] = bflo(gw.x) * acc[ai][bj][m][0][0]; v0[1] = bfhi(gw.x) * acc[ai][bj][m][0][1]; v0[2] = bflo(gw.y) * acc[ai][bj][m][0][2]; v0[3] = bfhi(gw.y) * acc[ai][bj][m][0][3];
                    v1[0] = bflo(gw.z) * acc[ai][bj][m][1][0]; v1[1] = bfhi(gw.z) * acc[ai][bj][m][1][1]; v1[2] = bflo(gw.w) * acc[ai][bj][m][1][2]; v1[3] = bfhi(gw.w) * acc[ai][bj][m][1][3];
                    float* mp = Mf + (size_t)row * DM + col;
                    if (mode > 0) { const float* rp = mp + (mode == 2 ? MF_STRIDE : 0); v0 = v0 + *(const f32x4*)rp; v1 = v1 + *(const f32x4*)(rp + 4); }
                    if (mode < 2) { float* wp = mp + (mode == 1 ? MF_STRIDE : 0); *(f32x4*)wp = v0; *(f32x4*)(wp + 4) = v1; }
                    else { u32x4 w; w.x = cvt_pk_bf16(v0[0], v0[1]); w.y = cvt_pk_bf16(v0[2], v0[3]); w.z = cvt_pk_bf16(v1[0], v1[1]); w.w = cvt_pk_bf16(v1[2], v1[3]);
                           *(u32x4*)(Mb + (size_t)row * DM + col) = w; }
                }
            }
    }
};

struct EpiWin {
    static constexpr bool PERM = true;
    bf16_t* PM; bf16_t* PS; bf16_t* PR; float* SGQ; const float* ssq;
    __device__ __forceinline__ void operator()(const f32x4 (&acc)[2][2][4][2], const Unit& u, int wr, int wc, int fr, int fq) const {
        const int row0 = u.pm * 256 + wr * 64 + fr, cw = wc * 32 + 8 * fq;
        const int kind = u.pn < 2 ? 0 : (u.pn < 6 ? 1 : 2);
        bf16_t* base; int ld, col0;
        if (kind == 0) { base = PM; ld = 512; col0 = u.pn * 256 + cw; } else if (kind == 1) { base = PS; ld = 1024; col0 = (u.pn - 2) * 256 + cw; } else { base = PR; ld = RWC; col0 = (u.pn - 6) * 256 + cw; }
#pragma unroll
        for (int ai = 0; ai < 2; ++ai)
#pragma unroll
            for (int m = 0; m < 4; ++m) {
                const int row = row0 + ai * 128 + m * 16; const float rs = rstd16(ssq, row, fq); float ss = 0.f;
#pragma unroll
                for (int bj = 0; bj < 2; ++bj) {
                    float o[8];
#pragma unroll
                    for (int n = 0; n < 2; ++n)
#pragma unroll
                        for (int j = 0; j < 4; ++j) { float v = acc[ai][bj][m][n][j] * rs; if (kind == 1) { v = gelu_tanh(v); ss += v * v; } o[n * 4 + j] = v; }
                    u32x4 w; w.x = cvt_pk_bf16(o[0], o[1]); w.y = cvt_pk_bf16(o[2], o[3]); w.z = cvt_pk_bf16(o[4], o[5]); w.w = cvt_pk_bf16(o[6], o[7]);
                    *(u32x4*)(base + (size_t)row * ld + col0 + bj * 128) = w;
                }
                if (u.pn == 4 || u.pn == 5) { ss += __shfl_xor(ss, 16); ss += __shfl_xor(ss, 32); if (fq == 0) SGQ[(size_t)row * 8 + (u.pn - 4) * 4 + wc] = ss; }
            }
    }
};
struct EpiGateS {
    static constexpr bool PERM = true;
    bf16_t* S; const float* ssq;
    __device__ __forceinline__ void operator()(const f32x4 (&acc)[2][2][4][2], const Unit& u, int wr, int wc, int fr, int fq) const {
        const int row0 = u.pm * 256 + wr * 64 + fr, col0 = u.pn * 256 + wc * 32 + 8 * fq;
#pragma unroll
        for (int ai = 0; ai < 2; ++ai)
#pragma unroll
            for (int m = 0; m < 4; ++m) {
                const int row = row0 + ai * 128 + m * 16; const float rs = rstd16(ssq, row, fq);
#pragma unroll
                for (int bj = 0; bj < 2; ++bj) {
                    float o[8];
#pragma unroll
                    for (int n = 0; n < 2; ++n)
#pragma unroll
                        for (int j = 0; j < 4; ++j) o[n * 4 + j] = sigmoidf_(acc[ai][bj][m][n][j] * rs);
                    u32x4 w; w.x = cvt_pk_bf16(o[0], o[1]); w.y = cvt_pk_bf16(o[2], o[3]); w.z = cvt_pk_bf16(o[4], o[5]); w.w = cvt_pk_bf16(o[6], o[7]);
                    *(u32x4*)(S + (size_t)row * DM + col0 + bj * 128) = w;
                }
            }
    }
};
struct EpiMerge2 {
    static constexpr bool PERM = true;
    const bf16_t* S; bf16_t* M; int first;
    __device__ __forceinline__ void operator()(const f32x4 (&acc)[2][2][4][2], const Unit& u, int wr, int wc, int fr, int fq) const {
        __builtin_amdgcn_fence(__ATOMIC_ACQUIRE, "agent");
        const int row0 = u.pm * 256 + wr * 64 + fr, col0 = u.pn * 256 + wc * 32 + 8 * fq;
#pragma unroll
        for (int ai = 0; ai < 2; ++ai)
#pragma unroll
            for (int m = 0; m < 4; ++m) {
                const int row = row0 + ai * 128 + m * 16;
#pragma unroll
                for (int bj = 0; bj < 2; ++bj) {
                    const size_t off = (size_t)row * DM + col0 + bj * 128;
                    const u32x4 gw = *(const u32x4*)(S + off);
                    float o[8];
                    o[0] = bflo(gw.x) * acc[ai][bj][m][0][0]; o[1] = bfhi(gw.x) * acc[ai][bj][m][0][1]; o[2] = bflo(gw.y) * acc[ai][bj][m][0][2]; o[3] = bfhi(gw.y) * acc[ai][bj][m][0][3];
                    o[4] = bflo(gw.z) * acc[ai][bj][m][1][0]; o[5] = bfhi(gw.z) * acc[ai][bj][m][1][1]; o[6] = bflo(gw.w) * acc[ai][bj][m][1][2]; o[7] = bfhi(gw.w) * acc[ai][bj][m][1][3];
                    if (!first) { const u32x4 mw = *(const u32x4*)(M + off);
                        o[0] += bflo(mw.x); o[1] += bfhi(mw.x); o[2] += bflo(mw.y); o[3] += bfhi(mw.y); o[4] += bflo(mw.z); o[5] += bfhi(mw.z); o[6] += bflo(mw.w); o[7] += bfhi(mw.w); }
                    u32x4 w; w.x = cvt_pk_bf16(o[0], o[1]); w.y = cvt_pk_bf16(o[2], o[3]); w.z = cvt_pk_bf16(o[4], o[5]); w.w = cvt_pk_bf16(o[6], o[7]);
                    *(u32x4*)(M + off) = w;
                }
            }
    }
};

struct EpiGate3 {
    static constexpr bool PERM = true;
    bf16_t* G0; bf16_t* G1; bf16_t* G2; const float* ssq;
    __device__ __forceinline__ void operator()(const f32x4 (&acc)[2][2][4][2], const Unit& u, int wr, int wc, int fr, int fq) const {
        const int br = u.pn >> 2;
        const long long d1 = (const char*)G1 - (const char*)G0, d2 = (const char*)G2 - (const char*)G0;
        bf16_t* S = (bf16_t*)((char*)G0 + (br == 1 ? d1 : 0ll) + (br == 2 ? d2 : 0ll));
        const int row0 = u.pm * 256 + wr * 64 + fr, col0 = (u.pn & 3) * 256 + wc * 32 + 8 * fq;
#pragma unroll
        for (int ai = 0; ai < 2; ++ai)
#pragma unroll
            for (int m = 0; m < 4; ++m) {
                const int row = row0 + ai * 128 + m * 16; const float rs = rstd16(ssq, row, fq);
#pragma unroll
                for (int bj = 0; bj < 2; ++bj) {
                    float o[8];
#pragma unroll
                    for (int n = 0; n < 2; ++n)
#pragma unroll
                        for (int j = 0; j < 4; ++j) o[n * 4 + j] = sigmoidf_(acc[ai][bj][m][n][j] * rs);
                    u32x4 w; w.x = cvt_pk_bf16(o[0], o[1]); w.y = cvt_pk_bf16(o[2], o[3]); w.z = cvt_pk_bf16(o[4], o[5]); w.w = cvt_pk_bf16(o[6], o[7]);
                    *(u32x4*)(S + (size_t)row * DM + col0 + bj * 128) = w;
                }
            }
    }
};
constexpr size_t MiB = 1u << 20;
constexpr size_t WS_W = 0;
constexpr size_t WS_HHI = 52 * MiB, WS_HLO = 84 * MiB;
constexpr size_t WS_VF = 116 * MiB;
constexpr size_t WS_SSQ = 132 * MiB;
constexpr size_t WS_ROPE = 133 * MiB;
constexpr size_t WS_MISC = 135 * MiB;
constexpr size_t WS_T1 = 136 * MiB;
constexpr size_t WS_ACT = 138 * MiB;
constexpr size_t WS_A = 138 * MiB;
constexpr size_t WS_B = 154 * MiB;
constexpr size_t WS_C = 186 * MiB;
constexpr size_t WS_D = 242 * MiB;
constexpr size_t WS_END = 270 * MiB;
constexpr size_t DO_Q = 0, DO_K = 24 * MiB, DO_VT = 48 * MiB;
constexpr size_t DO_PCORR = 0, DO_HL = 16 * MiB, DO_GX = 32 * MiB;
constexpr size_t DO_S = 0, DO_M = 32 * MiB;
constexpr size_t OW_W1GU1 = 0, OW_W2_1 = OW_W1GU1 + (size_t)2 * FF * DM, OW_W1GU2 = OW_W2_1 + (size_t)DM * FF, OW_W2_2 = OW_W1GU2 + (size_t)2 * FF * DM,
                 OW_WIN = OW_W2_2 + (size_t)DM * FF, OW_WOUT = OW_WIN + (size_t)6400 * DM, OW_WO = OW_WOUT + (size_t)DM * 1536, OW_END = OW_WO + (size_t)DM * DM;
static_assert(OW_END * 2 <= 52 * MiB, "weights fit");
constexpr int TB = SEQ;

__device__ __forceinline__ void conv_load(f32x4 (&v)[8], const float* src, int ld_src, int sn0, int lane) {
    if (sn0 >= 0) { const int kr = lane >> 3, nc = (lane & 7) * 4;
#pragma unroll
        for (int i = 0; i < 8; ++i) v[i] = *(const f32x4*)(src + (size_t)(8 * i + kr) * ld_src + sn0 + nc); }
    else {
#pragma unroll
        for (int i = 0; i < 8; ++i) v[i] = (f32x4){0.f, 0.f, 0.f, 0.f}; }
}
__device__ __forceinline__ void conv_finish(const f32x4 (&v)[8], const float* scale, bf16_t* dst, int ldd, LAS float* scr, int lane) {
    const int kr = lane >> 3, nc = (lane & 7) * 4;
#pragma unroll
    for (int i = 0; i < 8; ++i) { const int kk = 8 * i + kr; const float sc = scale ? scale[kk] : 1.f;
        scr[kk * 33 + nc] = v[i][0] * sc; scr[kk * 33 + nc + 1] = v[i][1] * sc; scr[kk * 33 + nc + 2] = v[i][2] * sc; scr[kk * 33 + nc + 3] = v[i][3] * sc; }
    asm volatile("s_waitcnt lgkmcnt(0)" ::: "memory");
    const int c = lane & 7;
#pragma unroll
    for (int j = 0; j < 4; ++j) { const int n = (lane >> 3) + 8 * j; const LAS float* sp = scr + (8 * c) * 33 + n;
        u32x4 o; o.x = pk2h(sp[0 * 33], sp[1 * 33]); o.y = pk2h(sp[2 * 33], sp[3 * 33]); o.z = pk2h(sp[4 * 33], sp[5 * 33]); o.w = pk2h(sp[6 * 33], sp[7 * 33]);
        *(u32x4*)(dst + (size_t)n * ldd + 8 * c) = o; }
    asm volatile("s_waitcnt lgkmcnt(0)" ::: "memory");
}
__device__ __forceinline__ void conv_item(const float* src, int ld_src, int sn0, const float* scale, bf16_t* dst, int ldd, LAS float* scr, int lane) {
    f32x4 v[8]; conv_load(v, src, ld_src, sn0, lane); conv_finish(v, scale, dst, ldd, scr, lane);
}

struct Args { const void* in[39]; float* out; unsigned char* ws; int ph_lo, ph_hi; };
typedef __attribute__((address_space(4))) const Args CArgs;
struct LayerW {
    CArgs* ap; int L;
#define FI(i) ((const float*)ap->in[i])
#define ACC(name, expr) __device__ __forceinline__ const float* name() const { return expr; }
    ACC(n1, FI(2) + (size_t)L * DM) ACC(g1, FI(3) + (size_t)L * DM * FF) ACC(u1, FI(4) + (size_t)L * DM * FF) ACC(d1, FI(5) + (size_t)L * FF * DM)
    ACC(mixn, FI(6) + (size_t)L * DM) ACC(win, FI(7) + (size_t)L * DM * 6304)
    ACC(qan, FI(8) + L * 256) ACC(wuq, FI(9) + (size_t)L * 256 * 768) ACC(kvan, FI(10) + L * 128) ACC(wukv, FI(11) + (size_t)L * 128 * 1024)
    ACC(qn, FI(12) + L * 96) ACC(kn, FI(13) + L * 96) ACC(sgvn, FI(14) + L * 512) ACC(sgws, FI(15) + (size_t)L * 8 * 128 * 128) ACC(sgbs, FI(16) + L * 8 * 128)
    ACC(mu, FI(17) + L * RWC) ACC(w0, FI(18) + L * 512) ACC(w2, FI(19) + (size_t)L * 64 * 512) ACC(a0, FI(20) + L * 512) ACC(a2, FI(21) + (size_t)L * 64 * 512)
    ACC(g2, FI(22) + (size_t)L * 128 * 512) ACC(kk, FI(23) + L * 512) ACC(ka, FI(24) + L * 512) ACC(rk, FI(25) + L * 512) ACC(lng, FI(26) + L * 512) ACC(lnb, FI(27) + L * 512)
    ACC(v0, FI(28) + (L > 0 ? L - 1 : 0) * 512) ACC(v1, FI(29) + (size_t)(L > 0 ? L - 1 : 0) * 512 * 32) ACC(v2, FI(30) + (size_t)(L > 0 ? L - 1 : 0) * 32 * 512)
    ACC(womla, FI(31) + (size_t)L * 512 * DM) ACC(wosg, FI(32) + (size_t)L * 512 * DM) ACC(worw, FI(33) + (size_t)L * 512 * DM) ACC(wo, FI(34) + (size_t)L * DM * DM)
    ACC(n2, FI(35) + (size_t)L * DM) ACC(g2f, FI(36) + (size_t)L * DM * FF) ACC(u2, FI(37) + (size_t)L * DM * FF) ACC(d2, FI(38) + (size_t)L * FF * DM)
#undef ACC
#undef FI
};

struct CvItem { const float* src; const float* scale; bf16_t* dst; int ld_src, sn0, ldd; };
__device__ __forceinline__ bool conv_decode(const LayerW& w, bf16_t* W, int it, CvItem& c) {
    constexpr int I_GU = 16 * 176, I_D = 44 * 32, I_IN = 16 * 200, I_OUT = 24 * 32, I_O = 16 * 32;
    int r = it;
    if (r < 2 * I_GU) {
        const int f = r / I_GU; r -= f * I_GU; const int kb = r / 176, nb = r % 176, dn0 = 32 * nb, pn = dn0 >> 8, bj = (dn0 >> 7) & 1, cc = dn0 & 127;
        const float* g = f == 0 ? w.g1() : w.g2f(); const float* u = f == 0 ? w.u1() : w.u2();
        c.src = (bj ? u : g) + (size_t)(64 * kb) * FF; c.ld_src = FF; c.sn0 = 128 * pn + cc; c.scale = (f == 0 ? w.n1() : w.n2()) + 64 * kb;
        c.dst = W + (f == 0 ? OW_W1GU1 : OW_W1GU2) + (size_t)dn0 * DM + 64 * kb; c.ldd = DM; return true; }
    r -= 2 * I_GU;
    if (r < 2 * I_D) {
        const int f = r / I_D; r -= f * I_D; const int kb = r / 32, nb = r % 32;
        c.src = (f == 0 ? w.d1() : w.d2()) + (size_t)(64 * kb) * DM; c.ld_src = DM; c.sn0 = 32 * nb; c.scale = nullptr;
        c.dst = W + (f == 0 ? OW_W2_1 : OW_W2_2) + (size_t)(32 * nb) * FF + 64 * kb; c.ldd = FF; return true; }
    r -= 2 * I_D;
    if (r < I_IN) {
        const int kb = r / 200, nb = r % 200, dn0 = 32 * nb;
        if (w.L > 0 && (dn0 == 416 || dn0 == 448)) return false;
        c.src = w.win() + (size_t)(64 * kb) * 6304; c.ld_src = 6304; c.sn0 = dn0 < 416 ? dn0 : (dn0 < 512 ? -1 : dn0 - 96); c.scale = w.mixn() + 64 * kb;
        c.dst = W + OW_WIN + (size_t)dn0 * DM + 64 * kb; c.ldd = DM; return true; }
    r -= I_IN;
    if (r < I_OUT) {
        const int kb = r / 32, nb = r % 32, br = kb >> 3, kl = kb & 7;
        const float* a = w.womla(); const float* b = w.wosg(); const float* d = w.worw();
        c.src = (br == 0 ? a : br == 1 ? b : d) + (size_t)(64 * kl) * DM; c.ld_src = DM; c.sn0 = 32 * nb; c.scale = nullptr;
        c.dst = W + OW_WOUT + ((size_t)br * DM + 32 * nb) * 512 + 64 * kl; c.ldd = 512; return true; }
    r -= I_OUT;
    { const int kb = r / 32, nb = r % 32;
      c.src = w.wo() + (size_t)(64 * kb) * DM; c.ld_src = DM; c.sn0 = 32 * nb; c.scale = nullptr; c.dst = W + OW_WO + (size_t)(32 * nb) * DM + 64 * kb; c.ldd = DM; return true; }
}
__device__ __forceinline__ void conv_weights(const LayerW& w, bf16_t* W, LAS float* scr, int gw, int NGW, int lane) {
    constexpr int NIT = 2 * 16 * 176 + 2 * 44 * 32 + 16 * 200 + 24 * 32 + 16 * 32;
    CvItem cur, nxt; f32x4 va[8], vb[8];
    int it = gw; bool hc = false;
    for (; it < NIT && !hc; it += NGW) hc = conv_decode(w, W, it, cur);
    if (!hc) return;
    conv_load(va, cur.src, cur.ld_src, cur.sn0, lane);
    for (;;) {
        bool hn = false;
        for (; it < NIT && !hn; it += NGW) hn = conv_decode(w, W, it, nxt);
        if (hn) conv_load(vb, nxt.src, nxt.ld_src, nxt.sn0, lane);
        conv_finish(va, cur.scale, cur.dst, cur.ldd, scr, lane);
        if (!hn) break;
#pragma unroll
        for (int i = 0; i < 8; ++i) va[i] = vb[i];
        cur = nxt;
    }
}

struct CvTile { const float* src; const float* scale; bf16_t* dst; int ld_src, ldd; };
__device__ __forceinline__ bool conv_decode128(const LayerW& w, bf16_t* W, int it, CvTile& c) {
    constexpr int T_GU = 16 * 44, T_D = 44 * 8, T_IN = 16 * 49, T_OUT = 24 * 8, T_O = 16 * 8;
    int r = it;
    if (r < 2 * T_GU) { const int f = r / T_GU; r -= f * T_GU; const int kb = r / 44, nb = r % 44, dn0 = 128 * nb, pn = dn0 >> 8, bj = (dn0 >> 7) & 1;
        const float* g = f == 0 ? w.g1() : w.g2f(); const float* u = f == 0 ? w.u1() : w.u2();
        c.src = (bj ? u : g) + (size_t)(64 * kb) * FF + 128 * pn; c.ld_src = FF; c.scale = (f == 0 ? w.n1() : w.n2()) + 64 * kb;
        c.dst = W + (f == 0 ? OW_W1GU1 : OW_W1GU2) + (size_t)dn0 * DM + 64 * kb; c.ldd = DM; return true; }
    r -= 2 * T_GU;
    if (r < 2 * T_D) { const int f = r / T_D; r -= f * T_D; const int kb = r / 8, nb = r % 8;
        c.src = (f == 0 ? w.d1() : w.d2()) + (size_t)(64 * kb) * DM + 128 * nb; c.ld_src = DM; c.scale = nullptr;
        c.dst = W + (f == 0 ? OW_W2_1 : OW_W2_2) + (size_t)(128 * nb) * FF + 64 * kb; c.ldd = FF; return true; }
    r -= 2 * T_D;
    if (r < T_IN) { const int kb = r / 49; int nb = r % 49; if (nb >= 3) ++nb; const int dn0 = 128 * nb;
        c.src = w.win() + (size_t)(64 * kb) * 6304 + (dn0 < 384 ? dn0 : dn0 - 96); c.ld_src = 6304; c.scale = w.mixn() + 64 * kb;
        c.dst = W + OW_WIN + (size_t)dn0 * DM + 64 * kb; c.ldd = DM; return true; }
    r -= T_IN;
    if (r < T_OUT) { const int kb = r / 8, nb = r % 8, br = kb >> 3, kl = kb & 7;
        const float* a = w.womla(); const float* b = w.wosg(); const float* d = w.worw();
        c.src = (br == 0 ? a : br == 1 ? b : d) + (size_t)(64 * kl) * DM + 128 * nb; c.ld_src = DM; c.scale = nullptr;
        c.dst = W + OW_WOUT + ((size_t)br * DM + 128 * nb) * 512 + 64 * kl; c.ldd = 512; return true; }
    r -= T_OUT;
    if (r < T_O) { const int kb = r / 8, nb = r % 8;
        c.src = w.wo() + (size_t)(64 * kb) * DM + 128 * nb; c.ld_src = DM; c.scale = nullptr; c.dst = W + OW_WO + (size_t)(128 * nb) * DM + 64 * kb; c.ldd = DM; return true; }
    return false;
}
__device__ __forceinline__ void conv_weights_wg(const LayerW& w, bf16_t* W, LAS float* tile, int bid, int G, int tid) {
    constexpr int NIT = 2 * 16 * 44 + 2 * 44 * 8 + 16 * 49 + 24 * 8 + 16 * 8;
    CvTile c0, c1, c2; f32x4 v0[4], v1[4], v2[4];
    int it = bid; if (it >= NIT) return;
#define CV_LOAD(V, C) do { _Pragma("unroll") for (int i = 0; i < 4; ++i) { const int q = tid + 512 * i; V[i] = *(const f32x4*)(C.src + (size_t)(q >> 5) * C.ld_src + 4 * (q & 31)); } } while (0)
#define CV_PROC(V, C) do { \
        asm volatile("s_waitcnt lgkmcnt(0)\n\ts_barrier" ::: "memory");                                \
        _Pragma("unroll") for (int i = 0; i < 4; ++i) { const int q = tid + 512 * i, k = q >> 5, n4 = 4 * (q & 31); const float sc = C.scale ? C.scale[k] : 1.f; \
            *(LAS f32x4*)(tile + k * 128 + (n4 ^ (8 * ((k >> 3) & 3)))) = V[i] * sc; } \
        asm volatile("s_waitcnt lgkmcnt(0)\n\ts_barrier" ::: "memory"); \
        _Pragma("unroll") for (int j = 0; j < 2; ++j) { const int p2 = tid + 512 * j, n = p2 >> 3, k8 = 8 * (p2 & 7); const LAS float* tp = tile + k8 * 128 + (n ^ (8 * ((k8 >> 3) & 3))); \
            u32x4 o; o.x = pk2h(tp[0], tp[128]); o.y = pk2h(tp[256], tp[384]); o.z = pk2h(tp[512], tp[640]); o.w = pk2h(tp[768], tp[896]); \
            *(u32x4*)(C.dst + (size_t)n * C.ldd + k8) = o; } } while (0)
    conv_decode128(w, W, it, c0); CV_LOAD(v0, c0);
    if (it + G < NIT) { conv_decode128(w, W, it + G, c1); CV_LOAD(v1, c1); }
    for (;;) {
        if (it + 2 * G < NIT) { conv_decode128(w, W, it + 2 * G, c2); CV_LOAD(v2, c2); }
        CV_PROC(v0, c0); it += G; if (it >= NIT) break;
        if (it + 2 * G < NIT) { conv_decode128(w, W, it + 2 * G, c0); CV_LOAD(v0, c0); }
        CV_PROC(v1, c1); it += G; if (it >= NIT) break;
        if (it + 2 * G < NIT) { conv_decode128(w, W, it + 2 * G, c1); CV_LOAD(v1, c1); }
        CV_PROC(v2, c2); it += G; if (it >= NIT) break;
    }
#undef CV_LOAD
#undef CV_PROC
}
__device__ __forceinline__ void conv_win_block3(const LayerW& w, bf16_t* W, LAS float* scr, int gw, int NGW, int lane) {
    for (int it = gw; it < 64; it += NGW) { const int kb = it >> 2, nb = 12 + (it & 3); CvItem c;
        if (conv_decode(w, W, 2 * 16 * 176 + 2 * 44 * 32 + kb * 200 + nb, c)) conv_item(c.src, c.ld_src, c.sn0, c.scale, c.dst, c.ldd, scr, lane); }
}

__device__ __forceinline__ void init_rows(const float* x, bf16_t* hi, bf16_t* lo, float* ssq, int gw, int NGW, int lane) {
    for (int r = gw; r < T; r += NGW) {
        const f32x4* xr = (const f32x4*)(x + (size_t)r * DM) + lane; float s = 0.f;
#pragma unroll
        for (int j = 0; j < 4; ++j) { const f32x4 v = xr[64 * j]; s += (v[0] * v[0] + v[1] * v[1]) + (v[2] * v[2] + v[3] * v[3]);
            u32x2 h; h.x = pk2(v[0], v[1]); h.y = pk2(v[2], v[3]);
            u32x2 l; l.x = pk2(v[0] - bflo(h.x), v[1] - bfhi(h.x)); l.y = pk2(v[2] - bflo(h.y), v[3] - bfhi(h.y));
            const size_t off = (size_t)r * DM + 4 * (lane + 64 * j);
            *(u32x2*)(hi + off) = h; *(u32x2*)(lo + off) = l; }
        s = wave_sum(s);
        if (lane < 16) ssq[(size_t)r * 16 + lane] = lane == 0 ? s : 0.f;
    }
}
__device__ __forceinline__ void init_rope(const int* pos, float* cosT, float* sinT, int gtid, int NT) {
    for (int i = gtid; i < T * 16; i += NT) { const int t = i >> 4, f = i & 15;
        const float inv = powf(10000.f, -(float)f * (1.f / 16.f)); const float ang = (float)pos[t] * inv;
        cosT[i] = cosf(ang); sinT[i] = sinf(ang); }
}

constexpr float ATT_SC = 0.10206207261596577f * 1.4426950408889634f;

__device__ __forceinline__ void mla_unit(const LayerW& w, const float* P, const float* cosT, const float* sinT, bf16_t* Q, bf16_t* K, bf16_t* Vt, int tb, int rb, LAS float* sm) {
    const int tid = tid_opaque(), lane = tid & 63, wv = tid >> 6;
    LAS float* a = sm; LAS float* kpe = sm + 3072; LAS float* out = sm + 3328;
    __syncthreads();
    { const float* row = P + (size_t)(tb + wv) * NPC;
      const f32x4 v = *(const f32x4*)(row + lane * 4); float ss = wave_sum((v[0] * v[0] + v[1] * v[1]) + (v[2] * v[2] + v[3] * v[3]));
      float rs = __builtin_amdgcn_rsqf(ss * (1.f / 256.f) + EPS);
#pragma unroll
      for (int i = 0; i < 4; ++i) a[wv * 384 + lane * 4 + i] = v[i] * rs * w.qan()[lane * 4 + i];
      const f32x2 v2 = *(const f32x2*)(row + 256 + lane * 2); ss = wave_sum(v2[0] * v2[0] + v2[1] * v2[1]);
      rs = __builtin_amdgcn_rsqf(ss * (1.f / 128.f) + EPS);
      a[wv * 384 + 256 + lane * 2] = v2[0] * rs * w.kvan()[lane * 2]; a[wv * 384 + 256 + lane * 2 + 1] = v2[1] * rs * w.kvan()[lane * 2 + 1];
      if (lane < 32) kpe[wv * 32 + lane] = row[384 + lane]; }
    __syncthreads();
    for (int n = tid; n < 1792; n += 512) {
        float acc[8];
#pragma unroll
        for (int j = 0; j < 8; ++j) acc[j] = 0.f;
        if (n < 768) { for (int k = 0; k < 256; ++k) { const float ww = w.wuq()[(size_t)k * 768 + n];
#pragma unroll
                for (int j = 0; j < 8; ++j) acc[j] += a[j * 384 + k] * ww; } }
        else { for (int k = 0; k < 128; ++k) { const float ww = w.wukv()[(size_t)k * 1024 + (n - 768)];
#pragma unroll
                for (int j = 0; j < 8; ++j) acc[j] += a[j * 384 + 256 + k] * ww; } }
#pragma unroll
        for (int j = 0; j < 8; ++j) out[j * 1792 + n] = acc[j];
    }
    __syncthreads();
    if (tid < 64) {
        const int j = tid >> 3, h = tid & 7, t = tb + j; const size_t gr = (size_t)(rb + t);
        const LAS float* q = out + j * 1792 + h * 96; float ss = 0.f;
        for (int d = 0; d < 96; ++d) ss += q[d] * q[d];
        float rs = __builtin_amdgcn_rsqf(ss * (1.f / 96.f) + EPS);
        bf16_t* qo = Q + (size_t)t * 768 + h * 96;
        for (int d = 0; d < 64; ++d) qo[d] = (bf16_t)f2bf(q[d] * rs * w.qn()[d] * ATT_SC);
        for (int i = 0; i < 16; ++i) { const float x1 = q[64 + i] * rs * w.qn()[64 + i], x2 = q[80 + i] * rs * w.qn()[80 + i], c = cosT[gr * 16 + i], s = sinT[gr * 16 + i];
            qo[64 + i] = (bf16_t)f2bf((x1 * c - x2 * s) * ATT_SC); qo[80 + i] = (bf16_t)f2bf((x2 * c + x1 * s) * ATT_SC); }
        const LAS float* kn = out + j * 1792 + 768 + h * 128; const LAS float* kp = kpe + j * 32; ss = 0.f;
        for (int d = 0; d < 64; ++d) ss += kn[d] * kn[d];
        for (int i = 0; i < 32; ++i) ss += kp[i] * kp[i];
        rs = __builtin_amdgcn_rsqf(ss * (1.f / 96.f) + EPS);
        bf16_t* ko = K + (size_t)t * 768 + h * 96;
        for (int d = 0; d < 64; ++d) ko[d] = (bf16_t)f2bf(kn[d] * rs * w.kn()[d]);
        for (int i = 0; i < 16; ++i) { const float x1 = kp[i] * rs * w.kn()[64 + i], x2 = kp[16 + i] * rs * w.kn()[80 + i], c = cosT[gr * 16 + i], s = sinT[gr * 16 + i];
            ko[64 + i] = (bf16_t)f2bf(x1 * c - x2 * s); ko[80 + i] = (bf16_t)f2bf(x2 * c + x1 * s); }
        for (int d = 0; d < 64; ++d) Vt[(size_t)(h * 64 + d) * SEQ + t] = (bf16_t)f2bf(kn[64 + d]);
    }
}

__device__ __forceinline__ void attn_naive_unit(const float* Q, const float* K, const float* V, bf16_t* YA, int h, int qb, LAS float* sm) {
    const int tid = tid_opaque(); const int row = qb * 512 + tid; const int wmax = qb * 512 + (tid | 63);
    LAS float* Ks = sm; LAS float* Vs = sm + 6144;
    float q[96], o[64];
#pragma unroll
    for (int d = 0; d < 96; d += 4) { const f32x4 v = *(const f32x4*)(Q + (size_t)row * 768 + h * 96 + d); q[d] = v[0]; q[d + 1] = v[1]; q[d + 2] = v[2]; q[d + 3] = v[3]; }
#pragma unroll
    for (int d = 0; d < 64; ++d) o[d] = 0.f;
    float m = -INFINITY, l = 0.f;
    const int ntile = 8 * (qb + 1);
    for (int kt = 0; kt < ntile; ++kt) {
        __syncthreads();
        for (int i = tid; i < 6144; i += 512) { const int j = i / 96, d = i - j * 96; Ks[i] = K[(size_t)(kt * 64 + j) * 768 + h * 96 + d]; }
        for (int i = tid; i < 4096; i += 512) { const int j = i >> 6, d = i & 63; Vs[i] = V[(size_t)(kt * 64 + j) * 512 + h * 64 + d]; }
        __syncthreads();
        if (kt * 64 <= wmax) {
            for (int j = 0; j < 64; ++j) {
                const int key = kt * 64 + j; if (key > wmax) break;
                float s = 0.f;
#pragma unroll
                for (int d = 0; d < 96; d += 4) { const f32x4 kv = *(const LAS f32x4*)(Ks + j * 96 + d); s += q[d] * kv[0] + q[d + 1] * kv[1] + q[d + 2] * kv[2] + q[d + 3] * kv[3]; }
                if (key <= row) {
                    const float mn = fmaxf(m, s), c = exp2f(m - mn), p = exp2f(s - mn); l = l * c + p; m = mn;
#pragma unroll
                    for (int d = 0; d < 64; d += 4) { const f32x4 vv = *(const LAS f32x4*)(Vs + j * 64 + d);
                        o[d] = o[d] * c + p * vv[0]; o[d + 1] = o[d + 1] * c + p * vv[1]; o[d + 2] = o[d + 2] * c + p * vv[2]; o[d + 3] = o[d + 3] * c + p * vv[3]; }
                }
            }
        }
    }
    const float il = 1.f / l;
#pragma unroll
    for (int d = 0; d < 64; d += 8) { u32x4 wq; wq.x = pk2(o[d] * il, o[d + 1] * il); wq.y = pk2(o[d + 2] * il, o[d + 3] * il); wq.z = pk2(o[d + 4] * il, o[d + 5] * il); wq.w = pk2(o[d + 6] * il, o[d + 7] * il);
        *(u32x4*)(YA + (size_t)row * 512 + h * 64 + d) = wq; }
}

__device__ __forceinline__ void sg_rstd_rows(const float* P, float* SGR, int gw, int NGW, int lane) {
    for (int t = gw; t < TB; t += NGW) { const float* row = P + (size_t)t * NPC + 1024; float ss = 0.f;
#pragma unroll
        for (int j = 0; j < 8; ++j) { const float g = gelu_tanh(row[lane + 64 * j]); ss += g * g; }
        ss = wave_sum(ss); if (lane == 0) SGR[t] = __builtin_amdgcn_rsqf(ss * (1.f / 512.f) + EPS); }
}
__device__ __forceinline__ void sg_mix_unit(const LayerW& w, const float* P, const float* SGR, bf16_t* YB, int c, int g, LAS float* sm) {
    const int tid = tid_opaque(); LAS float* Wl = sm; LAS float* vn = sm + 16384;
    __syncthreads();
    for (int i = tid; i < 16384; i += 512) Wl[i] = w.sgws()[(size_t)g * 16384 + i];
    for (int i = tid; i < 8192; i += 512) { const int s = i >> 6, cc = i & 63; const int t = c * 128 + s;
        vn[i] = gelu_tanh(P[(size_t)t * NPC + 1024 + g * 64 + cc]) * SGR[t] * w.sgvn()[g * 64 + cc]; }
    __syncthreads();
    const int cc = tid & 63, tq = tid >> 6;
    for (int tt = 0; tt < 16; ++tt) { const int tl = tq + 8 * tt; float acc = 0.f;
        for (int s = 0; s <= tl; ++s) acc += Wl[tl * 128 + s] * vn[s * 64 + cc];
        const int t = c * 128 + tl; const float mixed = acc + w.sgbs()[g * 128 + tl]; const float uu = gelu_tanh(P[(size_t)t * NPC + 512 + g * 64 + cc]);
        YB[(size_t)t * 512 + g * 64 + cc] = (bf16_t)f2bf(uu * mixed); }
}

struct RwArr { float *R, *W, *KX, *VV, *A, *B, *GG, *BN; };
__device__ __forceinline__ void rw_prep_unit(const LayerW& w, int L, const float* P, float* VF, const RwArr& ar, int tb, int rb, LAS float* sm) {
    const int tid = tid_opaque();
    LAS float* xs = sm; LAS float* t1 = sm + 14336; LAS float* kkp = sm + 14592; LAS float* rkp = sm + 18688; LAS float* hs = sm + 22784;
    __syncthreads();
    for (int i = tid; i < 8 * RWC; i += 512) { const int j = i / RWC, c = i - j * RWC, t = tb + j;
        const float cur = P[(size_t)t * NPC + 1536 + c], prev = t > 0 ? P[(size_t)(t - 1) * NPC + 1536 + c] : 0.f;
        xs[i] = cur + (prev - cur) * w.mu()[c]; }
    __syncthreads();
    { const int j = tid >> 6, ii = tid & 63; xs[j * RWC + 1536 + ii] = tanhf(xs[j * RWC + 1536 + ii]);
      xs[j * RWC + 1664 + ii] = sigmoidf_(xs[j * RWC + 1664 + ii]); xs[j * RWC + 1728 + ii] = sigmoidf_(xs[j * RWC + 1728 + ii]); }
    if (L > 0 && tid < 256) { const int j = tid >> 5, r = tid & 31; float acc = 0.f;
        for (int c = 0; c < 512; ++c) acc += xs[j * RWC + 1024 + c] * w.v1()[c * 32 + r];
        t1[j * 32 + r] = acc; }
    __syncthreads();
    const int n = tid; float aw[8], aa[8], ag[8];
#pragma unroll
    for (int j = 0; j < 8; ++j) { aw[j] = 0.f; aa[j] = 0.f; ag[j] = 0.f; }
    for (int i = 0; i < 64; ++i) { const float x2 = w.w2()[i * 512 + n], y2 = w.a2()[i * 512 + n];
#pragma unroll
        for (int j = 0; j < 8; ++j) { aw[j] += xs[j * RWC + 1536 + i] * x2; aa[j] += xs[j * RWC + 1600 + i] * y2; } }
    for (int i = 0; i < 128; ++i) { const float z2 = w.g2()[i * 512 + n];
#pragma unroll
        for (int j = 0; j < 8; ++j) ag[j] += xs[j * RWC + 1664 + i] * z2; }
    float av[8], vv[8];
#pragma unroll
    for (int j = 0; j < 8; ++j) {
        const int t = tb + j; const size_t gr = (size_t)(rb + t), o = (size_t)t * 512 + n;
        const float wpre = w.w0()[n] + aw[j]; const float xn = -wpre; const float sp = fmaxf(xn, 0.f) + log1pf(__expf(-fabsf(xn)));
        const float wl = -sp - 0.5f; const float decay = __expf(-__expf(wl));
        const float a = sigmoidf_(w.a0()[n] + aa[j]);
        const float r = xs[j * RWC + n], k = xs[j * RWC + 512 + n]; float v = xs[j * RWC + 1024 + n];
        if (L == 0) VF[gr * 512 + n] = v;
        else { float acc = w.v0()[n];
#pragma unroll 8
            for (int q = 0; q < 32; ++q) acc += t1[j * 32 + q] * w.v2()[q * 512 + n];
            const float vf = VF[gr * 512 + n]; v = v + (vf - v) * sigmoidf_(acc); }
        const float kx = k * (1.f + (a - 1.f) * w.ka()[n]);
        kkp[j * 512 + n] = k * w.kk()[n]; rkp[j * 512 + n] = r * kx * w.rk()[n];
        ar.R[o] = r; ar.W[o] = decay; ar.KX[o] = kx; ar.VV[o] = v; ar.GG[o] = ag[j];
        av[j] = a; vv[j] = v;
    }
    __syncthreads();
    if (tid < 64) { const int j = tid >> 3, h = tid & 7; float s1 = 0.f, s2 = 0.f;
        for (int c = 0; c < 64; ++c) { const float x = kkp[j * 512 + h * 64 + c]; s1 += x * x; s2 += rkp[j * 512 + h * 64 + c]; }
        hs[(j * 8 + h) * 2] = s1; hs[(j * 8 + h) * 2 + 1] = s2; }
    __syncthreads();
#pragma unroll
    for (int j = 0; j < 8; ++j) { const int h = n >> 6; const size_t o = (size_t)(tb + j) * 512 + n;
        const float rinv = __builtin_amdgcn_rsqf(fmaxf(hs[(j * 8 + h) * 2], 1e-24f)); const float kk = kkp[j * 512 + n] * rinv;
        ar.A[o] = -kk; ar.B[o] = kk * av[j]; ar.BN[o] = hs[(j * 8 + h) * 2 + 1] * vv[j]; }
}

__device__ __forceinline__ void rw_scan_row(const RwArr& ar, float* YR, int h, int i, int lane) {
    float S = 0.f; const int cb = h * 64;
    for (int t0 = 0; t0 < TB; t0 += 8) {
        float a[8], b[8], wd[8], kx[8], r[8], v[8];
#pragma unroll
        for (int j = 0; j < 8; ++j) { const size_t o = (size_t)(t0 + j) * 512 + cb;
            a[j] = ar.A[o + lane]; b[j] = ar.B[o + lane]; wd[j] = ar.W[o + lane]; kx[j] = ar.KX[o + lane]; r[j] = ar.R[o + lane]; v[j] = ar.VV[o + i]; }
#pragma unroll
        for (int j = 0; j < 8; ++j) {
            const float sa = wave_sum(S * a[j]);
            S = S * wd[j] + sa * b[j] + v[j] * kx[j];
            const float y = wave_sum(S * r[j]);
            if (lane == 0) YR[(size_t)(t0 + j) * 512 + cb + i] = y;
        }
    }
}
__device__ __forceinline__ void rw_out_unit(const LayerW& w, const float* YR, const RwArr& ar, bf16_t* YC, int tb, LAS float* sm) {
    const int tid = tid_opaque(), n = tid;
    __syncthreads();
    for (int j = 0; j < 8; ++j) sm[j * 512 + n] = YR[(size_t)(tb + j) * 512 + n];
    __syncthreads();
    const int hb = n & ~63;
    for (int j = 0; j < 8; ++j) { float mean = 0.f;
        for (int c = 0; c < 64; ++c) mean += sm[j * 512 + hb + c];
        mean *= (1.f / 64.f); float var = 0.f;
        for (int c = 0; c < 64; ++c) { const float d = sm[j * 512 + hb + c] - mean; var += d * d; }
        var *= (1.f / 64.f);
        const size_t o = (size_t)(tb + j) * 512 + n;
        const float y = (sm[j * 512 + n] - mean) * __builtin_amdgcn_rsqf(var + 64e-5f) * w.lng()[n] + w.lnb()[n];
        YC[o] = (bf16_t)f2bf((y + ar.BN[o]) * ar.GG[o]); }
}

__device__ __forceinline__ void mla_unit_ab(const LayerW& w, const bf16_t* PM, const float* cosT, const float* sinT, bf16_t* Q, bf16_t* K, bf16_t* Vt, int t0, LAS float* sm) {
    const int tid = tid_opaque(), lane = tid & 63, wv = tid >> 6;
    LAS float* a = sm; LAS float* kpe = sm + 3072; LAS float* out = sm + 3328;
    __syncthreads();
    { const bf16_t* row = PM + (size_t)(t0 + wv) * 512;
      const u32x2 q4 = *(const u32x2*)(row + lane * 4); const float v0 = bflo(q4.x), v1 = bfhi(q4.x), v2 = bflo(q4.y), v3 = bfhi(q4.y);
      float ss = wave_sum((v0 * v0 + v1 * v1) + (v2 * v2 + v3 * v3)); float rs = __builtin_amdgcn_rsqf(ss * (1.f / 256.f) + EPS);
      a[wv * 384 + lane * 4] = v0 * rs * w.qan()[lane * 4]; a[wv * 384 + lane * 4 + 1] = v1 * rs * w.qan()[lane * 4 + 1]; a[wv * 384 + lane * 4 + 2] = v2 * rs * w.qan()[lane * 4 + 2]; a[wv * 384 + lane * 4 + 3] = v3 * rs * w.qan()[lane * 4 + 3];
      const unsigned k2 = *(const unsigned*)(row + 256 + lane * 2); const float c0 = bflo(k2), c1 = bfhi(k2);
      ss = wave_sum(c0 * c0 + c1 * c1); rs = __builtin_amdgcn_rsqf(ss * (1.f / 128.f) + EPS);
      a[wv * 384 + 256 + lane * 2] = c0 * rs * w.kvan()[lane * 2]; a[wv * 384 + 256 + lane * 2 + 1] = c1 * rs * w.kvan()[lane * 2 + 1];
      if (lane < 32) kpe[wv * 32 + lane] = bf2f(row[384 + lane]); }
    __syncthreads();
    for (int n = tid; n < 1792; n += 512) {
        float acc[8];
#pragma unroll
        for (int j = 0; j < 8; ++j) acc[j] = 0.f;
        if (n < 768) { for (int k = 0; k < 256; ++k) { const float ww = w.wuq()[(size_t)k * 768 + n];
#pragma unroll
                for (int j = 0; j < 8; ++j) acc[j] += a[j * 384 + k] * ww; } }
        else { for (int k = 0; k < 128; ++k) { const float ww = w.wukv()[(size_t)k * 1024 + (n - 768)];
#pragma unroll
                for (int j = 0; j < 8; ++j) acc[j] += a[j * 384 + 256 + k] * ww; } }
#pragma unroll
        for (int j = 0; j < 8; ++j) out[j * 1792 + n] = acc[j];
    }
    __syncthreads();
    if (tid < 64) {
        const int j = tid >> 3, h = tid & 7, t = t0 + j, b = t / SEQ, ts = t - b * SEQ;
        const LAS float* q = out + j * 1792 + h * 96; float ss = 0.f;
        for (int d = 0; d < 96; ++d) ss += q[d] * q[d];
        float rs = __builtin_amdgcn_rsqf(ss * (1.f / 96.f) + EPS);
        bf16_t* qo = Q + (size_t)t * 768 + h * 96;
        for (int d = 0; d < 64; ++d) qo[d] = (bf16_t)f2bf(q[d] * rs * w.qn()[d] * ATT_SC);
        for (int i = 0; i < 16; ++i) { const float x1 = q[64 + i] * rs * w.qn()[64 + i], x2 = q[80 + i] * rs * w.qn()[80 + i], c = cosT[(size_t)t * 16 + i], sn = sinT[(size_t)t * 16 + i];
            qo[64 + i] = (bf16_t)f2bf((x1 * c - x2 * sn) * ATT_SC); qo[80 + i] = (bf16_t)f2bf((x2 * c + x1 * sn) * ATT_SC); }
        const LAS float* kn = out + j * 1792 + 768 + h * 128; const LAS float* kp = kpe + j * 32; ss = 0.f;
        for (int d = 0; d < 64; ++d) ss += kn[d] * kn[d];
        for (int i = 0; i < 32; ++i) ss += kp[i] * kp[i];
        rs = __builtin_amdgcn_rsqf(ss * (1.f / 96.f) + EPS);
        bf16_t* ko = K + (size_t)t * 768 + h * 96;
        for (int d = 0; d < 64; ++d) ko[d] = (bf16_t)f2bf(kn[d] * rs * w.kn()[d]);
        for (int i = 0; i < 16; ++i) { const float x1 = kp[i] * rs * w.kn()[64 + i], x2 = kp[16 + i] * rs * w.kn()[80 + i], c = cosT[(size_t)t * 16 + i], sn = sinT[(size_t)t * 16 + i];
            ko[64 + i] = (bf16_t)f2bf(x1 * c - x2 * sn); ko[80 + i] = (bf16_t)f2bf(x2 * c + x1 * sn); }
        for (int d = 0; d < 64; ++d) Vt[((size_t)(b * 8 + h) * 64 + d) * SEQ + ts] = (bf16_t)f2bf(kn[64 + d]);
    }
}
__device__ __forceinline__ void sg_mix_ab(const LayerW& w, bf16_t* PS, const float* SGQ, int c, int g, LAS float* sm, bf16_t* dst = nullptr) {
    const int tid = tid_opaque(); LAS float* Wl = sm; LAS float* vn = sm + 16384;
    __syncthreads();
    for (int i = tid; i < 16384; i += 512) Wl[i] = w.sgws()[(size_t)g * 16384 + i];
    for (int i = tid; i < 8192; i += 512) { const int s = i >> 6, cc = i & 63; const int t = c * 128 + s;
        const f32x4 q0 = *(const f32x4*)(SGQ + (size_t)t * 8), q1 = *(const f32x4*)(SGQ + (size_t)t * 8 + 4);
        const float rs = __builtin_amdgcn_rsqf((((q0[0] + q0[1]) + (q0[2] + q0[3])) + ((q1[0] + q1[1]) + (q1[2] + q1[3]))) * (1.f / 512.f) + EPS);
        vn[i] = bf2f(PS[(size_t)t * 1024 + 512 + g * 64 + cc]) * rs * w.sgvn()[g * 64 + cc]; }
    __syncthreads();
    const int cc = tid & 63, tq = tid >> 6;
    for (int tt = 0; tt < 16; ++tt) { const int tl = tq + 8 * tt; float acc = 0.f;
        for (int s = 0; s <= tl; ++s) acc += Wl[tl * 128 + s] * vn[s * 64 + cc];
        const int t = c * 128 + tl; const float mixed = acc + w.sgbs()[g * 128 + tl]; bf16_t* up = PS + (size_t)t * 1024 + g * 64 + cc;
        const bf16_t o = (bf16_t)f2bf(bf2f(*up) * mixed); if (dst) dst[(size_t)t * 512 + g * 64 + cc] = o; else *up = o; }
}
typedef short bf16x8 __attribute__((ext_vector_type(8)));
typedef short s16x4 __attribute__((ext_vector_type(4)));
typedef float f32x16 __attribute__((ext_vector_type(16)));
typedef float f32x2v __attribute__((ext_vector_type(2)));
constexpr int AT_KSLOT = 12288, AT_VSLOT = 8192, AT_LK = 0, AT_LV = 4 * AT_KSLOT, AT_LDS = AT_LV + 3 * AT_VSLOT;
constexpr float AT_THR = 8.f;
__device__ __forceinline__ int crow(int r, int hi) { return (r & 3) + 8 * (r >> 2) + 4 * hi; }
#define AT_SBAR() __builtin_amdgcn_sched_barrier(0)
#define AT_PIN(x) asm volatile("" : "+v"(x))
#define AT_MFMA(a, b, c) __builtin_amdgcn_mfma_f32_32x32x16_bf16((a), (b), (c), 0, 0, 0)
#define AT_WB(N) asm volatile("s_waitcnt vmcnt(" #N ") lgkmcnt(0)\n\ts_barrier" ::: "memory")
__device__ __forceinline__ void at_glds16(const void* g, unsigned lds_base) {
    unsigned sv; asm volatile("s_mov_b32 %0, m0\n\ts_mov_b32 m0, %2\n\ts_nop 0\n\tglobal_load_lds_dwordx4 %1, off\n\ts_mov_b32 m0, %0" : "=&s"(sv) : "v"(g), "s"(lds_base) : "memory"); }
__device__ __forceinline__ void at_kload2(bf16x8* kf, const LAS unsigned char* kp, int d0) { kf[2 * d0] = *(const LAS bf16x8*)(kp + d0 * 2048); kf[2 * d0 + 1] = *(const LAS bf16x8*)(kp + d0 * 2048 + 512); }
__device__ __forceinline__ void at_scale(f32x16& c, float a) {
    const f32x2v aa = {a, a};
#pragma unroll
    for (int i = 0; i < 8; ++i) { f32x2v t = {c[2 * i], c[2 * i + 1]}; t = t * aa; c[2 * i] = t.x; c[2 * i + 1] = t.y; }
}
#define AT_MX3(a, b, c) __builtin_fmaxf(__builtin_fmaxf((a), (b)), (c))
__device__ __forceinline__ float at_rowmax(const f32x16& p0, const f32x16& p1) {
    float a = AT_MX3(p0[0], p0[1], p1[0]), b = AT_MX3(p0[2], p0[3], p1[1]); a = AT_MX3(a, p1[2], p1[3]);
#pragma unroll
    for (int r = 4; r < 16; r += 4) { a = AT_MX3(a, p0[r], p0[r + 1]); b = AT_MX3(b, p0[r + 2], p0[r + 3]); a = AT_MX3(a, p1[r], p1[r + 1]); b = AT_MX3(b, p1[r + 2], p1[r + 3]); }
    const float m = __builtin_fmaxf(a, b); const u32x2 rr = __builtin_amdgcn_permlane32_swap(__float_as_uint(m), __float_as_uint(m), false, false);
    return __builtin_fmaxf(__uint_as_float(rr.x), __uint_as_float(rr.y)); }
__device__ __forceinline__ void at_cmask(f32x16& p0, f32x16& p1, int jb, int qrel, int hi) {
    const int kb = 64 * jb + 4 * hi;
#pragma unroll
    for (int r = 0; r < 16; ++r) { const int kv = kb + (r & 3) + 8 * (r >> 2); if (kv > qrel) p0[r] = -INFINITY; if (kv + 32 > qrel) p1[r] = -INFINITY; } }

__device__ __forceinline__ void attn_unit(const bf16_t* Qb, const bf16_t* Kb, const bf16_t* Vt, bf16_t* YA, int ya_pitch, int tok0, int bh, int h, int qb, LAS unsigned char* sm) {
    const int tid = tid_opaque(), lane = tid & 63, wid = __builtin_amdgcn_readfirstlane(tid >> 6), r32 = lane & 31, hi = lane >> 5;
    const bool wlow = wid < 4;
    const int q0 = qb * 256, NT = 4 * (qb + 1), qrel = wid * 32 + r32, qrow = q0 + qrel;
    const unsigned lds0 = (unsigned)(uintptr_t)sm;
    const bf16_t* ksrc = Kb + (size_t)(tok0 + lane) * 768 + h * 96 + wid * 8;
    const bf16_t* vsrc = Vt + ((size_t)bh * 64 + lane) * SEQ + wid * 8;
    const unsigned kdst = lds0 + AT_LK + wid * 1024, vdst = lds0 + AT_LV + wid * 1024;
#define AT_DMA_K(t, sl) do { at_glds16(ksrc + (size_t)(t) * 64 * 768, (unsigned)__builtin_amdgcn_readfirstlane(kdst + (sl) * AT_KSLOT)); \
        if (wlow) at_glds16(ksrc + (size_t)(t) * 64 * 768 + 64, (unsigned)__builtin_amdgcn_readfirstlane(kdst + 8192 + (sl) * AT_KSLOT)); } while (0)
#define AT_DMA_V(t, sl) at_glds16(vsrc + (t) * 64, (unsigned)__builtin_amdgcn_readfirstlane(vdst + (sl) * AT_VSLOT))
#define AT_WAITB(NLO, NHI) do { if (wlow) { AT_WB(NLO); } else { AT_WB(NHI); } } while (0)
    const LAS unsigned char* vp0 = sm + AT_LV + hi * 1024 + r32 * 16;
    const LAS unsigned char* kp0 = sm + AT_LK + hi * 1024 + r32 * 16;
    AT_DMA_K(0, 0); AT_DMA_V(0, 0); AT_DMA_K(1, 1);
    bf16x8 qr[6];
    { const bf16_t* qp = Qb + (size_t)(tok0 + qrow) * 768 + h * 96 + hi * 8;
#pragma unroll
      for (int d0 = 0; d0 < 6; ++d0) qr[d0] = *(const bf16x8*)(qp + d0 * 16); }
    float mhat = 0.f, l_reg = 0.f, fsc = 1.f; f32x16 o0 = {}, o1 = {}; const f32x16 zero16 = {};
    bool resc = false;
    f32x16 pA0, pA1, pB0, pB1; bf16x8 kf[12], vf[8]; u32x4 pw0, pw1, pw2, pw3;
    int sl_prev = 0, sl_cur = 0, sl_next = 1;
#define AT_ROT() do { sl_prev = sl_cur; sl_cur = sl_next; sl_next = (sl_next == 2) ? 0 : sl_next + 1; } while (0)
#define AT_RESC() do { if (resc) { at_scale(o0, fsc); at_scale(o1, fsc); } } while (0)
    AT_DMA_K(2, 2); AT_DMA_K(3, 3);
    AT_WAITB(7, 4);
#pragma unroll
    for (int d0 = 0; d0 < 6; ++d0) at_kload2(kf, kp0, d0);
    pA0 = AT_MFMA(kf[0], qr[0], zero16); pA1 = AT_MFMA(kf[1], qr[0], zero16);
#pragma unroll
    for (int d0 = 1; d0 < 6; ++d0) { pA0 = AT_MFMA(kf[2 * d0], qr[d0], pA0); pA1 = AT_MFMA(kf[2 * d0 + 1], qr[d0], pA1); }
    if (NT == 4) at_cmask(pA0, pA1, 0, qrel, hi);
    { mhat = at_rowmax(pA0, pA1);
#pragma unroll
      for (int r = 0; r < 16; ++r) { pA0[r] = __builtin_amdgcn_exp2f(pA0[r] - mhat); pA1[r] = __builtin_amdgcn_exp2f(pA1[r] - mhat); } }
    AT_WB(0);
    AT_DMA_V(1, 1); AT_ROT();
#pragma unroll
    for (int d0 = 0; d0 < 4; ++d0) at_kload2(kf, kp0 + AT_KSLOT, d0);
    AT_WB(1);
#define AT_PKW(P, i) pg8::cvt_pk_bf16(P[i], P[i + 1])
#define AT_PB(k) __builtin_bit_cast(bf16x8, pw##k)
#define AT_VRD(i) do { vf[i] = *(const LAS bf16x8*)(vp_ + ((i) & 3) * 2048 + ((i) >> 2) * 512); } while (0)
#define AT_KRD(G, d0) do { if (G) { at_kload2(kf, kn_, d0); AT_SBAR(); } } while (0)
#define AT_GAPA(MF, P, i, PW, j) do { MF; sacc = sacc + (f32x2v){P[i], P[i + 1]}; sacc = sacc + (f32x2v){P[i + 2], P[i + 3]}; PW[j] = AT_PKW(P, i); PW[j + 1] = AT_PKW(P, i + 2); AT_PIN(PW); AT_PIN(sacc); AT_SBAR(); } while (0)
#define AT_GAPM(MF) do { MF; AT_SBAR(); } while (0)
#define AT_GAPB(MF, X, i) do { MF; { f32x2v t0_ = (f32x2v){X[i], X[i + 1]} + nmh2, t1_ = (f32x2v){X[i + 2], X[i + 3]} + nmh2; \
        X[i] = __builtin_amdgcn_exp2f(t0_.x); X[i + 1] = __builtin_amdgcn_exp2f(t0_.y); X[i + 2] = __builtin_amdgcn_exp2f(t1_.x); X[i + 3] = __builtin_amdgcn_exp2f(t1_.y); } AT_PIN(X); AT_SBAR(); } while (0)
#define AT_STEP(C0, C1, P0, P1, t, MASK, GK, GV, GL, WY) do { AT_SBAR(); \
    const LAS unsigned char* vp_ = vp0 + sl_prev * AT_VSLOT; f32x2v sacc = {0.f, 0.f}; \
    const LAS unsigned char* kc_ = kp0 + ((t) & 3) * AT_KSLOT; const LAS unsigned char* kn_ = kp0 + (((t) + 1) & 3) * AT_KSLOT; \
    AT_VRD(0); at_kload2(kf, kc_, 4); AT_SBAR(); AT_GAPA(C0 = AT_MFMA(kf[0], qr[0], zero16), P0, 0,  pw0, 0); \
    AT_VRD(4); AT_SBAR(); AT_GAPA(C1 = AT_MFMA(kf[1], qr[0], zero16), P0, 4,  pw0, 2); \
    AT_VRD(1); at_kload2(kf, kc_, 5); AT_SBAR(); AT_GAPA(C0 = AT_MFMA(kf[2], qr[1], C0),     P0, 8,  pw1, 0); \
    AT_VRD(5); AT_SBAR(); AT_GAPA(C1 = AT_MFMA(kf[3], qr[1], C1),     P0, 12, pw1, 2); \
    AT_VRD(2); AT_SBAR(); AT_GAPA(C0 = AT_MFMA(kf[4], qr[2], C0),     P1, 0,  pw2, 0); \
    AT_VRD(6); AT_SBAR(); AT_GAPA(C1 = AT_MFMA(kf[5], qr[2], C1),     P1, 4,  pw2, 2); \
    AT_VRD(3); AT_SBAR(); AT_GAPA(C0 = AT_MFMA(kf[6], qr[3], C0),     P1, 8,  pw3, 0); \
    AT_VRD(7); AT_SBAR(); AT_GAPA(C1 = AT_MFMA(kf[7], qr[3], C1),     P1, 12, pw3, 2); \
    AT_GAPM(C0 = AT_MFMA(kf[8], qr[4], C0)); AT_GAPM(C1 = AT_MFMA(kf[9], qr[4], C1)); AT_GAPM(C0 = AT_MFMA(kf[10], qr[5], C0)); AT_GAPM(C1 = AT_MFMA(kf[11], qr[5], C1)); \
    l_reg += sacc.x + sacc.y; \
    if (GK) AT_DMA_K((t) + 3, ((t) + 3) & 3); if (GV) AT_DMA_V((t) + 1, sl_next);                             \
    if (MASK) at_cmask(C0, C1, (t) - (NT - 4), qrel, hi); \
    { const float rm = at_rowmax(C0, C1) - mhat; resc = false;                                                \
      if (__builtin_expect(__any(rm > AT_THR), 0)) { const float dl = __builtin_fmaxf(rm, 0.f); mhat += dl;     \
          fsc = __builtin_amdgcn_exp2f(-dl); l_reg *= fsc; resc = true; } } \
    const f32x2v nmh2 = {-mhat, -mhat}; if (!wlow) { WY; } AT_SBAR();                                       \
    AT_GAPB(o0 = AT_MFMA(vf[0], AT_PB(0), o0), C0, 0);                   AT_GAPB(o1 = AT_MFMA(vf[4], AT_PB(0), o1), C0, 4); \
    AT_KRD(GL, 0); AT_GAPB(o0 = AT_MFMA(vf[1], AT_PB(1), o0), C0, 8);    AT_KRD(GL, 1); AT_GAPB(o1 = AT_MFMA(vf[5], AT_PB(1), o1), C0, 12); \
    AT_KRD(GL, 2); AT_GAPB(o0 = AT_MFMA(vf[2], AT_PB(2), o0), C1, 0);    AT_KRD(GL, 3); AT_GAPB(o1 = AT_MFMA(vf[6], AT_PB(2), o1), C1, 4); \
    AT_GAPB(o0 = AT_MFMA(vf[3], AT_PB(3), o0), C1, 8);                   AT_GAPB(o1 = AT_MFMA(vf[7], AT_PB(3), o1), C1, 12); \
    } while (0)
    int t = 1;
    for (; t + 5 < NT; t += 2) {
        AT_STEP(pB0, pB1, pA0, pA1, t, false, true, true, true, AT_WB(2));     if (wlow) { AT_WB(3); } AT_RESC(); AT_ROT();
        AT_STEP(pA0, pA1, pB0, pB1, t + 1, false, true, true, true, AT_WB(2)); if (wlow) { AT_WB(3); } AT_RESC(); AT_ROT();
    }
#define AT_ENDW(tt, NK) do { if ((tt) + 3 < NT) { AT_WB(NK); } else if ((tt) + 2 < NT) { AT_WB(1); } else { AT_WB(0); } } while (0)
    for (; t + 1 < NT; t += 2) {
        AT_STEP(pB0, pB1, pA0, pA1, t, true, (t + 3 < NT), (t + 1 < NT), (t + 1 < NT), AT_ENDW(t, 2));             if (wlow) { AT_ENDW(t, 3); }     AT_RESC(); AT_ROT();
        AT_STEP(pA0, pA1, pB0, pB1, t + 1, true, (t + 4 < NT), (t + 2 < NT), (t + 2 < NT), AT_ENDW(t + 1, 2));     if (wlow) { AT_ENDW(t + 1, 3); } AT_RESC(); AT_ROT();
    }
    AT_STEP(pB0, pB1, pA0, pA1, NT - 1, true, false, false, false, (void)0); AT_RESC();
    { f32x2v sacc = {0.f, 0.f};
#pragma unroll
      for (int r = 0; r < 16; r += 2) { sacc = sacc + (f32x2v){pB0[r], pB0[r + 1]}; sacc = sacc + (f32x2v){pB1[r], pB1[r + 1]}; }
      l_reg += sacc.x + sacc.y;
      pw0 = (u32x4){AT_PKW(pB0, 0), AT_PKW(pB0, 2), AT_PKW(pB0, 4), AT_PKW(pB0, 6)}; pw1 = (u32x4){AT_PKW(pB0, 8), AT_PKW(pB0, 10), AT_PKW(pB0, 12), AT_PKW(pB0, 14)};
      pw2 = (u32x4){AT_PKW(pB1, 0), AT_PKW(pB1, 2), AT_PKW(pB1, 4), AT_PKW(pB1, 6)}; pw3 = (u32x4){AT_PKW(pB1, 8), AT_PKW(pB1, 10), AT_PKW(pB1, 12), AT_PKW(pB1, 14)};
      const LAS unsigned char* vp_ = vp0 + sl_cur * AT_VSLOT;
#pragma unroll
      for (int i = 0; i < 8; ++i) AT_VRD(i);
      o0 = AT_MFMA(vf[0], AT_PB(0), o0); o1 = AT_MFMA(vf[4], AT_PB(0), o1); o0 = AT_MFMA(vf[1], AT_PB(1), o0); o1 = AT_MFMA(vf[5], AT_PB(1), o1);
      o0 = AT_MFMA(vf[2], AT_PB(2), o0); o1 = AT_MFMA(vf[6], AT_PB(2), o1); o0 = AT_MFMA(vf[3], AT_PB(3), o0); o1 = AT_MFMA(vf[7], AT_PB(3), o1); }
    { const u32x2 rr = __builtin_amdgcn_permlane32_swap(__float_as_uint(l_reg), __float_as_uint(l_reg), false, false); l_reg = __uint_as_float(rr.x) + __uint_as_float(rr.y); }
    const float il = 1.f / l_reg;
    bf16_t* op = YA + (size_t)(tok0 + qrow) * ya_pitch + h * 64 + 4 * hi;
#pragma unroll
    for (int g = 0; g < 4; ++g) {
        u32x2 w0; w0.x = pg8::cvt_pk_bf16(o0[4 * g] * il, o0[4 * g + 1] * il); w0.y = pg8::cvt_pk_bf16(o0[4 * g + 2] * il, o0[4 * g + 3] * il);
        u32x2 w1; w1.x = pg8::cvt_pk_bf16(o1[4 * g] * il, o1[4 * g + 1] * il); w1.y = pg8::cvt_pk_bf16(o1[4 * g + 2] * il, o1[4 * g + 3] * il);
        *(u32x2*)(op + 8 * g) = w0; *(u32x2*)(op + 32 + 8 * g) = w1;
    }
    asm volatile("s_waitcnt lgkmcnt(0)\n\ts_barrier" ::: "memory");
#undef AT_DMA_K
#undef AT_DMA_V
#undef AT_WAITB
#undef AT_ROT
#undef AT_RESC
#undef AT_PKW
#undef AT_PB
#undef AT_VRD
#undef AT_KRD
#undef AT_GAPA
#undef AT_GAPM
#undef AT_GAPB
#undef AT_STEP
#undef AT_ENDW
}
constexpr int RW_C = 64, RW_NC = SEQ / RW_C;
constexpr int RP = 72;
constexpr int RPG = 136;
constexpr int RF = 68;
constexpr int RFR = 132;
constexpr size_t OW_W2T = OW_END, OW_A2T = OW_W2T + 512 * 64, OW_G2T = OW_A2T + 512 * 64, OW_XEND_RW = OW_G2T + 512 * 128, OW_XEND = OW_XEND_RW + 512 * 32;
static_assert(OW_XEND * 2 <= 52 * MiB, "weights fit");

__device__ __forceinline__ void conv_small(const LayerW& w, bf16_t* W, int gtid, int NT) {
    for (int i = gtid; i < 512 * 64; i += NT) { const int n = i >> 6, k = i & 63; W[OW_W2T + i] = (bf16_t)f2bf(w.w2()[k * 512 + n]); W[OW_A2T + i] = (bf16_t)f2bf(w.a2()[k * 512 + n]); }
    for (int i = gtid; i < 512 * 128; i += NT) { const int n = i >> 7, k = i & 127; W[OW_G2T + i] = (bf16_t)f2bf(w.g2()[k * 512 + n]); }
    if (w.L > 0) for (int i = gtid; i < 512 * 32; i += NT) { const int n = i >> 5, q = i & 31; W[OW_XEND_RW + i] = (bf16_t)f2bf(w.v2()[q * 512 + n]); }
}

template <class PL> __device__ __forceinline__ void rw_t1_rows(const LayerW& w, const PL& pl, float* T1, int ntok, int gw, int NGW, int lane) {
    for (int tp = gw; tp < ntok / 2; tp += NGW) { const int t = 2 * tp + (lane >> 5), r = lane & 31; const int ts = t & (SEQ - 1); float acc = 0.f;
        for (int c = 0; c < 512; ++c) { const float cur = pl.ld(t, 1024 + c), prev = ts > 0 ? pl.ld(t - 1, 1024 + c) : 0.f; acc += (cur + (prev - cur) * w.mu()[1024 + c]) * w.v1()[c * 32 + r]; }
        T1[(size_t)t * 32 + r] = acc; }
}

struct PLbf16 { const bf16_t* P; __device__ __forceinline__ float ld(int t, int c) const { return bf2f(P[(size_t)t * RWC + c]); } };
struct PLf32 { const float* P; __device__ __forceinline__ float ld(int t, int c) const { return P[(size_t)t * NPC + 1536 + c]; } };

struct RwBufs { bf16_t* PCORR; bf16_t* HL; float* GC; bf16_t* GX; };

__device__ __forceinline__ f32x16 zero16() { f32x16 z;
#pragma unroll
    for (int r = 0; r < 16; ++r) z[r] = 0.f; return z; }
template <int KS, class PA, class PB> __device__ __forceinline__ f32x16 mm32(PA a, PB b, f32x16 acc) {
#pragma unroll
    for (int s = 0; s < KS; ++s) acc = __builtin_amdgcn_mfma_f32_32x32x16_bf16(*(const bf16x8*)((const bf16_t*)a + 16 * s), *(const bf16x8*)((const bf16_t*)b + 16 * s), acc, 0, 0, 0);
    return acc;
}
template <int KS> __device__ __forceinline__ f32x16 mm32_ll(const LAS bf16_t* a, const LAS bf16_t* b, f32x16 acc) {
#pragma unroll
    for (int s = 0; s < KS; ++s) acc = __builtin_amdgcn_mfma_f32_32x32x16_bf16(*(const LAS bf16x8*)(a + 16 * s), *(const LAS bf16x8*)(b + 16 * s), acc, 0, 0, 0);
    return acc;
}
template <int KS> __device__ __forceinline__ f32x16 mm32_lg(const LAS bf16_t* a, const bf16_t* b, f32x16 acc) {
#pragma unroll
    for (int s = 0; s < KS; ++s) acc = __builtin_amdgcn_mfma_f32_32x32x16_bf16(*(const LAS bf16x8*)(a + 16 * s), *(const bf16x8*)(b + 16 * s), acc, 0, 0, 0);
    return acc;
}

template <int KS> __device__ __forceinline__ f32x16 mm32_rr(const bf16x8 (&a)[KS], const bf16x8 (&b)[KS], f32x16 acc) {
#pragma unroll
    for (int s = 0; s < KS; ++s) acc = __builtin_amdgcn_mfma_f32_32x32x16_bf16(a[s], b[s], acc, 0, 0, 0);
    return acc;
}
template <int KS> __device__ __forceinline__ f32x16 mm32_lr(const LAS bf16_t* a, const bf16x8 (&b)[KS], f32x16 acc) {
#pragma unroll
    for (int s = 0; s < KS; ++s) acc = __builtin_amdgcn_mfma_f32_32x32x16_bf16(*(const LAS bf16x8*)(a + 16 * s), b[s], acc, 0, 0, 0);
    return acc;
}
#define LDS_BAR() asm volatile("s_waitcnt lgkmcnt(0)\n\ts_barrier" ::: "memory")
constexpr size_t OW_V2B = OW_XEND_RW;
__device__ __forceinline__ float group8_sum(float v) {
    v += __builtin_bit_cast(float, __builtin_amdgcn_update_dpp(0, __builtin_bit_cast(int, v), 0xB1, 0xF, 0xF, false));
    v += __builtin_bit_cast(float, __builtin_amdgcn_update_dpp(0, __builtin_bit_cast(int, v), 0x4E, 0xF, 0xF, false));
    v += __builtin_bit_cast(float, __builtin_amdgcn_update_dpp(0, __builtin_bit_cast(int, v), 0x141, 0xF, 0xF, false));
    return v;
}
__device__ __forceinline__ void unpack8(const u32x4 x, float (&e)[8]) { e[0] = bflo(x.x); e[1] = bfhi(x.x); e[2] = bflo(x.y); e[3] = bfhi(x.y); e[4] = bflo(x.z); e[5] = bfhi(x.z); e[6] = bflo(x.w); e[7] = bfhi(x.w); }
__device__ __forceinline__ u32x4 pack8(const float (&e)[8]) { u32x4 o; o.x = pk2h(e[0], e[1]); o.y = pk2h(e[2], e[3]); o.z = pk2h(e[4], e[5]); o.w = pk2h(e[6], e[7]); return o; }
__device__ __forceinline__ void ldc8(const LAS float* p, float (&e)[8]) { const f32x4 a = *(const LAS f32x4*)p, b = *(const LAS f32x4*)(p + 4); e[0] = a[0]; e[1] = a[1]; e[2] = a[2]; e[3] = a[3]; e[4] = b[0]; e[5] = b[1]; e[6] = b[2]; e[7] = b[3]; }
constexpr int CT_MR = 0, CT_MK = 64, CT_MV = 128, CT_MW = 192, CT_MA = 256, CT_MG = 320, CT_W0 = 448, CT_A0 = 512, CT_KK = 576, CT_KA = 640, CT_RK = 704, CT_V0 = 768, CT_LG = 832, CT_LB = 896;
__device__ __forceinline__ void rw_load_rows(const bf16_t* PR, int tok0, int h, int c, u32x4 (&cq)[7], u32x4 (&pq)[7]) {
    const int tid = tid_opaque(), lane = tid & 63, wv = __builtin_amdgcn_readfirstlane(tid >> 6);
    const int tq = 8 * wv + (lane >> 3), kc = 8 * (lane & 7), chn = h * 64 + kc;
    const bf16_t* rowc = PR + ((size_t)tok0 + c * RW_C + tq) * RWC; const bool hasp = (c > 0) || (tq > 0);
#pragma unroll
    for (int i = 0; i < 7; ++i) { const int col = i < 3 ? i * 512 + chn : 1536 + (i - 3) * 64 + kc;
        cq[i] = *(const u32x4*)(rowc + col); pq[i] = hasp ? *(const u32x4*)(rowc - RWC + col) : (u32x4){0u, 0u, 0u, 0u}; }
}
template <int PASS>
__device__ __forceinline__ void rw_chunk_unit(const LayerW& w, int L, const bf16_t* PR, const bf16_t* Wb, bf16_t* VF, const float* T1, const RwBufs& rb_, bf16_t* YC, int yc_pitch,
                                              int tok0, int bh, int h, int c, LAS unsigned char* sm, int cnext, bool first, u32x4 (&cq)[7], u32x4 (&pq)[7]) {
    const int tid = tid_opaque(), lane = tid & 63, wv = __builtin_amdgcn_readfirstlane(tid >> 6), r32 = lane & 31, hi = lane >> 5;
    LAS bf16_t* A_w = (LAS bf16_t*)(sm); LAS bf16_t* A_a = (LAS bf16_t*)(sm + 9216); LAS bf16_t* A_g = (LAS bf16_t*)(sm + 18432);
    LAS float* LPw = (LAS float*)(sm + 35840); LAS float* LPa = (LAS float*)(sm + 53248); LAS float* LPg = (LAS float*)(sm + 70656);
    LAS float* LPv = (LAS float*)(sm + 88064);
    LAS float* Aab = (LAS float*)(sm); LAS bf16_t* Aak = (LAS bf16_t*)(sm + 17408); LAS bf16_t* Arb = (LAS bf16_t*)(sm + 68608); LAS bf16_t* Ark = (LAS bf16_t*)(sm + 77824);
    LAS bf16_t* Xt = (LAS bf16_t*)(sm + 26624);
    LAS bf16_t* Lb = (LAS bf16_t*)(sm + 45056);
    LAS bf16_t* Tinv = (LAS bf16_t*)(sm + 54272);
    LAS float* Ylf = (LAS float*)(sm); LAS bf16_t* R2T = (LAS bf16_t*)(sm + 17408);
    LAS bf16_t* At = (LAS bf16_t*)(sm + 88064); LAS bf16_t* Bt = (LAS bf16_t*)(sm + 97280); LAS bf16_t* Kt = (LAS bf16_t*)(sm + 106496);
    LAS bf16_t* Rt = (LAS bf16_t*)(sm + 59392);
    LAS bf16_t* BtT = (LAS bf16_t*)(sm + 115712); LAS bf16_t* KtT = (LAS bf16_t*)(sm + 124928);
    LAS bf16_t* t1b = (LAS bf16_t*)(sm + 124928);
    LAS bf16_t* VtT = (LAS bf16_t*)(sm + 134144);
    LAS float* gC = (LAS float*)(sm + 143360); LAS float* tot = (LAS float*)(sm + 143616);
    LAS float* CT = (LAS float*)(sm + 145664);
    const int tq = 8 * wv + (lane >> 3), kc = 8 * (lane & 7), chn = h * 64 + kc;
    const size_t tok = (size_t)tok0 + c * RW_C + tq;
    const size_t chh = (size_t)bh * RW_NC + c;
    bf16x8 wf[4], gf[8], v2f[2]; f32x4 t1q = {0.f, 0.f, 0.f, 0.f}; u32x4 vfq = {0u, 0u, 0u, 0u};
    { const int pj = wv >> 2, cb = wv & 1; const bf16_t* bp = Wb + (pj ? OW_A2T : OW_W2T) + (size_t)(h * 64 + 32 * cb + r32) * 64 + 8 * hi;
#pragma unroll
      for (int s = 0; s < 4; ++s) wf[s] = *(const bf16x8*)(bp + 16 * s);
      if (wv < 4) { const bf16_t* bg = Wb + OW_G2T + (size_t)(h * 64 + 32 * cb + r32) * 128 + 8 * hi;
#pragma unroll
          for (int s = 0; s < 8; ++s) gf[s] = *(const bf16x8*)(bg + 16 * s); }
      if (L > 0) { if (wv < 4) { const bf16_t* vp = Wb + OW_V2B + (size_t)(h * 64 + 32 * cb + r32) * 32 + 8 * hi; v2f[0] = *(const bf16x8*)vp; v2f[1] = *(const bf16x8*)(vp + 16); }
                   t1q = *(const f32x4*)(T1 + tok * 32 + 4 * (lane & 7)); vfq = *(const u32x4*)(VF + tok * 512 + chn); } }
    if (first) {
        if (tid < 64) { CT[CT_MR + tid] = w.mu()[h * 64 + tid]; CT[CT_MK + tid] = w.mu()[512 + h * 64 + tid]; CT[CT_MV + tid] = w.mu()[1024 + h * 64 + tid]; CT[CT_MW + tid] = w.mu()[1536 + tid]; CT[CT_MA + tid] = w.mu()[1600 + tid]; }
        else if (tid < 192) CT[CT_MG + tid - 64] = w.mu()[1664 + tid - 64];
        else if (tid < 256) { const int q = tid - 192, n_ = h * 64 + q; CT[CT_W0 + q] = w.w0()[n_]; CT[CT_A0 + q] = w.a0()[n_]; CT[CT_KK + q] = w.kk()[n_]; CT[CT_KA + q] = w.ka()[n_]; }
        else if (tid < 320) { const int q = tid - 256, n_ = h * 64 + q; CT[CT_RK + q] = w.rk()[n_]; CT[CT_V0 + q] = L > 0 ? w.v0()[n_] : 0.f; CT[CT_LG + q] = w.lng()[n_]; CT[CT_LB + q] = w.lnb()[n_]; }
    }
    LDS_BAR();
    float rr[8], kq[8], vv[8];
    { float cu[8], pv_[8], mu[8], o[8];
      unpack8(cq[0], cu); unpack8(pq[0], pv_); ldc8(CT + CT_MR + kc, mu);
#pragma unroll
      for (int i = 0; i < 8; ++i) rr[i] = cu[i] + (pv_[i] - cu[i]) * mu[i];
      unpack8(cq[1], cu); unpack8(pq[1], pv_); ldc8(CT + CT_MK + kc, mu);
#pragma unroll
      for (int i = 0; i < 8; ++i) kq[i] = cu[i] + (pv_[i] - cu[i]) * mu[i];
      unpack8(cq[2], cu); unpack8(pq[2], pv_); ldc8(CT + CT_MV + kc, mu);
#pragma unroll
      for (int i = 0; i < 8; ++i) vv[i] = cu[i] + (pv_[i] - cu[i]) * mu[i];
      unpack8(cq[3], cu); unpack8(pq[3], pv_); ldc8(CT + CT_MW + kc, mu);
#pragma unroll
      for (int i = 0; i < 8; ++i) o[i] = tanh_fast(cu[i] + (pv_[i] - cu[i]) * mu[i]);
      *(LAS u32x4*)(A_w + tq * RP + kc) = pack8(o);
      unpack8(cq[4], cu); unpack8(pq[4], pv_); ldc8(CT + CT_MA + kc, mu);
#pragma unroll
      for (int i = 0; i < 8; ++i) o[i] = cu[i] + (pv_[i] - cu[i]) * mu[i];
      *(LAS u32x4*)(A_a + tq * RP + kc) = pack8(o);
      {
#pragma unroll
          for (int q = 0; q < 2; ++q) { unpack8(cq[5 + q], cu); unpack8(pq[5 + q], pv_); ldc8(CT + CT_MG + 64 * q + kc, mu);
#pragma unroll
              for (int i = 0; i < 8; ++i) o[i] = sigmoidf_(cu[i] + (pv_[i] - cu[i]) * mu[i]);
              *(LAS u32x4*)(A_g + tq * RPG + 64 * q + kc) = pack8(o); } }
      if (L > 0) { u32x2 t2; t2.x = pk2h(t1q[0], t1q[1]); t2.y = pk2h(t1q[2], t1q[3]); *(LAS u32x2*)(t1b + tq * 40 + 4 * (lane & 7)) = t2; } }
    LDS_BAR();
    { const int pj = wv >> 2, rb = (wv >> 1) & 1, cb = wv & 1;
      const LAS bf16_t* ap = (pj ? A_a : A_w) + (32 * rb + r32) * RP + 8 * hi;
      f32x16 acc = mm32_lr<4>(ap, wf, zero16());
      LAS float* lp = (pj ? LPa : LPw) + (32 * rb + 4 * hi) * RF + 32 * cb + r32;
#pragma unroll
      for (int r = 0; r < 16; ++r) lp[((r & 3) + 8 * (r >> 2)) * RF] = acc[r];
      if (wv < 4) { const LAS bf16_t* ag = A_g + (32 * rb + r32) * RPG + 8 * hi;
          f32x16 ag_ = mm32_lr<8>(ag, gf, zero16()); LAS float* lg = LPg + (32 * rb + 4 * hi) * RF + 32 * cb + r32;
#pragma unroll
          for (int r = 0; r < 16; ++r) lg[((r & 3) + 8 * (r >> 2)) * RF] = ag_[r]; }
      if (L > 0 && wv < 4) { f32x16 av_ = mm32_lr<2>(t1b + (32 * rb + r32) * 40 + 8 * hi, v2f, zero16()); LAS float* lv = LPv + (32 * rb + 4 * hi) * RF + 32 * cb + r32;
#pragma unroll
          for (int r = 0; r < 16; ++r) lv[((r & 3) + 8 * (r >> 2)) * RF] = av_[r]; } }
    LDS_BAR();
    float gg[8]; float bon = 0.f;
    { float lw[8], aa[8], kx[8], kkn[8], cl[8];
      { float lp[8], c0[8], c1[8]; float ssk = 0.f, sbn = 0.f;
        ldc8(LPw + tq * RF + kc, lp); ldc8(CT + CT_W0 + kc, c0);
#pragma unroll
        for (int i = 0; i < 8; ++i) lw[i] = -__expf(-softplus_fast(-(c0[i] + lp[i])) - 0.5f);
        ldc8(LPa + tq * RF + kc, lp); ldc8(CT + CT_A0 + kc, c0);
#pragma unroll
        for (int i = 0; i < 8; ++i) aa[i] = sigmoidf_(c0[i] + lp[i]);
        if (L > 0) { float vf[8]; unpack8(vfq, vf); ldc8(LPv + tq * RF + kc, lp); ldc8(CT + CT_V0 + kc, c0);
#pragma unroll
            for (int i = 0; i < 8; ++i) vv[i] = vv[i] + (vf[i] - vv[i]) * sigmoidf_(c0[i] + lp[i]); }
        else *(u32x4*)(VF + tok * 512 + chn) = pack8(vv);
        ldc8(CT + CT_KK + kc, c0); ldc8(CT + CT_KA + kc, c1);
#pragma unroll
        for (int i = 0; i < 8; ++i) { kkn[i] = kq[i] * c0[i]; ssk += kkn[i] * kkn[i]; kx[i] = kq[i] * (1.f + (aa[i] - 1.f) * c1[i]); }
        const float rinv = __builtin_amdgcn_rsqf(fmaxf(group8_sum(ssk), 1e-24f));
#pragma unroll
        for (int i = 0; i < 8; ++i) kkn[i] *= rinv;
        { ldc8(CT + CT_RK + kc, c0); ldc8(LPg + tq * RF + kc, gg);
#pragma unroll
            for (int i = 0; i < 8; ++i) sbn += rr[i] * kx[i] * c0[i];
            bon = group8_sum(sbn); } }
#pragma unroll
      for (int i = 0; i < 8; ++i) { float x = lw[i]; float t = __shfl_up(x, 8); if ((lane >> 3) >= 1) x += t; t = __shfl_up(x, 16); if ((lane >> 3) >= 2) x += t; t = __shfl_up(x, 32); if ((lane >> 3) >= 4) x += t; cl[i] = x; }
      if ((lane >> 3) == 7) { *(LAS f32x4*)(tot + wv * 64 + kc) = (f32x4){cl[0], cl[1], cl[2], cl[3]}; *(LAS f32x4*)(tot + wv * 64 + kc + 4) = (f32x4){cl[4], cl[5], cl[6], cl[7]}; }
      LDS_BAR();
      { float off[8];
#pragma unroll
        for (int i = 0; i < 8; ++i) off[i] = 0.f;
#pragma unroll
        for (int q = 0; q < 7; ++q) { float tq_[8]; ldc8(tot + q * 64 + kc, tq_);
#pragma unroll
            for (int i = 0; i < 8; ++i) off[i] += (q < wv) ? tq_[i] : 0.f; }
        float at[8], bt[8], kt[8], rt[8], gv[8];
#pragma unroll
        for (int i = 0; i < 8; ++i) { const float cj = off[i] + cl[i]; const float g = __expf(cj), gm1 = __expf(cj - lw[i]), gi = __expf(-cj);
            at[i] = -kkn[i] * gm1; bt[i] = kkn[i] * aa[i] * gi; kt[i] = kx[i] * gi; rt[i] = rr[i] * g; gv[i] = g; }
        const u32x4 pb_ = pack8(bt), pk_ = pack8(kt), pv_ = pack8(vv);
        *(LAS u32x4*)(Bt + tq * RP + kc) = pb_; *(LAS u32x4*)(Kt + tq * RP + kc) = pk_;
        *(LAS u32x4*)(Rt + tq * RP + kc) = pack8(rt);
        if (tq == 63) { *(LAS f32x4*)(gC + kc) = (f32x4){gv[0], gv[1], gv[2], gv[3]}; *(LAS f32x4*)(gC + kc + 4) = (f32x4){gv[4], gv[5], gv[6], gv[7]}; }
#pragma unroll
        for (int i = 0; i < 8; ++i) { const unsigned wv_ = (i & 1) ? (pv_[i >> 1] >> 16) : (pv_[i >> 1] & 0xffffu); VtT[(kc + i) * RP + tq] = (bf16_t)wv_; }
        { const u32x4 pa_ = pack8(at); *(LAS u32x4*)(At + tq * RP + kc) = pa_;
#pragma unroll
            for (int i = 0; i < 8; ++i) { const int sh = (i & 1) * 16; Xt[(kc + i) * RP + tq] = (bf16_t)((pa_[i >> 1] >> sh) & 0xffffu); BtT[(kc + i) * RP + tq] = (bf16_t)((pb_[i >> 1] >> sh) & 0xffffu); KtT[(kc + i) * RP + tq] = (bf16_t)((pk_[i >> 1] >> sh) & 0xffffu); } } } }
    LDS_BAR();
#pragma unroll
    for (int it = 0; it < 2; ++it) {
        const int blk = wv + 8 * it, rbk = blk >> 2, cbk = blk & 3;
        const LAS bf16_t* ap = (cbk < 2 ? Bt : Kt) + (32 * (cbk & 1) + r32) * RP + 8 * hi; const LAS bf16_t* bp = (rbk < 2 ? At : Rt) + (32 * (rbk & 1) + r32) * RP + 8 * hi;
        const f32x16 acc = mm32_ll<4>(ap, bp, zero16());
        const int t = 32 * (rbk & 1) + r32, sb0 = 32 * (cbk & 1) + 4 * hi;
        const int lim = rbk < 2 ? t : t + 1;
        if (rbk < 2 && cbk < 2) {
#pragma unroll
            for (int g = 0; g < 4; ++g) { const int s0 = sb0 + 8 * g; f32x4 v; v[0] = s0 < lim ? acc[4 * g] : 0.f; v[1] = s0 + 1 < lim ? acc[4 * g + 1] : 0.f; v[2] = s0 + 2 < lim ? acc[4 * g + 2] : 0.f; v[3] = s0 + 3 < lim ? acc[4 * g + 3] : 0.f;
                *(LAS f32x4*)(Aab + t * RF + s0) = v; u32x2 o; o.x = pk2h(v[0], v[1]); o.y = pk2h(v[2], v[3]); *(LAS u32x2*)(Lb + t * RP + s0) = o; }
        } else {
            LAS bf16_t* dst = rbk < 2 ? Aak : (cbk < 2 ? Arb : Ark);
#pragma unroll
            for (int g = 0; g < 4; ++g) { const int s0 = sb0 + 8 * g; u32x2 o; o.x = pk2h(s0 < lim ? acc[4 * g] : 0.f, s0 + 1 < lim ? acc[4 * g + 1] : 0.f); o.y = pk2h(s0 + 2 < lim ? acc[4 * g + 2] : 0.f, s0 + 3 < lim ? acc[4 * g + 3] : 0.f);
                *(LAS u32x2*)(dst + t * RP + s0) = o; }
        }
    }
    LDS_BAR();
    if (cnext >= 0) rw_load_rows(PR, tok0, h, cnext, cq, pq);
    {
        if (wv < 4) { const int rbk = wv >> 1, cbk = wv & 1;
            f32x16 acc = mm32_ll<4>(Aak + (32 * rbk + r32) * RP + 8 * hi, VtT + (32 * cbk + r32) * RP + 8 * hi, zero16());
                    LAS bf16_t* rp = Xt + (64 + 32 * cbk + r32) * RP + 32 * rbk + 4 * hi;
    #pragma unroll
            for (int g = 0; g < 4; ++g) { u32x2 o; o.x = pk2h(acc[4 * g], acc[4 * g + 1]); o.y = pk2h(acc[4 * g + 2], acc[4 * g + 3]); *(LAS u32x2*)(rp + 8 * g) = o; }
        } else if (wv == 4) {
            float x[32]; const LAS float* lb = Aab + (32 * hi) * RF + 32 * hi;
    #pragma unroll
            for (int t = 0; t < 32; ++t) { float a0_ = (t == r32) ? 1.f : 0.f, a1_ = 0.f;
    #pragma unroll
                for (int s4 = 0; s4 < (t + 3) / 4; ++s4) { const f32x4 lv = *(const LAS f32x4*)(lb + t * RF + 4 * s4);
                    if (4 * s4 < t) a0_ += lv[0] * x[4 * s4]; if (4 * s4 + 1 < t) a1_ += lv[1] * x[4 * s4 + 1]; if (4 * s4 + 2 < t) a0_ += lv[2] * x[4 * s4 + 2]; if (4 * s4 + 3 < t) a1_ += lv[3] * x[4 * s4 + 3]; }
                x[t] = a0_ + a1_; Tinv[(32 * hi + t) * 40 + r32] = (bf16_t)f2bf(x[t]); }
        }
        LDS_BAR();
        if (wv < 4) {
            LAS bf16_t* xc = Xt + (32 * wv + r32) * RP;
            f32x16 x0 = mm32_ll<2>(Tinv + r32 * 40 + 8 * hi, xc + 8 * hi, zero16());
            f32x16 z;
    #pragma unroll
            for (int g = 0; g < 4; ++g) { const u32x2 rw = *(const LAS u32x2*)(xc + 32 + 4 * hi + 8 * g); z[4 * g] = bflo(rw.x); z[4 * g + 1] = bfhi(rw.x); z[4 * g + 2] = bflo(rw.y); z[4 * g + 3] = bfhi(rw.y); }
    #pragma unroll
            for (int g = 0; g < 4; ++g) { u32x2 o; o.x = pk2h(x0[4 * g], x0[4 * g + 1]); o.y = pk2h(x0[4 * g + 2], x0[4 * g + 3]); *(LAS u32x2*)(xc + 4 * hi + 8 * g) = o; }
            z = mm32_ll<2>(Lb + (32 + r32) * RP + 8 * hi, xc + 8 * hi, z);
    #pragma unroll
            for (int g = 0; g < 4; ++g) { u32x2 o; o.x = pk2h(z[4 * g], z[4 * g + 1]); o.y = pk2h(z[4 * g + 2], z[4 * g + 3]); *(LAS u32x2*)(xc + 32 + 4 * hi + 8 * g) = o; }
            const f32x16 x1 = mm32_ll<2>(Tinv + (32 + r32) * 40 + 8 * hi, xc + 32 + 8 * hi, zero16());
    #pragma unroll
            for (int g = 0; g < 4; ++g) { u32x2 o; o.x = pk2h(x1[4 * g], x1[4 * g + 1]); o.y = pk2h(x1[4 * g + 2], x1[4 * g + 3]); *(LAS u32x2*)(xc + 32 + 4 * hi + 8 * g) = o; }
        }
        LDS_BAR();

    }
    {
        const int rbk = (wv >> 1) & 1, cbk = wv & 1;
        if (wv < 4) { const f32x16 acc = mm32_ll<4>(Xt + (32 * cbk + r32) * RP + 8 * hi, BtT + (32 * rbk + r32) * RP + 8 * hi, zero16());
            const float gk = gC[32 * rbk + r32]; bf16_t* pc = rb_.PCORR + chh * 4096 + (size_t)(32 * rbk + r32) * 64 + 32 * cbk + 4 * hi;
#pragma unroll
            for (int g = 0; g < 4; ++g) { u32x2 o; o.x = pk2h(acc[4 * g] * gk, acc[4 * g + 1] * gk); o.y = pk2h(acc[4 * g + 2] * gk, acc[4 * g + 3] * gk); *(u32x2*)(pc + 8 * g) = o; } }
        else { f32x16 acc = mm32_ll<4>(BtT + (32 * rbk + r32) * RP + 8 * hi, Xt + (64 + 32 * cbk + r32) * RP + 8 * hi, zero16());
            acc = mm32_ll<4>(KtT + (32 * rbk + r32) * RP + 8 * hi, VtT + (32 * cbk + r32) * RP + 8 * hi, acc);
            bf16_t* hp = rb_.HL + chh * 4096 + (size_t)(32 * cbk + r32) * 64 + 32 * rbk + 4 * hi;
#pragma unroll
            for (int g = 0; g < 4; ++g) { const int k0 = 32 * rbk + 4 * hi + 8 * g; u32x2 o; o.x = pk2h(acc[4 * g] * gC[k0], acc[4 * g + 1] * gC[k0 + 1]); o.y = pk2h(acc[4 * g + 2] * gC[k0 + 2], acc[4 * g + 3] * gC[k0 + 3]);
                *(u32x2*)(hp + 8 * g) = o; } }
        if (tid < 64) rb_.GC[chh * 64 + tid] = gC[tid];
        if (wv < 4) { f32x16 acc = mm32_ll<4>(Arb + (32 * rbk + r32) * RP + 8 * hi, Xt + (64 + 32 * cbk + r32) * RP + 8 * hi, zero16());
            acc = mm32_ll<4>(Ark + (32 * rbk + r32) * RP + 8 * hi, VtT + (32 * cbk + r32) * RP + 8 * hi, acc);
            LAS float* yp = Ylf + (32 * rbk + 4 * hi) * RF + 32 * cbk + r32;
#pragma unroll
            for (int r = 0; r < 16; ++r) yp[((r & 3) + 8 * (r >> 2)) * RF] = acc[r]; }
        else { f32x16 acc; const LAS bf16_t* rp_ = Rt + (32 * rbk + 4 * hi) * RP + 32 * cbk + r32;
#pragma unroll
            for (int r = 0; r < 16; ++r) acc[r] = bf2f(rp_[((r & 3) + 8 * (r >> 2)) * RP]);
            acc = mm32_ll<4>(Arb + (32 * rbk + r32) * RP + 8 * hi, Xt + (32 * cbk + r32) * RP + 8 * hi, acc);
            LAS bf16_t* op_ = R2T + (32 * cbk + r32) * RP + 32 * rbk + 4 * hi;
#pragma unroll
            for (int g = 0; g < 4; ++g) { u32x2 o; o.x = pk2h(acc[4 * g], acc[4 * g + 1]); o.y = pk2h(acc[4 * g + 2], acc[4 * g + 3]); *(LAS u32x2*)(op_ + 8 * g) = o; } }
        LDS_BAR();
        { float yl[8], o[8]; ldc8(Ylf + tq * RF + kc, yl);
          bf16_t* base = tq == 63 ? rb_.GX + chh * 8192 + 4096 + kc : (bf16_t*)PR + tok * RWC + chn; const int stride = tq == 63 ? 64 : 512;
          *(u32x4*)base = pack8(gg);
#pragma unroll
          for (int i = 0; i < 8; ++i) o[i] = bon * vv[i] * gg[i];
          *(u32x4*)(base + stride) = pack8(o); *(u32x4*)(base + 2 * stride) = pack8(yl);
          const LAS bf16_t* xp = R2T + kc * RP + tq; u32x4 gq;
          gq.x = (unsigned)xp[0] | ((unsigned)xp[RP] << 16); gq.y = (unsigned)xp[2 * RP] | ((unsigned)xp[3 * RP] << 16); gq.z = (unsigned)xp[4 * RP] | ((unsigned)xp[5 * RP] << 16); gq.w = (unsigned)xp[6 * RP] | ((unsigned)xp[7 * RP] << 16);
          *(u32x4*)(rb_.GX + chh * 8192 + (size_t)tq * 64 + kc) = gq; }
    }
}

__device__ __forceinline__ void rw_passb_phase(const LayerW& w, const bf16_t* PR, const RwBufs& rb_, bf16_t* YC, int yc_pitch, int bid, int G, LAS unsigned char* sm) {
    const int tid = tid_opaque(), lane = tid & 63, wv = __builtin_amdgcn_readfirstlane(tid >> 6), r32 = lane & 31, hi = lane >> 5;
    LAS float* Yf = (LAS float*)(sm); LAS float* CT = (LAS float*)(sm + 145664);
    const int tq = 8 * wv + (lane >> 3), kc = 8 * (lane & 7), rbk = wv >> 1, cbk = wv & 1;
    if (bid >= 2048) return;
    const int bh = bid & 31, h = bh & 7, chn = h * 64 + kc, tok0 = (bh >> 3) * SEQ;
    if (tid < 64) { CT[CT_LG + tid] = w.lng()[h * 64 + tid]; CT[CT_LB + tid] = w.lnb()[h * 64 + tid]; }
    bf16x8 r2a[4], hfa[4], r2b[4], hfb[4]; u32x4 qga, qba, qla, qgb, qbb, qlb;
#define PB_LOAD(R2, HF, QG, QB, QL, u_) do { const int c_ = (u_) >> 5; const size_t chh_ = (size_t)bh * RW_NC + c_, tok_ = (size_t)tok0 + c_ * RW_C + tq; \
        if (wv < 4) { const bf16_t* r2p = rb_.GX + chh_ * 8192 + (size_t)(32 * rbk + r32) * 64 + 8 * hi; const bf16_t* hp = rb_.HL + chh_ * 4096 + (size_t)(32 * cbk + r32) * 64 + 8 * hi; \
            _Pragma("unroll") for (int s = 0; s < 4; ++s) { R2[s] = *(const bf16x8*)(r2p + 16 * s); HF[s] = *(const bf16x8*)(hp + 16 * s); } } \
        const bf16_t* base_ = tq == 63 ? rb_.GX + chh_ * 8192 + 4096 + kc : PR + tok_ * RWC + chn; const int stride_ = tq == 63 ? 64 : 512; \
        QG = *(const u32x4*)base_; QB = *(const u32x4*)(base_ + stride_); QL = *(const u32x4*)(base_ + 2 * stride_); } while (0)
#define PB_PROC(R2, HF, QG, QB, QL, u_) do { const size_t tok_ = (size_t)tok0 + ((u_) >> 5) * RW_C + tq; \
        LDS_BAR();                                                      \
        if (wv < 4) { const f32x16 acc = mm32_rr<4>(R2, HF, zero16()); LAS float* yp = Yf + (32 * rbk + 4 * hi) * RF + 32 * cbk + r32; \
            _Pragma("unroll") for (int r = 0; r < 16; ++r) yp[((r & 3) + 8 * (r >> 2)) * RF] = acc[r]; } \
        LDS_BAR(); \
        { float y[8], yl[8], gg[8], bg[8], lg_[8], lb_[8], o[8]; ldc8(Yf + tq * RF + kc, y); ldc8(CT + CT_LG + kc, lg_); ldc8(CT + CT_LB + kc, lb_); unpack8(QL, yl); unpack8(QG, gg); unpack8(QB, bg); \
          float sy = 0.f; \
          _Pragma("unroll") for (int i = 0; i < 8; ++i) { y[i] += yl[i]; sy += y[i]; } \
          const float mean = group8_sum(sy) * (1.f / 64.f); float sd = 0.f; \
          _Pragma("unroll") for (int i = 0; i < 8; ++i) { y[i] -= mean; sd += y[i] * y[i]; } \
          const float rs = __builtin_amdgcn_rsqf(group8_sum(sd) * (1.f / 64.f) + 64e-5f); \
          _Pragma("unroll") for (int i = 0; i < 8; ++i) o[i] = (y[i] * rs * lg_[i] + lb_[i]) * gg[i] + bg[i]; \
          *(u32x4*)(YC + tok_ * yc_pitch + chn) = pack8(o); } } while (0)
    int u = bid;
    PB_LOAD(r2a, hfa, qga, qba, qla, u);
    for (;;) {
        if (u + G < 2048) PB_LOAD(r2b, hfb, qgb, qbb, qlb, u + G);
        PB_PROC(r2a, hfa, qga, qba, qla, u); u += G; if (u >= 2048) break;
        if (u + G < 2048) PB_LOAD(r2a, hfa, qga, qba, qla, u + G);
        PB_PROC(r2b, hfb, qgb, qbb, qlb, u); u += G; if (u >= 2048) break;
    }
#undef PB_LOAD
#undef PB_PROC
}

#undef LDS_BAR
struct SeqLd { u32x2 pa[2][4][2]; u32x2 hw[2][4]; };
__device__ __forceinline__ void rw_seq_load(SeqLd& d, const RwBufs& rb_, size_t chh, int v, int r32, int hi) {
    const bf16_t* hl = rb_.HL + chh * 4096 + (size_t)v * 64 + 4 * hi; const bf16_t* pc = rb_.PCORR + chh * 4096 + (size_t)r32 * 64 + 4 * hi;
#pragma unroll
    for (int rb = 0; rb < 2; ++rb) {
#pragma unroll
        for (int g = 0; g < 4; ++g) d.hw[rb][g] = *(const u32x2*)(hl + 32 * rb + 8 * g);
#pragma unroll
        for (int s = 0; s < 4; ++s) { d.pa[rb][s][0] = *(const u32x2*)(pc + (size_t)32 * rb * 64 + 16 * s); d.pa[rb][s][1] = *(const u32x2*)(pc + (size_t)32 * rb * 64 + 16 * s + 8); } }
}
__device__ __forceinline__ void rw_seq_wave(const RwBufs& rb_, int bh, int vs, int lane, LAS float* gcl) {
    const int r32 = lane & 31, hi = lane >> 5, v = 32 * vs + r32;
    for (int i = lane; i < RW_NC * 16; i += 64) *(LAS f32x4*)(gcl + 4 * i) = *(const f32x4*)(rb_.GC + (size_t)bh * RW_NC * 64 + 4 * i);
    asm volatile("s_waitcnt vmcnt(0) lgkmcnt(0)" ::: "memory");
    f32x16 st[2]; st[0] = zero16(); st[1] = zero16();
    SeqLd cur, nxt;
    rw_seq_load(cur, rb_, (size_t)bh * RW_NC, v, r32, hi);
    for (int c = 0; c < RW_NC; ++c) {
        const size_t chh = (size_t)bh * RW_NC + c;
        if (c + 1 < RW_NC) rw_seq_load(nxt, rb_, chh + 1, v, r32, hi);
        bf16_t* hl = rb_.HL + chh * 4096 + (size_t)v * 64 + 4 * hi; const LAS float* gc = gcl + c * 64 + 4 * hi;
        bf16x8 bh_[4], bl_[4];
#pragma unroll
        for (int s = 0; s < 4; ++s) { u32x4 wh, wl;
#pragma unroll
            for (int q = 0; q < 4; ++q) { const float x0 = st[s >> 1][8 * (s & 1) + 2 * q], x1 = st[s >> 1][8 * (s & 1) + 2 * q + 1]; const unsigned ph = pk2h(x0, x1); wh[q] = ph; wl[q] = pk2h(x0 - bflo(ph), x1 - bfhi(ph)); }
            bh_[s] = __builtin_bit_cast(bf16x8, wh); bl_[s] = __builtin_bit_cast(bf16x8, wl); }
        f32x16 nw[2];
#pragma unroll
        for (int rb = 0; rb < 2; ++rb) {
#pragma unroll
            for (int g = 0; g < 4; ++g) { const f32x4 gv = *(const LAS f32x4*)(gc + 32 * rb + 8 * g); const u32x2 hw = cur.hw[rb][g];
                nw[rb][4 * g] = gv[0] * st[rb][4 * g] + bflo(hw.x); nw[rb][4 * g + 1] = gv[1] * st[rb][4 * g + 1] + bfhi(hw.x);
                nw[rb][4 * g + 2] = gv[2] * st[rb][4 * g + 2] + bflo(hw.y); nw[rb][4 * g + 3] = gv[3] * st[rb][4 * g + 3] + bfhi(hw.y);
                u32x2 o; o.x = pk2h(st[rb][4 * g], st[rb][4 * g + 1]); o.y = pk2h(st[rb][4 * g + 2], st[rb][4 * g + 3]); *(u32x2*)(hl + 32 * rb + 8 * g) = o; }
#pragma unroll
            for (int s = 0; s < 4; ++s) { const u32x2 a0 = cur.pa[rb][s][0], a1 = cur.pa[rb][s][1];
                const bf16x8 af = __builtin_bit_cast(bf16x8, (u32x4){a0.x, a0.y, a1.x, a1.y});
                nw[rb] = __builtin_amdgcn_mfma_f32_32x32x16_bf16(af, bh_[s], nw[rb], 0, 0, 0);
                nw[rb] = __builtin_amdgcn_mfma_f32_32x32x16_bf16(af, bl_[s], nw[rb], 0, 0, 0); }
        }
        st[0] = nw[0]; st[1] = nw[1];
        if (c + 1 < RW_NC) cur = nxt;
    }
}
constexpr size_t OW_WUQ = OW_XEND, OW_WUKV = OW_WUQ + (size_t)768 * 256, OW_YEND = OW_WUKV + (size_t)1024 * 128;
static_assert(OW_YEND * 2 <= 52 * MiB, "weights fit");
constexpr int MP = 392;

__device__ __forceinline__ void conv_mla(const LayerW& w, bf16_t* W, int gtid, int NT) {
    for (int i = gtid; i < 24576 + 16384; i += NT) {
        float v[8]; bf16_t* dst;
        if (i < 24576) { const int lane = i & 63, ks = (i >> 6) & 15, hn = i >> 10; const int h = hn / 3, nb = hn - 3 * h; const int n = h * 96 + 32 * nb + (lane & 31), k0 = 16 * ks + 8 * (lane >> 5);
#pragma unroll
            for (int j = 0; j < 8; ++j) v[j] = w.wuq()[(size_t)(k0 + j) * 768 + n] * w.qan()[k0 + j];
            dst = W + OW_WUQ + (size_t)i * 8; }
        else { const int r = i - 24576; const int lane = r & 63, ks = (r >> 6) & 7, q = r >> 9; const int nb = q & 1, part = (q >> 1) & 1, h = q >> 2; const int n = h * 128 + 64 * part + 32 * nb + (lane & 31), k0 = 16 * ks + 8 * (lane >> 5);
#pragma unroll
            for (int j = 0; j < 8; ++j) v[j] = w.wukv()[(size_t)(k0 + j) * 1024 + n] * w.kvan()[k0 + j];
            dst = W + OW_WUKV + (size_t)r * 8; }
        u32x4 o; o.x = pk2h(v[0], v[1]); o.y = pk2h(v[2], v[3]); o.z = pk2h(v[4], v[5]); o.w = pk2h(v[6], v[7]); *(u32x4*)dst = o;
    }
}
__device__ __forceinline__ void conv_t1(const LayerW& w, bf16_t* W, int gtid, int NT) {
    for (int i = gtid; i < 1024 * 32 * 4; i += NT) { const int cs = i & 3, r = (i >> 2) & 31, k = i >> 7; const float* wr = w.win() + (size_t)k * 6304 + 2464 + 128 * cs; float sa = 0.f, sb = 0.f;
#pragma unroll 8
        for (int c = 0; c < 128; ++c) { const float x = wr[c] * w.v1()[(128 * cs + c) * 32 + r], m = w.mu()[1024 + 128 * cs + c]; sa += x * (1.f - m); sb += x * m; }
        sa += __shfl_xor(sa, 1); sb += __shfl_xor(sb, 1); sa += __shfl_xor(sa, 2); sb += __shfl_xor(sb, 2);
        if (cs == 0) { const float g = w.mixn()[k];
            W[OW_WIN + (size_t)(416 + r) * DM + k] = (bf16_t)f2bf(sa * g); W[OW_WIN + (size_t)(448 + r) * DM + k] = (bf16_t)f2bf(sb * g); } }
}

__device__ __forceinline__ void mla_unit_mfma(const LayerW& w, int L, const bf16_t* PM, const bf16_t* Wb, const float* cosT, const float* sinT, bf16_t* Q, bf16_t* K, bf16_t* Vt, float* T1, int t0, LAS unsigned char* sm) {
    const int tid = tid_opaque(), lane = tid & 63, wv = __builtin_amdgcn_readfirstlane(tid >> 6), r32 = lane & 31, hi = lane >> 5;
    LAS bf16_t* An = (LAS bf16_t*)sm; LAS float* kpe = (LAS float*)(sm + 64 * MP * 2); LAS float* kpss = kpe + 64 * 32;
    __syncthreads();
#pragma unroll
    for (int j = 0; j < 8; ++j) { const int tl = 8 * wv + j; const bf16_t* row = PM + (size_t)(t0 + tl) * 512;
        const u32x2 q4 = *(const u32x2*)(row + lane * 4); const float v0 = bflo(q4.x), v1 = bfhi(q4.x), v2 = bflo(q4.y), v3 = bfhi(q4.y);
        const unsigned k2 = *(const unsigned*)(row + 256 + lane * 2); const float c0 = bflo(k2), c1 = bfhi(k2);
        const float pe = lane < 32 ? bf2f(row[384 + lane]) : 0.f;
        const float rq = __builtin_amdgcn_rsqf(wave_sum((v0 * v0 + v1 * v1) + (v2 * v2 + v3 * v3)) * (1.f / 256.f) + EPS);
        const float rk = __builtin_amdgcn_rsqf(wave_sum(c0 * c0 + c1 * c1) * (1.f / 128.f) + EPS);
        const float ps = wave_sum(pe * pe);
        u32x2 o; o.x = pk2(v0 * rq, v1 * rq); o.y = pk2(v2 * rq, v3 * rq); *(LAS u32x2*)(An + tl * MP + lane * 4) = o;
        *(LAS unsigned*)(An + tl * MP + 256 + lane * 2) = pk2(c0 * rk, c1 * rk);
        if (lane < 32) kpe[tl * 32 + lane] = pe;
        if (lane == 0) kpss[tl] = ps;
        if (L > 0 && lane < 32) { const int t = t0 + tl; const float a = bf2f(row[416 + lane]); const float b = (t & (SEQ - 1)) ? bf2f(*(row - 512 + 448 + lane)) : 0.f; T1[(size_t)t * 32 + lane] = a + b; } }
    __syncthreads();
    const int h = wv; const int b_ = t0 / SEQ, ts0 = t0 - b_ * SEQ;
    { f32x16 acc[3][2];
#pragma unroll
      for (int nb = 0; nb < 3; ++nb) { acc[nb][0] = zero16(); acc[nb][1] = zero16(); }
      const bf16_t* wq = Wb + OW_WUQ + ((size_t)(h * 3) * 16 * 64 + lane) * 8; const LAS bf16_t* an = An + r32 * MP + 8 * hi;
#pragma unroll 4
      for (int s = 0; s < 16; ++s) { const bf16x8 b0 = *(const LAS bf16x8*)(an + 16 * s), b1 = *(const LAS bf16x8*)(an + 32 * MP + 16 * s);
#pragma unroll
          for (int nb = 0; nb < 3; ++nb) { const bf16x8 a = *(const bf16x8*)(wq + (size_t)(nb * 16 + s) * 512);
              acc[nb][0] = __builtin_amdgcn_mfma_f32_32x32x16_bf16(a, b0, acc[nb][0], 0, 0, 0); acc[nb][1] = __builtin_amdgcn_mfma_f32_32x32x16_bf16(a, b1, acc[nb][1], 0, 0, 0); } }
#pragma unroll
      for (int tb = 0; tb < 2; ++tb) { const int t = t0 + 32 * tb + r32; float ss = 0.f;
#pragma unroll
          for (int nb = 0; nb < 3; ++nb)
#pragma unroll
              for (int r = 0; r < 16; ++r) ss += acc[nb][tb][r] * acc[nb][tb][r];
          ss += __shfl_xor(ss, 32); const float rs = __builtin_amdgcn_rsqf(ss * (1.f / 96.f) + EPS) * ATT_SC;
          bf16_t* qo = Q + (size_t)t * 768 + h * 96 + 4 * hi;
#pragma unroll
          for (int nb = 0; nb < 2; ++nb)
#pragma unroll
              for (int g = 0; g < 4; ++g) { const f32x4 gn = *(const f32x4*)(w.qn() + 32 * nb + 8 * g + 4 * hi);
                  u32x2 o; o.x = pk2(acc[nb][tb][4 * g] * rs * gn[0], acc[nb][tb][4 * g + 1] * rs * gn[1]); o.y = pk2(acc[nb][tb][4 * g + 2] * rs * gn[2], acc[nb][tb][4 * g + 3] * rs * gn[3]);
                  *(u32x2*)(qo + 32 * nb + 8 * g) = o; }
#pragma unroll
          for (int g = 0; g < 2; ++g) { const int i0 = 8 * g + 4 * hi; const f32x4 g1 = *(const f32x4*)(w.qn() + 64 + i0), g2 = *(const f32x4*)(w.qn() + 80 + i0);
              const f32x4 cs = *(const f32x4*)(cosT + (size_t)t * 16 + i0), sn = *(const f32x4*)(sinT + (size_t)t * 16 + i0); float o1[4], o2[4];
#pragma unroll
              for (int i = 0; i < 4; ++i) { const float x1 = acc[2][tb][4 * g + i] * rs * g1[i], x2 = acc[2][tb][8 + 4 * g + i] * rs * g2[i]; o1[i] = x1 * cs[i] - x2 * sn[i]; o2[i] = x2 * cs[i] + x1 * sn[i]; }
              u32x2 a; a.x = pk2(o1[0], o1[1]); a.y = pk2(o1[2], o1[3]); u32x2 b; b.x = pk2(o2[0], o2[1]); b.y = pk2(o2[2], o2[3]);
              *(u32x2*)(qo + 64 + 8 * g) = a; *(u32x2*)(qo + 80 + 8 * g) = b; } } }
#pragma unroll
    for (int part = 0; part < 2; ++part) {
        f32x16 acc[2][2]; acc[0][0] = zero16(); acc[0][1] = zero16(); acc[1][0] = zero16(); acc[1][1] = zero16();
        const bf16_t* wk = Wb + OW_WUKV + ((size_t)((h * 2 + part) * 2) * 8 * 64 + lane) * 8; const LAS bf16_t* an = An + r32 * MP + 256 + 8 * hi;
#pragma unroll 4
        for (int s = 0; s < 8; ++s) { const bf16x8 b0 = *(const LAS bf16x8*)(an + 16 * s), b1 = *(const LAS bf16x8*)(an + 32 * MP + 16 * s);
#pragma unroll
            for (int nb = 0; nb < 2; ++nb) { const bf16x8 a = *(const bf16x8*)(wk + (size_t)(nb * 8 + s) * 512);
                acc[nb][0] = __builtin_amdgcn_mfma_f32_32x32x16_bf16(a, b0, acc[nb][0], 0, 0, 0); acc[nb][1] = __builtin_amdgcn_mfma_f32_32x32x16_bf16(a, b1, acc[nb][1], 0, 0, 0); } }
#pragma unroll
        for (int tb = 0; tb < 2; ++tb) { const int tl = 32 * tb + r32, t = t0 + tl;
            if (part == 0) { float ss = 0.f;
#pragma unroll
                for (int nb = 0; nb < 2; ++nb)
#pragma unroll
                    for (int r = 0; r < 16; ++r) ss += acc[nb][tb][r] * acc[nb][tb][r];
                ss += __shfl_xor(ss, 32); const float rs = __builtin_amdgcn_rsqf((ss + kpss[tl]) * (1.f / 96.f) + EPS);
                bf16_t* ko = K + (size_t)t * 768 + h * 96 + 4 * hi;
#pragma unroll
                for (int nb = 0; nb < 2; ++nb)
#pragma unroll
                    for (int g = 0; g < 4; ++g) { const f32x4 gn = *(const f32x4*)(w.kn() + 32 * nb + 8 * g + 4 * hi);
                        u32x2 o; o.x = pk2(acc[nb][tb][4 * g] * rs * gn[0], acc[nb][tb][4 * g + 1] * rs * gn[1]); o.y = pk2(acc[nb][tb][4 * g + 2] * rs * gn[2], acc[nb][tb][4 * g + 3] * rs * gn[3]);
                        *(u32x2*)(ko + 32 * nb + 8 * g) = o; }
#pragma unroll
                for (int g = 0; g < 2; ++g) { const int i0 = 8 * g + 4 * hi; const f32x4 g1 = *(const f32x4*)(w.kn() + 64 + i0), g2 = *(const f32x4*)(w.kn() + 80 + i0);
                    const f32x4 cs = *(const f32x4*)(cosT + (size_t)t * 16 + i0), sn = *(const f32x4*)(sinT + (size_t)t * 16 + i0);
                    const f32x4 p1 = *(const LAS f32x4*)(kpe + tl * 32 + i0), p2 = *(const LAS f32x4*)(kpe + tl * 32 + 16 + i0); float o1[4], o2[4];
#pragma unroll
                    for (int i = 0; i < 4; ++i) { const float x1 = p1[i] * rs * g1[i], x2 = p2[i] * rs * g2[i]; o1[i] = x1 * cs[i] - x2 * sn[i]; o2[i] = x2 * cs[i] + x1 * sn[i]; }
                    u32x2 a; a.x = pk2(o1[0], o1[1]); a.y = pk2(o1[2], o1[3]); u32x2 b; b.x = pk2(o2[0], o2[1]); b.y = pk2(o2[2], o2[3]);
                    *(u32x2*)(ko + 64 + 8 * g) = a; *(u32x2*)(ko + 80 + 8 * g) = b; }
            } else {
                bf16_t* vo = Vt + ((size_t)(b_ * 8 + h) * 64 + 4 * hi) * SEQ + ts0 + ((tl & ~12) | ((tl & 4) << 1) | ((tl & 8) >> 1));
#pragma unroll
                for (int nb = 0; nb < 2; ++nb)
#pragma unroll
                    for (int r = 0; r < 16; ++r) vo[(size_t)(32 * nb + (r & 3) + 8 * (r >> 2)) * SEQ] = (bf16_t)f2bf(acc[nb][tb][r]);
            } }
    }
}
constexpr size_t OW_WS = OW_YEND, OW_ZEND = OW_WS + (size_t)8 * 128 * 128;
static_assert(OW_ZEND * 2 <= 52 * MiB, "weights fit");
constexpr int SVP = 136;
__device__ __forceinline__ void conv_sgu(const LayerW& w, bf16_t* W, int gtid, int NT) {
    for (int i = gtid; i < 8 * 128 * 128; i += NT) { const int t = (i >> 7) & 127, s = i & 127; W[OW_WS + i] = (bf16_t)(s <= t ? f2bf(w.sgws()[i]) : 0u); }
}
__device__ __forceinline__ void sg_mix_mfma(const LayerW& w, const bf16_t* PS, bf16_t* YB, const float* SGQ, const bf16_t* Wb, int c, int g, LAS unsigned char* sm) {
    const int tid = tid_opaque(), lane = tid & 63, wv = __builtin_amdgcn_readfirstlane(tid >> 6), r32 = lane & 31, hi = lane >> 5;
    LAS bf16_t* vnT = (LAS bf16_t*)sm;
    __syncthreads();
    { const float gn = w.sgvn()[g * 64 + lane];
#pragma unroll
      for (int q = 0; q < 2; ++q) { unsigned pv[8];
#pragma unroll
          for (int j = 0; j < 8; ++j) { const int t = c * 128 + 16 * wv + 8 * q + j;
              const f32x4 q0 = *(const f32x4*)(SGQ + (size_t)t * 8), q1 = *(const f32x4*)(SGQ + (size_t)t * 8 + 4);
              const float rs = __builtin_amdgcn_rsqf((((q0[0] + q0[1]) + (q0[2] + q0[3])) + ((q1[0] + q1[1]) + (q1[2] + q1[3]))) * (1.f / 512.f) + EPS);
              pv[j] = f2bf(bf2f(PS[(size_t)t * 1024 + 512 + g * 64 + lane]) * rs * gn); }
          u32x4 o; o.x = pv[0] | (pv[1] << 16); o.y = pv[2] | (pv[3] << 16); o.z = pv[4] | (pv[5] << 16); o.w = pv[6] | (pv[7] << 16);
          *(LAS u32x4*)(vnT + lane * SVP + 16 * wv + 8 * q) = o; } }
    __syncthreads();
    const int rb = wv >> 1, cb = wv & 1;
    f32x16 acc = zero16();
    const bf16_t* ap_ = Wb + OW_WS + (size_t)g * 16384 + (size_t)(32 * rb + r32) * 128 + 8 * hi; const LAS bf16_t* bp = vnT + (32 * cb + r32) * SVP + 8 * hi;
    for (int ks = 0; ks < 2 * (rb + 1); ++ks) acc = __builtin_amdgcn_mfma_f32_32x32x16_bf16(*(const bf16x8*)(ap_ + 16 * ks), *(const LAS bf16x8*)(bp + 16 * ks), acc, 0, 0, 0);
    const int cc = g * 64 + 32 * cb + r32;
#pragma unroll
    for (int r = 0; r < 16; ++r) { const int tl = 32 * rb + 4 * hi + (r & 3) + 8 * (r >> 2); const size_t t = (size_t)(c * 128 + tl);
        YB[t * 512 + cc] = f2bfh(bf2f(PS[t * 1024 + cc]) * (acc[r] + w.sgbs()[g * 128 + tl])); }
}
constexpr int LDS_BYTES = 151552;
constexpr int PH_PER_LAYER = 14, N_PHASES = DEPTH * PH_PER_LAYER;

struct MergeSched {
    int pm, pn; const char* ws;
    __device__ __forceinline__ bool next(int i, pg8::MUnit& u) const { if (pm < 0 || i >= 6) return false; u.pm = pm; u.pn = pn; u.kind = i; return true; }
    __device__ __forceinline__ pg8::MDesc desc(int kind) const { const int i = kind >> 1, br = kind & 1;
        const size_t ya = WS_A + (i == 1 ? WS_B - WS_A : 0) + (i == 2 ? WS_D - WS_A : 0);
        const size_t ao = br ? ya : WS_HHI, bo = br ? WS_W + (OW_WOUT + (size_t)i * 512) * 2 : WS_W + (OW_WIN + (size_t)(NPC + i * DM) * DM) * 2;
        pg8::MDesc d; d.A = (const bf16_t*)(ws + ao); d.Bt = (const bf16_t*)(ws + bo);
        d.lda = br ? (i == 1 ? 1024 : 512) : DM; d.ldb = br ? 1536 : DM; d.nt = br ? 8 : 16; return d; }
    __device__ __forceinline__ void a_ready(const pg8::MUnit&) const {}
    __device__ __forceinline__ void done(const pg8::MUnit&) const {}
};
struct EpiMergeM {
    static constexpr bool PERM = true;
    bf16_t* S; bf16_t* M; const float* ssq;
    __device__ __forceinline__ void operator()(const f32x4 (&acc)[2][2][4][2], const pg8::MUnit& u, int wr, int wc, int fr, int fq) const {
        Unit uu; uu.pm = u.pm; uu.pn = u.pn;
        if (!(u.kind & 1)) { EpiGateS e{S, ssq}; e(acc, uu, wr, wc, fr, fq); }
        else { EpiMerge2 e{S, M, u.kind == 1}; e(acc, uu, wr, wc, fr, fq); }
    }
};


constexpr int YOFF1 = (int)((WS_D - WS_A) / (256 * 512 * 2)), YOFF2 = (int)((WS_B - WS_A) / (256 * 512 * 2));
static_assert((WS_D - WS_A) % (256 * 512 * 2) == 0 && (WS_B - WS_A) % (256 * 512 * 2) == 0, "branch bases are whole row tiles apart");
struct MergeOrder {
    pg8::StaticOrder so; bool has; pg8::Unit u0;
    __device__ __forceinline__ void init(int G, int c) { so.init(T, DM, G, c); has = so.next(0, u0); }
    __device__ __forceinline__ bool next(int j, pg8::Unit& u) const { if (!has || j >= 3) return false; const int i = j == 0 ? 2 : j - 1;
        u.pm = u0.pm + (i == 1 ? YOFF1 : 0) + (i == 2 ? YOFF2 : 0); u.pn = u0.pn + 4 * i; return true; }
    __device__ __forceinline__ void a_ready(const pg8::Unit&) const {}
    __device__ __forceinline__ void done(const pg8::Unit&) const {}
};
struct EpiMerge3 {
    static constexpr bool PERM = true;
    const bf16_t* G0; const bf16_t* G1; bf16_t* M;
    __device__ __forceinline__ void operator()(const f32x4 (&acc)[2][2][4][2], const pg8::Unit& u, int wr, int wc, int fr, int fq) const {
        __builtin_amdgcn_fence(__ATOMIC_ACQUIRE, "agent");
        const int i = u.pn >> 2, pm = u.pm - (i == 1 ? YOFF1 : 0) - (i == 2 ? YOFF2 : 0);
        const long long d1 = (const char*)G1 - (const char*)G0, d2 = (const char*)M - (const char*)G0;
        const bf16_t* S = (const bf16_t*)((const char*)G0 + (i == 1 ? d1 : 0ll) + (i == 2 ? d2 : 0ll));
        const int row0 = pm * 256 + wr * 64 + fr, col0 = (u.pn & 3) * 256 + wc * 32 + 8 * fq;
#pragma unroll
        for (int ai = 0; ai < 2; ++ai)
#pragma unroll
            for (int m = 0; m < 4; ++m) {
                const int row = row0 + ai * 128 + m * 16;
#pragma unroll
                for (int bj = 0; bj < 2; ++bj) {
                    const size_t off = (size_t)row * DM + col0 + bj * 128;
                    const u32x4 gw = *(const u32x4*)(S + off);
                    float o[8];
                    o[0] = bflo(gw.x) * acc[ai][bj][m][0][0]; o[1] = bfhi(gw.x) * acc[ai][bj][m][0][1]; o[2] = bflo(gw.y) * acc[ai][bj][m][0][2]; o[3] = bfhi(gw.y) * acc[ai][bj][m][0][3];
                    o[4] = bflo(gw.z) * acc[ai][bj][m][1][0]; o[5] = bfhi(gw.z) * acc[ai][bj][m][1][1]; o[6] = bflo(gw.w) * acc[ai][bj][m][1][2]; o[7] = bfhi(gw.w) * acc[ai][bj][m][1][3];
                    if (i != 2) { const u32x4 mw = *(const u32x4*)(M + off);
                        o[0] += bflo(mw.x); o[1] += bfhi(mw.x); o[2] += bflo(mw.y); o[3] += bfhi(mw.y); o[4] += bflo(mw.z); o[5] += bfhi(mw.z); o[6] += bflo(mw.w); o[7] += bfhi(mw.w); }
                    u32x4 w; w.x = cvt_pk_bf16(o[0], o[1]); w.y = cvt_pk_bf16(o[2], o[3]); w.z = cvt_pk_bf16(o[4], o[5]); w.w = cvt_pk_bf16(o[6], o[7]);
                    *(u32x4*)(M + off) = w;
                }
            }
    }
};

#define WSP(T_, off) ((T_*)(ap->ws + (off)))
#define DOP(T_, off) ((T_*)((unsigned char*)ap->out + (off)))
__device__ __forceinline__ RwBufs rw_bufs(CArgs* ap) { RwBufs b; b.PCORR = DOP(bf16_t, DO_PCORR); b.HL = DOP(bf16_t, DO_HL); b.GC = WSP(float, WS_MISC + 512 * 1024); b.GX = DOP(bf16_t, DO_GX); return b; }
__device__ __forceinline__ void run_phase(CArgs* ap, int ph, unsigned char* lds_g) {
    LAS unsigned char* lds = (LAS unsigned char*)lds_g; LAS float* smf = (LAS float*)lds_g;
    const int tid = tid_opaque(), lane = tid & 63, wave = __builtin_amdgcn_readfirstlane(tid >> 6);
    const int G = gridDim.x, bid = blockIdx.x; const int gw = bid * 8 + wave, NGW = G * 8;
    const int L = ph / PH_PER_LAYER, s = ph % PH_PER_LAYER;
    pg8::StaticOrder S;
    if (s == 0) {
        const LayerW w{ap, L};
        conv_weights_wg(w, WSP(bf16_t, WS_W), smf, bid, G, tid);
        __syncthreads();
        conv_win_block3(w, WSP(bf16_t, WS_W), smf + wave * 2112, NGW - 1 - gw, NGW, lane);
        { int nt_ = G * 512; asm volatile("" : "+s"(nt_));
          conv_small(w, WSP(bf16_t, WS_W), bid * 512 + tid, nt_); }
        conv_mla(w, WSP(bf16_t, WS_W), (G - 1 - bid) * 512 + tid, G * 512);
        if (L > 0) conv_t1(w, WSP(bf16_t, WS_W), bid * 512 + tid, G * 512);
        conv_sgu(w, WSP(bf16_t, WS_W), bid * 512 + tid, G * 512);
        if (L == 0) { init_rows((const float*)ap->in[0], WSP(bf16_t, WS_HHI), WSP(bf16_t, WS_HLO), WSP(float, WS_SSQ), gw, NGW, lane);
                      init_rope((const int*)ap->in[1], WSP(float, WS_ROPE), WSP(float, WS_ROPE) + (size_t)T * 16, bid * 512 + tid, G * 512); }
    } else if (s == 1 || s == 12) {
        pg8::Gemm g{WSP(bf16_t, WS_HHI), WSP(bf16_t, WS_W) + (s == 1 ? OW_W1GU1 : OW_W1GU2), DM, DM, T, 2 * FF, DM}; S.init(T, 2 * FF, G, bid);
        EpiUp E{WSP(bf16_t, WS_ACT), WSP(float, WS_SSQ)}; pg8::gemm_phase<EpiUp, pg8::StaticOrder, true, true>(lds, g, S, E);
    } else if (s == 2 || s == 13) {
        pg8::Gemm g{WSP(bf16_t, WS_ACT), WSP(bf16_t, WS_W) + (s == 2 ? OW_W2_1 : OW_W2_2), FF, FF, T, DM, FF}; S.init(T, DM, G, bid);
        EpiRes E{WSP(bf16_t, WS_HHI), WSP(bf16_t, WS_HLO), WSP(float, WS_SSQ), 0.5f, (s == 13 && L == DEPTH - 1) ? ap->out : nullptr}; pg8::gemm_phase<EpiRes, pg8::StaticOrder, true, true>(lds, g, S, E);
    } else if (s == 3) {
        pg8::Gemm g{WSP(bf16_t, WS_HHI), WSP(bf16_t, WS_W) + OW_WIN, DM, DM, T, NPC, DM}; S.init(T, NPC, G, bid);
        EpiWin E{WSP(bf16_t, WS_A), WSP(bf16_t, WS_B), WSP(bf16_t, WS_C), WSP(float, WS_MISC), WSP(float, WS_SSQ)}; pg8::gemm_phase<EpiWin, pg8::StaticOrder, true, true>(lds, g, S, E);
    } else if (s == 4) {
        const LayerW w{ap, L};
        for (int u = bid; u < T / 64; u += G) mla_unit_mfma(w, L, WSP(bf16_t, WS_A), WSP(bf16_t, WS_W), WSP(float, WS_ROPE), WSP(float, WS_ROPE) + (size_t)T * 16, DOP(bf16_t, DO_Q), DOP(bf16_t, DO_K), DOP(bf16_t, DO_VT), WSP(float, WS_T1), u * 64, lds);
    } else if (s == 5) {
#ifdef PROBE_DUP_ATTN
        for (int rep = 0; rep < 2; ++rep)
#endif
        int ub = bid; asm volatile("" : "+s"(ub));
        for (int u = ub; u < 256; u += G) { const int bh = u >> 3, sx = u & 7;
            attn_unit(DOP(bf16_t, DO_Q), DOP(bf16_t, DO_K), DOP(bf16_t, DO_VT), WSP(bf16_t, WS_A), 512, (bh >> 3) * SEQ, bh, bh & 7, 15 - sx, lds);
            attn_unit(DOP(bf16_t, DO_Q), DOP(bf16_t, DO_K), DOP(bf16_t, DO_VT), WSP(bf16_t, WS_A), 512, (bh >> 3) * SEQ, bh, bh & 7, sx, lds); }
#ifdef PROBE_ATTN_SHADOW
        for (int u = bid; u < 256; u += G) { const int bh = u >> 3, sx = u & 7;
            attn_unit<PROBE_ATTN_SHADOW>(DOP(bf16_t, DO_Q), DOP(bf16_t, DO_K), DOP(bf16_t, DO_VT), WSP(bf16_t, WS_D), 512, (bh >> 3) * SEQ, bh, bh & 7, 15 - sx, lds);
            attn_unit<PROBE_ATTN_SHADOW>(DOP(bf16_t, DO_Q), DOP(bf16_t, DO_K), DOP(bf16_t, DO_VT), WSP(bf16_t, WS_D), 512, (bh >> 3) * SEQ, bh, bh & 7, sx, lds); }
#endif
    } else if (s == 6 || s == 8) {
        const LayerW w{ap, L}; const RwBufs rbuf = rw_bufs(ap);
        if (s == 6) { u32x4 cq[7], pq[7];
            rw_load_rows(WSP(bf16_t, WS_C), ((bid & 31) >> 3) * SEQ, bid & 7, (bid >> 5) & (RW_NC - 1), cq, pq);
            for (int u = bid; u < 2048; u += G) { const int bh = u & 31, c = u >> 5; const int cn = u + G < 2048 ? c + (G >> 5) : -1;
                rw_chunk_unit<0>(w, L, WSP(bf16_t, WS_C), WSP(bf16_t, WS_W), WSP(bf16_t, WS_VF), WSP(float, WS_T1), rbuf, nullptr, 0, (bh >> 3) * SEQ, bh, bh & 7, c, lds, cn, u == bid, cq, pq); } }
        else rw_passb_phase(w, WSP(bf16_t, WS_C), rbuf, WSP(bf16_t, WS_B), 512, bid, G, lds);
    } else if (s == 7) {
        const RwBufs rbuf = rw_bufs(ap);
        if (wave == 0 && bid < 64) rw_seq_wave(rbuf, bid >> 1, bid & 1, lane, smf);
        if (bid >= 64) { const LayerW w{ap, L};
            for (int u = bid - 64; u < 1024; u += G - 64) sg_mix_mfma(w, WSP(bf16_t, WS_B), WSP(bf16_t, WS_D), WSP(float, WS_MISC), WSP(bf16_t, WS_W), u >> 3, u & 7, lds); }
    } else if (s == 9) {
        pg8::Gemm g{WSP(bf16_t, WS_HHI), WSP(bf16_t, WS_W) + OW_WIN + (size_t)NPC * DM, DM, DM, T, NGC, DM}; S.init(T, NGC, G, bid);
        EpiGate3 E{DOP(bf16_t, DO_S), DOP(bf16_t, DO_M), WSP(bf16_t, WS_C), WSP(float, WS_SSQ)}; pg8::gemm_phase<EpiGate3, pg8::StaticOrder, true, true>(lds, g, S, E);
    } else if (s == 10) {
        MergeOrder MO; MO.init(G, bid);
        pg8::Gemm g{WSP(bf16_t, WS_A), WSP(bf16_t, WS_W) + OW_WOUT, 512, 512, T, DM, 512};
        EpiMerge3 E{DOP(bf16_t, DO_S), DOP(bf16_t, DO_M), WSP(bf16_t, WS_C)}; pg8::gemm_phase<EpiMerge3, MergeOrder, true, true>(lds, g, MO, E);
    } else if (s == 11) {
        pg8::Gemm g{WSP(bf16_t, WS_C), WSP(bf16_t, WS_W) + OW_WO, DM, DM, T, DM, DM}; S.init(T, DM, G, bid);
        EpiRes E{WSP(bf16_t, WS_HHI), WSP(bf16_t, WS_HLO), WSP(float, WS_SSQ), 1.0f, nullptr}; pg8::gemm_phase<EpiRes, pg8::StaticOrder, true, true>(lds, g, S, E);
    }
}


#define XB_TMO      128
#define XB_XCNT(j)  (256  + 64 * (j))
#define XB_XSUB(j)  (1280 + 64 * (j))
#define XB_XGEN(j)  (2304 + 64 * (j))
#define XB_TOP      3328
#define XB_TOPGEN   3392
#define XCD_BAR_WORDS 3456
#define XB_SPIN_CAP (1u << 18)
constexpr size_t WS_CTL = WS_W + 52 * MiB - 16384;
static_assert(OW_ZEND * 2 <= 52 * MiB - 16384, "barrier words fit behind the weights");
__device__ __forceinline__ unsigned xb_ld(unsigned* p)              { return __hip_atomic_load(p, __ATOMIC_RELAXED, __HIP_MEMORY_SCOPE_AGENT); }
__device__ __forceinline__ unsigned xb_add(unsigned* p, unsigned v) { return __hip_atomic_fetch_add(p, v, __ATOMIC_RELAXED, __HIP_MEMORY_SCOPE_AGENT); }
__device__ __forceinline__ unsigned xb_xcc_id() { return (unsigned)__builtin_amdgcn_s_getreg((3 << 11) | 20) & 0xFu; }
#define XB_SPIN(cond, bar) do { unsigned _sp = 0; while (cond) { __builtin_amdgcn_s_sleep(1); \
    if ((++_sp & 255u) == 0u) { if (xb_ld(&(bar)[XB_TMO])) break; if (_sp > XB_SPIN_CAP) { atomicAdd(&(bar)[XB_TMO], 1u); break; } } } } while (0)
struct XcdBarrier { unsigned* bar; unsigned x; volatile LAS unsigned* st; };
__device__ __forceinline__ XcdBarrier xcd_barrier_post(unsigned* bar, volatile LAS unsigned* st) {
    XcdBarrier b; b.bar = bar; b.x = xb_xcc_id(); b.st = st;
    if (threadIdx.x == 0) (void)xb_add(&bar[XB_XCNT(b.x)], 1u);
    return b;
}
__device__ __forceinline__ void xcd_barrier_complete(unsigned* bar, unsigned x, unsigned& nloc, unsigned& nx) {
    const unsigned G = gridDim.x * gridDim.y * gridDim.z;
    unsigned sum, cnt, mine, sp = 0u;
    for (;;) {
        sum = 0u; cnt = 0u; mine = 0u;
#pragma unroll
        for (unsigned j = 0; j < 16; ++j) { const unsigned c = xb_ld(&bar[XB_XCNT(j)]); sum += c; cnt += (c > 0u) ? 1u : 0u; mine = (j == x) ? c : mine; }
        if (sum == G) break;
        __builtin_amdgcn_s_sleep(1);
        if ((++sp & 255u) == 0u) { if (xb_ld(&bar[XB_TMO])) break; if (sp > XB_SPIN_CAP) { atomicAdd(&bar[XB_TMO], 1u); break; } }
    }
    nloc = mine > 0u ? mine : 1u; nx = cnt > 0u ? cnt : 1u;
}
__device__ __forceinline__ void xcd_barrier(const XcdBarrier& b) {
    asm volatile("s_waitcnt vmcnt(0)" ::: "memory");
    __syncthreads();
    if (threadIdx.x == 0) {
        unsigned* bar = b.bar;
        __builtin_amdgcn_s_waitcnt(0);
        unsigned nloc = b.st[0], nx = b.st[1];
        if (nloc == 0u) { xcd_barrier_complete(bar, b.x, nloc, nx); b.st[0] = nloc; b.st[1] = nx; }
        const unsigned old = xb_add(&bar[XB_XSUB(b.x)], 1u);
        const unsigned gen = old / nloc;
        if (old + 1u == (gen + 1u) * nloc) {
            __builtin_amdgcn_fence(__ATOMIC_RELEASE, "agent");
            asm volatile("s_waitcnt vmcnt(0)" ::: "memory");
            const unsigned og = xb_add(&bar[XB_TOP], 1u);
            const unsigned tg = og / nx;
            if (og + 1u == (tg + 1u) * nx) xb_add(&bar[XB_TOPGEN], 1u);
            else XB_SPIN(xb_ld(&bar[XB_TOPGEN]) == tg, bar);
            __builtin_amdgcn_fence(__ATOMIC_ACQUIRE, "agent");
            xb_add(&bar[XB_XGEN(b.x)], 1u);
            asm volatile("s_waitcnt vmcnt(0)" ::: "memory");
        } else {
            XB_SPIN(xb_ld(&bar[XB_XGEN(b.x)]) == gen, bar);
            __builtin_amdgcn_fence(__ATOMIC_ACQUIRE, "agent");
            asm volatile("s_waitcnt vmcnt(0)" ::: "memory");
        }
    }
    __syncthreads();
}

__global__ void __launch_bounds__(512, 2) mk_fwd(Args a) {
    extern __shared__ __attribute__((aligned(16))) unsigned char lds[];
    cg::grid_group grid = cg::this_grid();
    CArgs* ap0 = (CArgs*)__builtin_amdgcn_kernarg_segment_ptr();
    const int ph_lo = ap0->ph_lo, ph_hi = ap0->ph_hi;
    volatile LAS unsigned* bst = (volatile LAS unsigned*)((LAS unsigned char*)lds + LDS_BYTES - 16);
    if (threadIdx.x < 4) bst[threadIdx.x] = 0u;
    __syncthreads();
    const XcdBarrier xbar = xcd_barrier_post((unsigned*)(ap0->ws + WS_CTL), bst);
    for (int ph = ph_lo; ph < ph_hi; ++ph) {
        CArgs* ap = ap0; asm volatile("" : "+s"(ap));
        run_phase(ap, ph, lds);
#ifdef PROBE_DUP_MASK
        if ((PROBE_DUP_MASK >> (ph % PH_PER_LAYER)) & 1) { xcd_barrier(xbar); CArgs* ap2 = ap0; asm volatile("" : "+s"(ap2)); run_phase(ap2, ph, lds); }
#endif
        if (ph + 1 < ph_hi) { if (ph == ph_lo) grid.sync(); else xcd_barrier(xbar); }
#ifdef PROBE_EXTRA_SYNC
        if (ph < PROBE_EXTRA_SYNC) { xcd_barrier(xbar); xcd_barrier(xbar); }
#endif
    }
}

#ifndef MK_ONE_LAUNCH
#define MK_ONE_LAUNCH 1
#endif
extern "C" void kernel_launch(void* const* d_in, const int* in_sizes, int n_in, void* d_out, int out_size, void* d_ws, size_t ws_size, hipStream_t stream) {
    static int grid = 0;
    if (grid == 0) {
        if (n_in != 39 || out_size != T * DM || ws_size < WS_END) { fprintf(stderr, "kernel_launch: unexpected shapes (n_in %d out %d ws %zu)\n", n_in, out_size, ws_size); grid = -1; return; }
        int dev = 0, cus = 0, per_cu = 0;
        hipGetDevice(&dev); hipDeviceGetAttribute(&cus, hipDeviceAttributeMultiprocessorCount, dev);
        hipFuncSetAttribute((const void*)mk_fwd, hipFuncAttributeMaxDynamicSharedMemorySize, LDS_BYTES);
        hipOccupancyMaxActiveBlocksPerMultiprocessor(&per_cu, (const void*)mk_fwd, 512, LDS_BYTES);
        if (per_cu < 1) { fprintf(stderr, "kernel_launch: occupancy query says %d blocks per CU\n", per_cu); per_cu = 1; }
        (void)hipGetLastError();
        grid = cus * 1;
    }
    if (grid < 0) return;
    Args a{};
    for (int i = 0; i < 39; ++i) a.in[i] = d_in[i];
    a.out = (float*)d_out; a.ws = (unsigned char*)d_ws;
#if MK_ONE_LAUNCH
    hipMemsetAsync((unsigned char*)d_ws + WS_CTL, 0, 16384, stream);
    a.ph_lo = 0; a.ph_hi = N_PHASES;
    void* args[] = {&a};
    hipError_t e = hipLaunchCooperativeKernel((const void*)mk_fwd, dim3(grid), dim3(512), args, LDS_BYTES, stream);
    if (e != hipSuccess) fprintf(stderr, "cooperative launch failed: %s (grid %d)\n", hipGetErrorString(e), grid);
#else
    for (int ph = 0; ph < N_PHASES; ++ph) { a.ph_lo = ph; a.ph_hi = ph + 1; hipLaunchKernelGGL(mk_fwd, dim3(grid), dim3(512), LDS_BYTES, stream, a); }
#endif
}
```

```cpp
#include <hip/hip_runtime.h>
#include <hip/hip_cooperative_groups.h>
#include <cstdio>
#include <cstdint>
#include <cmath>
namespace cg = cooperative_groups;
__device__ __forceinline__ int tid_opaque() { int t = threadIdx.x; asm volatile("" : "+v"(t)); return t; }
namespace pg8 {
#define PG8_LAS __attribute__((address_space(3)))
typedef unsigned short bf16_t;
typedef short bf16x8 __attribute__((ext_vector_type(8)));
typedef float f32x4 __attribute__((ext_vector_type(4)));
typedef float f32x2 __attribute__((ext_vector_type(2)));
typedef unsigned u32x4 __attribute__((ext_vector_type(4)));
typedef unsigned u32x2 __attribute__((ext_vector_type(2)));
constexpr int BM = 256, BK = 64, HALF = 128, HTB = HALF * BK * 2, STAGE_BYTES = 8 * HTB, NXCD = 8, WGM = 8;

__host__ __device__ __forceinline__ int lds_byte(int r, int c) { const int st = (r >> 4) * 2 + (c >> 5), rr = r & 15, cc = c & 31, ob = rr * 64 + cc * 2; return st * 1024 + (ob ^ (((ob >> 9) & 1) << 5)); }
__host__ __device__ __forceinline__ void stage_rc(int b, int& R, int& C) { const int st = b / 1024, sb = b % 1024, swz = sb ^ (((sb >> 9) & 1) << 5); R = (st >> 1) * 16 + swz / 64; C = (st & 1) * 32 + (swz % 64) / 2; }
__host__ __device__ __forceinline__ int perm32(int rho) { const int n = rho >> 4, i = rho & 15; return 8 * (i >> 2) + 4 * n + (i & 3); }

struct Unit { int pm, pn; };
struct Gemm { const bf16_t* A; const bf16_t* Bt; int lda, ldb; int M, N, K; };

struct StaticOrder {
    int nM, nN, nwg, G, c, imax;
    __host__ __device__ void init(int M, int N, int G_, int c_) { nM = M / BM; nN = N / BM; nwg = nM * nN; G = G_; c = c_; imax = 1 << 30; }
    __host__ __device__ __forceinline__ bool next(int i, Unit& u) const {
        const long L = (long)i * G + c; if (L >= nwg || i >= imax) return false;
        int wgid = (int)L; { const int q = nwg / NXCD, r = nwg % NXCD, xcd = wgid % NXCD, off = wgid / NXCD; wgid = (xcd < r ? xcd * (q + 1) : r * (q + 1) + (xcd - r) * q) + off; }
        const int nig = WGM * nN, gid = wgid / nig, fm = gid * WGM, gsz = (nM - fm) < WGM ? (nM - fm) : WGM;
        u.pm = fm + ((wgid % nig) % gsz); u.pn = (wgid % nig) / gsz; return true;
    }
    __device__ __forceinline__ void a_ready(const Unit&) const {}
    __device__ __forceinline__ void done(const Unit&) const {}
};

typedef __bf16 bf16x2_t __attribute__((ext_vector_type(2)));
__device__ __forceinline__ unsigned cvt_pk_bf16(float lo, float hi) { f32x2 v = {lo, hi}; bf16x2_t b = __builtin_convertvector(v, bf16x2_t); return __builtin_bit_cast(unsigned, b); }

template <class Epi, class Sched, bool ALIGN_EPI = false, bool SP2 = false>
__device__ __forceinline__ void gemm_phase(PG8_LAS unsigned char* lds, const Gemm g, const Sched& S, const Epi& E) {
    const int tid = tid_opaque(), wid = __builtin_amdgcn_readfirstlane(tid >> 6), lane = tid & 63, wr = wid >> 2, wc = wid & 3, fr = lane & 15, fq = lane >> 4;
    const int K = g.K, nt = K / BK;
    unsigned voffA[2], voffB[2];
#pragma unroll
    for (int i = 0; i < 2; ++i) { int R, C; stage_rc(tid * 16 + i * 8192, R, C); const int Rb = Epi::PERM ? ((R & ~31) + perm32(R & 31)) : R;
        voffA[i] = (unsigned)(R * g.lda + C) * 2u; voffB[i] = (unsigned)(Rb * g.ldb + C) * 2u; }
    const size_t kstep = (size_t)(BK * 2);
    const size_t hstepA = (size_t)HALF * g.lda * 2, hstepB = (size_t)HALF * g.ldb * 2;
    const size_t tstepA = 2 * hstepA, tstepB = 2 * hstepB;
    const unsigned ldsw = (unsigned)wid * 1024u;
    const int aoff = lds_byte(wr * 64 + fr, fq * 8), boff = lds_byte(wc * 32 + fr, fq * 8);
#define PG8_SA(b, h) (((b) * 2 + (h)) * HTB)
#define PG8_SB(b, h) ((4 + (b) * 2 + (h)) * HTB)
#define PG8_STAGE(bufoff, gbase, voff) do { _Pragma("unroll") for (int _i = 0; _i < 2; ++_i) \
        __builtin_amdgcn_global_load_lds((const unsigned*)((const char*)(gbase) + (voff)[_i]), (PG8_LAS unsigned*)(lds + (bufoff) + ldsw + _i * 8192), 16, 0, 0); } while (0)
#define PG8_LDA(dst, b, h) do { _Pragma("unroll") for (int m = 0; m < 4; ++m) _Pragma("unroll") for (int k = 0; k < 2; ++k) dst[m][k] = *(const PG8_LAS bf16x8*)(lds + PG8_SA(b, h) + aoff + m * 2048 + k * 1024); } while (0)
#define PG8_LDB(dst, b, h) do { _Pragma("unroll") for (int n = 0; n < 2; ++n) _Pragma("unroll") for (int k = 0; k < 2; ++k) dst[n][k] = *(const PG8_LAS bf16x8*)(lds + PG8_SB(b, h) + boff + n * 2048 + k * 1024); } while (0)
#define PG8_MMA(ai, bj, At, Bt) do { __builtin_amdgcn_s_setprio(1); _Pragma("unroll") for (int m = 0; m < 4; ++m) _Pragma("unroll") for (int n = 0; n < 2; ++n) _Pragma("unroll") for (int k = 0; k < 2; ++k) \
        acc[ai][bj][m][n] = __builtin_amdgcn_mfma_f32_16x16x32_bf16(Bt[n][k], At[m][k], acc[ai][bj][m][n], 0, 0, 0); __builtin_amdgcn_s_setprio(0); } while (0)
#define PG8_WAIT_V(n) asm volatile("s_waitcnt vmcnt(" #n ")" ::: "memory")
#define PG8_WAIT_L(n) asm volatile("s_waitcnt lgkmcnt(" #n ")" ::: "memory")
#define PG8_BAR __builtin_amdgcn_s_barrier()
#define PG8_SCHED __builtin_amdgcn_sched_barrier(0)
    Unit cur, nxt; int ui = 0;
    if (!S.next(0, cur)) return;
    f32x4 pre[2];
    f32x4 acc[2][2][4][2];
#pragma unroll
    for (int a = 0; a < 2; ++a)
#pragma unroll
        for (int b = 0; b < 2; ++b)
#pragma unroll
            for (int m = 0; m < 4; ++m)
#pragma unroll
                for (int n = 0; n < 2; ++n) acc[a][b][m][n] = (f32x4){0.f, 0.f, 0.f, 0.f};
    bf16x8 At[4][2], B0[2][2], B1[2][2];
    const char* cA = (const char*)g.A + (size_t)cur.pm * tstepA; const char* cB = (const char*)g.Bt + (size_t)cur.pn * tstepB;
    S.a_ready(cur);
    if constexpr (SP2) {
        PG8_STAGE(PG8_SB(0, 0), cB, voffB); PG8_STAGE(PG8_SB(0, 1), cB + hstepB, voffB); PG8_STAGE(PG8_SA(0, 0), cA, voffA); PG8_STAGE(PG8_SA(0, 1), cA + hstepA, voffA);
        if (wr == 1) PG8_BAR;
        PG8_WAIT_V(2); PG8_BAR;
        PG8_STAGE(PG8_SB(1, 0), cB + kstep, voffB); PG8_STAGE(PG8_SA(1, 0), cA + kstep, voffA); PG8_STAGE(PG8_SB(1, 1), cB + hstepB + kstep, voffB);
        PG8_WAIT_V(6); PG8_BAR;
    } else {
        PG8_STAGE(PG8_SB(0, 0), cB, voffB); PG8_STAGE(PG8_SA(0, 0), cA, voffA); PG8_STAGE(PG8_SB(0, 1), cB + hstepB, voffB); PG8_STAGE(PG8_SA(0, 1), cA + hstepA, voffA);
        if (wr == 1) PG8_BAR;
        PG8_WAIT_V(4); PG8_BAR;
        PG8_STAGE(PG8_SB(1, 0), cB + kstep, voffB); PG8_STAGE(PG8_SA(1, 0), cA + kstep, voffA); PG8_STAGE(PG8_SB(1, 1), cB + hstepB + kstep, voffB);
        PG8_WAIT_V(6); PG8_BAR;
    }
    for (;;) {
        const bool has_next = S.next(ui + 1, nxt);
        const char* nA = has_next ? (const char*)g.A + (size_t)nxt.pm * tstepA : cA; const char* nB = has_next ? (const char*)g.Bt + (size_t)nxt.pn * tstepB : cB;
        for (int t = 0; t < nt; t += 2) {
            const bool last = (t == nt - 2);
            if (last) E.prefetch(cur, wr, wc, fr, fq, pre);
            const char* a1 = cA + (size_t)(t + 1) * kstep;
            const char* a2 = last ? nA : cA + (size_t)(t + 2) * kstep; const char* b2 = last ? nB : cB + (size_t)(t + 2) * kstep;
            const char* a3 = a2 + kstep; const char* b3 = b2 + kstep;
            if (last && has_next) S.a_ready(nxt);
            if constexpr (SP2) {
            PG8_LDB(B0, 0, 0); PG8_LDB(B1, 0, 1); PG8_SCHED; PG8_LDA(At, 0, 0); PG8_STAGE(PG8_SA(1, 1), a1 + hstepA, voffA);
            PG8_WAIT_V(8); PG8_WAIT_L(0); PG8_BAR; PG8_MMA(0, 0, At, B0); PG8_MMA(0, 1, At, B1); PG8_BAR; PG8_SCHED;
            PG8_LDA(At, 0, 1); PG8_STAGE(PG8_SB(0, 0), b2, voffB); PG8_STAGE(PG8_SB(0, 1), b2 + hstepB, voffB); PG8_STAGE(PG8_SA(0, 0), a2, voffA);
            PG8_WAIT_V(8); PG8_WAIT_L(0); PG8_BAR; PG8_MMA(1, 0, At, B0); PG8_MMA(1, 1, At, B1); PG8_BAR; PG8_SCHED;
            PG8_LDB(B0, 1, 0); PG8_LDB(B1, 1, 1); PG8_SCHED; PG8_LDA(At, 1, 0); PG8_STAGE(PG8_SA(0, 1), a2 + hstepA, voffA);
            PG8_WAIT_V(8); PG8_WAIT_L(0); PG8_BAR; PG8_MMA(0, 0, At, B0); PG8_MMA(0, 1, At, B1); PG8_BAR; PG8_SCHED;
            PG8_LDA(At, 1, 1); PG8_STAGE(PG8_SB(1, 0), b3, voffB); PG8_STAGE(PG8_SB(1, 1), b3 + hstepB, voffB); PG8_STAGE(PG8_SA(1, 0), a3, voffA);
            PG8_WAIT_V(8); PG8_WAIT_L(0); PG8_BAR; PG8_MMA(1, 0, At, B0); PG8_MMA(1, 1, At, B1); PG8_BAR; PG8_SCHED;
            } else {
            PG8_LDB(B0, 0, 0); PG8_SCHED; PG8_LDA(At, 0, 0); PG8_STAGE(PG8_SA(1, 1), a1 + hstepA, voffA);
            PG8_WAIT_L(8); PG8_BAR; PG8_WAIT_L(0); PG8_MMA(0, 0, At, B0); PG8_BAR; PG8_SCHED;
            PG8_LDB(B1, 0, 1); PG8_STAGE(PG8_SB(0, 0), b2, voffB);
            PG8_BAR; PG8_WAIT_L(0); PG8_MMA(0, 1, At, B1); PG8_BAR;
            PG8_LDA(At, 0, 1); PG8_STAGE(PG8_SA(0, 0), a2, voffA);
            PG8_BAR; PG8_WAIT_L(0); PG8_MMA(1, 0, At, B0); PG8_BAR; PG8_SCHED;
            PG8_STAGE(PG8_SB(0, 1), b2 + hstepB, voffB);
            PG8_WAIT_V(6); PG8_BAR; PG8_MMA(1, 1, At, B1); PG8_BAR;
            PG8_LDB(B0, 1, 0); PG8_SCHED; PG8_LDA(At, 1, 0); PG8_STAGE(PG8_SA(0, 1), a2 + hstepA, voffA);
            PG8_WAIT_L(8); PG8_BAR; PG8_WAIT_L(0); PG8_MMA(0, 0, At, B0); PG8_BAR; PG8_SCHED;
            PG8_LDB(B1, 1, 1); PG8_STAGE(PG8_SB(1, 0), b3, voffB);
            PG8_BAR; PG8_WAIT_L(0); PG8_MMA(0, 1, At, B1); PG8_BAR;
            PG8_LDA(At, 1, 1); PG8_STAGE(PG8_SA(1, 0), a3, voffA);
            PG8_BAR; PG8_WAIT_L(0); PG8_MMA(1, 0, At, B0); PG8_BAR; PG8_SCHED;
            PG8_STAGE(PG8_SB(1, 1), b3 + hstepB, voffB);
            PG8_WAIT_V(6); PG8_BAR; PG8_MMA(1, 1, At, B1); PG8_BAR;
            }
        }
        if constexpr (ALIGN_EPI) { if (wr == 0) PG8_BAR; }
        E(acc, cur, wr, wc, fr, fq, pre); S.done(cur);
        if (!has_next) break;
#pragma unroll
        for (int a = 0; a < 2; ++a)
#pragma unroll
            for (int b = 0; b < 2; ++b)
#pragma unroll
                for (int m = 0; m < 4; ++m)
#pragma unroll
                    for (int n = 0; n < 2; ++n) acc[a][b][m][n] = (f32x4){0.f, 0.f, 0.f, 0.f};
        cur = nxt; cA = nA; cB = nB; ++ui;
        if constexpr (ALIGN_EPI) { if (wr == 1) PG8_BAR; }
    }
    PG8_WAIT_V(0);
    if constexpr (!ALIGN_EPI) { if (wr == 0) PG8_BAR; }
    PG8_BAR;
#undef PG8_SA
#undef PG8_SB
#undef PG8_STAGE
#undef PG8_LDA
#undef PG8_LDB
#undef PG8_MMA
#undef PG8_WAIT_V
#undef PG8_WAIT_L
#undef PG8_BAR
#undef PG8_SCHED
}
template <class Epi>
__device__ __forceinline__ void gemm_half(PG8_LAS unsigned char* lds, const Gemm g, int pm, int hsel, int pn, bool has, const Epi& E) {
    const int tid = tid_opaque(), wid = __builtin_amdgcn_readfirstlane(tid >> 6), lane = tid & 63, wr = wid >> 2, wc = wid & 3, fr = lane & 15, fq = lane >> 4;
    if (!has) return;
    const int nt = g.K / BK;
    unsigned voffA[2], voffB[2];
#pragma unroll
    for (int i = 0; i < 2; ++i) { int R, C; stage_rc(tid * 16 + i * 8192, R, C); const int Rb = Epi::PERM ? ((R & ~31) + perm32(R & 31)) : R;
        voffA[i] = (unsigned)(R * g.lda + C) * 2u; voffB[i] = (unsigned)(Rb * g.ldb + C) * 2u; }
    const size_t kstep = (size_t)(BK * 2), hstepB = (size_t)HALF * g.ldb * 2;
    const unsigned ldsw = (unsigned)wid * 1024u;
    const int aoff = lds_byte(wr * 64 + fr, fq * 8), boff = lds_byte(wc * 32 + fr, fq * 8);
#define PG8_SA(b, h) (((b) * 2 + (h)) * HTB)
#define PG8_SB(b, h) ((4 + (b) * 2 + (h)) * HTB)
#define PG8_STAGE(bufoff, gbase, voff) do { _Pragma("unroll") for (int _i = 0; _i < 2; ++_i) \
        __builtin_amdgcn_global_load_lds((const unsigned*)((const char*)(gbase) + (voff)[_i]), (PG8_LAS unsigned*)(lds + (bufoff) + ldsw + _i * 8192), 16, 0, 0); } while (0)
#define PG8_LDA(dst, b, h) do { _Pragma("unroll") for (int m = 0; m < 4; ++m) _Pragma("unroll") for (int k = 0; k < 2; ++k) dst[m][k] = *(const PG8_LAS bf16x8*)(lds + PG8_SA(b, h) + aoff + m * 2048 + k * 1024); } while (0)
#define PG8_LDB(dst, b, h) do { _Pragma("unroll") for (int n = 0; n < 2; ++n) _Pragma("unroll") for (int k = 0; k < 2; ++k) dst[n][k] = *(const PG8_LAS bf16x8*)(lds + PG8_SB(b, h) + boff + n * 2048 + k * 1024); } while (0)
#define PG8_MMAH(bj, At, Bt) do { __builtin_amdgcn_s_setprio(1); _Pragma("unroll") for (int m = 0; m < 4; ++m) _Pragma("unroll") for (int n = 0; n < 2; ++n) _Pragma("unroll") for (int k = 0; k < 2; ++k) \
        acc[bj][m][n] = __builtin_amdgcn_mfma_f32_16x16x32_bf16(Bt[n][k], At[m][k], acc[bj][m][n], 0, 0, 0); __builtin_amdgcn_s_setprio(0); } while (0)
    f32x4 acc[2][4][2];
#pragma unroll
    for (int b = 0; b < 2; ++b)
#pragma unroll
        for (int m = 0; m < 4; ++m)
#pragma unroll
            for (int n = 0; n < 2; ++n) acc[b][m][n] = (f32x4){0.f, 0.f, 0.f, 0.f};
    bf16x8 At[4][2], B0[2][2], B1[2][2];
    const char* cA = (const char*)g.A + ((size_t)pm * BM + (size_t)HALF * hsel) * g.lda * 2; const char* cB = (const char*)g.Bt + (size_t)pn * BM * g.ldb * 2;
    PG8_STAGE(PG8_SB(0, 0), cB, voffB); PG8_STAGE(PG8_SB(0, 1), cB + hstepB, voffB); PG8_STAGE(PG8_SA(0, 0), cA, voffA);
    PG8_STAGE(PG8_SB(1, 0), cB + kstep, voffB); PG8_STAGE(PG8_SB(1, 1), cB + hstepB + kstep, voffB); PG8_STAGE(PG8_SA(1, 0), cA + kstep, voffA);
    for (int t = 0; t < nt; t += 2) {
        asm volatile("s_waitcnt vmcnt(6)" ::: "memory"); __builtin_amdgcn_s_barrier();
        PG8_LDB(B0, 0, 0); PG8_LDB(B1, 0, 1); PG8_LDA(At, 0, 0);
        asm volatile("s_waitcnt lgkmcnt(0)" ::: "memory"); __builtin_amdgcn_s_barrier();
        if (t + 2 < nt) { const char* a2 = cA + (size_t)(t + 2) * kstep; const char* b2 = cB + (size_t)(t + 2) * kstep;
            PG8_STAGE(PG8_SB(0, 0), b2, voffB); PG8_STAGE(PG8_SB(0, 1), b2 + hstepB, voffB); PG8_STAGE(PG8_SA(0, 0), a2, voffA); }
        PG8_MMAH(0, At, B0); PG8_MMAH(1, At, B1);
        if (t + 2 < nt) asm volatile("s_waitcnt vmcnt(6)" ::: "memory"); else asm volatile("s_waitcnt vmcnt(0)" ::: "memory");
        __builtin_amdgcn_s_barrier();
        PG8_LDB(B0, 1, 0); PG8_LDB(B1, 1, 1); PG8_LDA(At, 1, 0);
        asm volatile("s_waitcnt lgkmcnt(0)" ::: "memory"); __builtin_amdgcn_s_barrier();
        if (t + 3 < nt) { const char* a3 = cA + (size_t)(t + 3) * kstep; const char* b3 = cB + (size_t)(t + 3) * kstep;
            PG8_STAGE(PG8_SB(1, 0), b3, voffB); PG8_STAGE(PG8_SB(1, 1), b3 + hstepB, voffB); PG8_STAGE(PG8_SA(1, 0), a3, voffA); }
        PG8_MMAH(0, At, B0); PG8_MMAH(1, At, B1);
    }
    E.half(acc, pm, hsel, pn, wr, wc, fr, fq);
    asm volatile("s_waitcnt vmcnt(0)" ::: "memory"); __builtin_amdgcn_s_barrier();
#undef PG8_SA
#undef PG8_SB
#undef PG8_STAGE
#undef PG8_LDA
#undef PG8_LDB
#undef PG8_MMAH
}
struct MUnit { int pm, pn, kind; };
__device__ __forceinline__ const char* uni64(const void* p) { const unsigned long long v = (unsigned long long)p; const unsigned lo = __builtin_amdgcn_readfirstlane((unsigned)v), hi = __builtin_amdgcn_readfirstlane((unsigned)(v >> 32)); return (const char*)(((unsigned long long)hi << 32) | lo); }
__device__ __forceinline__ int uni32(int v) { return __builtin_amdgcn_readfirstlane(v); }
struct MDesc { const bf16_t* A; const bf16_t* Bt; int lda, ldb, nt; };
template <class Epi, class Sched, bool ALIGN_EPI = false>
__device__ __forceinline__ void gemm_multi(PG8_LAS unsigned char* lds, const Sched& S, const Epi& E) {
    const int tid = tid_opaque(), wid = __builtin_amdgcn_readfirstlane(tid >> 6), lane = tid & 63, wr = wid >> 2, wc = wid & 3, fr = lane & 15, fq = lane >> 4;
    unsigned vA1[2], sA[2], sB[2];
#define PG8_SETV(vA, vB, lda_, ldb_) do { _Pragma("unroll") for (int _i = 0; _i < 2; ++_i) { int _R, _C; stage_rc(tid * 16 + _i * 8192, _R, _C); const int _Rb = Epi::PERM ? ((_R & ~31) + perm32(_R & 31)) : _R; \
        vA[_i] = (unsigned)(_R * (lda_) + _C) * 2u; vB[_i] = (unsigned)(_Rb * (ldb_) + _C) * 2u; } } while (0)
    const size_t kstep = (size_t)(BK * 2);
    const unsigned ldsw = (unsigned)wid * 1024u;
    const int aoff = lds_byte(wr * 64 + fr, fq * 8), boff = lds_byte(wc * 32 + fr, fq * 8);
#define PG8_SA(b, h) (((b) * 2 + (h)) * HTB)
#define PG8_SB(b, h) ((4 + (b) * 2 + (h)) * HTB)
#define PG8_STG(bufoff, gbase, voff) do { _Pragma("unroll") for (int _i = 0; _i < 2; ++_i) \
        __builtin_amdgcn_global_load_lds((const unsigned*)((const char*)(gbase) + (voff)[_i]), (PG8_LAS unsigned*)(lds + (bufoff) + ldsw + _i * 8192), 16, 0, 0); } while (0)
#define PG8_LDA(dst, b, h) do { _Pragma("unroll") for (int m = 0; m < 4; ++m) _Pragma("unroll") for (int k = 0; k < 2; ++k) dst[m][k] = *(const PG8_LAS bf16x8*)(lds + PG8_SA(b, h) + aoff + m * 2048 + k * 1024); } while (0)
#define PG8_LDB(dst, b, h) do { _Pragma("unroll") for (int n = 0; n < 2; ++n) _Pragma("unroll") for (int k = 0; k < 2; ++k) dst[n][k] = *(const PG8_LAS bf16x8*)(lds + PG8_SB(b, h) + boff + n * 2048 + k * 1024); } while (0)
#define PG8_MMA(ai, bj, At, Bt) do { __builtin_amdgcn_s_setprio(1); _Pragma("unroll") for (int m = 0; m < 4; ++m) _Pragma("unroll") for (int n = 0; n < 2; ++n) _Pragma("unroll") for (int k = 0; k < 2; ++k) \
        acc[ai][bj][m][n] = __builtin_amdgcn_mfma_f32_16x16x32_bf16(Bt[n][k], At[m][k], acc[ai][bj][m][n], 0, 0, 0); __builtin_amdgcn_s_setprio(0); } while (0)
#define PG8_WAIT_V(n) asm volatile("s_waitcnt vmcnt(" #n ")" ::: "memory")
#define PG8_WAIT_L(n) asm volatile("s_waitcnt lgkmcnt(" #n ")" ::: "memory")
#define PG8_BAR __builtin_amdgcn_s_barrier()
#define PG8_SCHED __builtin_amdgcn_sched_barrier(0)
    MUnit cur, nxt; int ui = 0;
    if (!S.next(0, cur)) return;
    MDesc dc = S.desc(cur.kind);
    PG8_SETV(sA, sB, dc.lda, dc.ldb); vA1[0] = sA[0]; vA1[1] = sA[1];
    f32x4 acc[2][2][4][2];
#pragma unroll
    for (int a = 0; a < 2; ++a)
#pragma unroll
        for (int b = 0; b < 2; ++b)
#pragma unroll
            for (int m = 0; m < 4; ++m)
#pragma unroll
                for (int n = 0; n < 2; ++n) acc[a][b][m][n] = (f32x4){0.f, 0.f, 0.f, 0.f};
    bf16x8 At[4][2], B0[2][2], B1[2][2];
    dc.lda = uni32(dc.lda); dc.ldb = uni32(dc.ldb); dc.nt = uni32(dc.nt);
    const char* cA = uni64((const char*)dc.A + (size_t)cur.pm * BM * dc.lda * 2); const char* cB = uni64((const char*)dc.Bt + (size_t)cur.pn * BM * dc.ldb * 2);
    { const size_t hA = (size_t)HALF * dc.lda * 2, hB = (size_t)HALF * dc.ldb * 2;
      PG8_STG(PG8_SB(0, 0), cB, sB); PG8_STG(PG8_SB(0, 1), cB + hB, sB); PG8_STG(PG8_SA(0, 0), cA, sA); PG8_STG(PG8_SA(0, 1), cA + hA, sA);
      if (wr == 1) PG8_BAR;
      PG8_WAIT_V(2); PG8_BAR;
      PG8_STG(PG8_SB(1, 0), cB + kstep, sB); PG8_STG(PG8_SA(1, 0), cA + kstep, sA); PG8_STG(PG8_SB(1, 1), cB + hB + kstep, sB);
      PG8_WAIT_V(6); PG8_BAR; }
    for (;;) {
        const bool has_next = S.next(ui + 1, nxt);
        MDesc dn = has_next ? S.desc(nxt.kind) : dc; dn.lda = uni32(dn.lda); dn.ldb = uni32(dn.ldb); dn.nt = uni32(dn.nt);
        const char* nA = uni64(has_next ? (const char*)dn.A + (size_t)nxt.pm * BM * dn.lda * 2 : cA); const char* nB = uni64(has_next ? (const char*)dn.Bt + (size_t)nxt.pn * BM * dn.ldb * 2 : cB);
        const size_t hA = (size_t)HALF * dc.lda * 2, hB = (size_t)HALF * dc.ldb * 2;
        const int nt = dc.nt;
        for (int t = 0; t < nt; t += 2) {
            const bool last = (t == nt - 2);
            const char* a1 = cA + (size_t)(t + 1) * kstep;
            const char* a2 = last ? nA : cA + (size_t)(t + 2) * kstep; const char* b2 = last ? nB : cB + (size_t)(t + 2) * kstep;
            const char* a3 = a2 + kstep; const char* b3 = b2 + kstep;
            const size_t hA2 = (size_t)HALF * (last ? dn.lda : dc.lda) * 2, hB2 = (size_t)HALF * (last ? dn.ldb : dc.ldb) * 2;
            if (last) PG8_SETV(sA, sB, dn.lda, dn.ldb);
            if (last && has_next) S.a_ready(nxt);
            PG8_LDB(B0, 0, 0); PG8_LDB(B1, 0, 1); PG8_SCHED; PG8_LDA(At, 0, 0); PG8_STG(PG8_SA(1, 1), a1 + hA, vA1);
            PG8_WAIT_V(8); PG8_WAIT_L(0); PG8_BAR; PG8_MMA(0, 0, At, B0); PG8_MMA(0, 1, At, B1); PG8_BAR; PG8_SCHED;
            PG8_LDA(At, 0, 1); PG8_STG(PG8_SB(0, 0), b2, sB); PG8_STG(PG8_SB(0, 1), b2 + hB2, sB); PG8_STG(PG8_SA(0, 0), a2, sA);
            PG8_WAIT_V(8); PG8_WAIT_L(0); PG8_BAR; PG8_MMA(1, 0, At, B0); PG8_MMA(1, 1, At, B1); PG8_BAR; PG8_SCHED;
            PG8_LDB(B0, 1, 0); PG8_LDB(B1, 1, 1); PG8_SCHED; PG8_LDA(At, 1, 0); PG8_STG(PG8_SA(0, 1), a2 + hA2, sA);
            PG8_WAIT_V(8); PG8_WAIT_L(0); PG8_BAR; PG8_MMA(0, 0, At, B0); PG8_MMA(0, 1, At, B1); PG8_BAR; PG8_SCHED;
            PG8_LDA(At, 1, 1); PG8_STG(PG8_SB(1, 0), b3, sB); PG8_STG(PG8_SB(1, 1), b3 + hB2, sB); PG8_STG(PG8_SA(1, 0), a3, sA);
            PG8_WAIT_V(8); PG8_WAIT_L(0); PG8_BAR; PG8_MMA(1, 0, At, B0); PG8_MMA(1, 1, At, B1); PG8_BAR; PG8_SCHED;
        }
        if constexpr (ALIGN_EPI) { if (wr == 0) PG8_BAR; }
        E(acc, cur, wr, wc, fr, fq); S.done(cur);
        if (!has_next) break;
#pragma unroll
        for (int a = 0; a < 2; ++a)
#pragma unroll
            for (int b = 0; b < 2; ++b)
#pragma unroll
                for (int m = 0; m < 4; ++m)
#pragma unroll
                    for (int n = 0; n < 2; ++n) acc[a][b][m][n] = (f32x4){0.f, 0.f, 0.f, 0.f};
        cur = nxt; cA = nA; cB = nB; ++ui; dc = dn; vA1[0] = sA[0]; vA1[1] = sA[1];
        if constexpr (ALIGN_EPI) { if (wr == 1) PG8_BAR; }
    }
    PG8_WAIT_V(0);
    if constexpr (!ALIGN_EPI) { if (wr == 0) PG8_BAR; }
    PG8_BAR;
#undef PG8_SA
#undef PG8_SB
#undef PG8_STG
#undef PG8_SETV
#undef PG8_LDA
#undef PG8_LDB
#undef PG8_MMA
#undef PG8_WAIT_V
#undef PG8_WAIT_L
#undef PG8_BAR
#undef PG8_SCHED
}
}
constexpr int BATCH = 4, SEQ = 4096, T = BATCH * SEQ, DM = 1024, FF = 2816, DEPTH = 2;
constexpr int NH = 8, QK = 96, NOPE = 64, ROPE = 32, VD = 64, QR = 256, KVR = 128;
constexpr int NPC = 3328;
constexpr int NGC = 3072;
constexpr int RWC = 1792;
constexpr float EPS = 1e-6f;

typedef unsigned short bf16_t;
typedef float f32x4 __attribute__((ext_vector_type(4)));
typedef float f32x2 __attribute__((ext_vector_type(2)));
typedef unsigned u32x4 __attribute__((ext_vector_type(4)));
typedef unsigned u32x2 __attribute__((ext_vector_type(2)));
#define LAS __attribute__((address_space(3)))

__device__ __forceinline__ float bf2f(unsigned short b) { return __uint_as_float(((unsigned)b) << 16); }
__device__ __forceinline__ float bflo(unsigned w) { return __uint_as_float(w << 16); }
__device__ __forceinline__ float bfhi(unsigned w) { return __uint_as_float(w & 0xffff0000u); }
__device__ __forceinline__ unsigned f2bf(float f) { unsigned u = __builtin_bit_cast(unsigned, f); return (u + 0x7fffu + ((u >> 16) & 1u)) >> 16; }
__device__ __forceinline__ unsigned pk2(float lo, float hi) { return f2bf(lo) | (f2bf(hi) << 16); }
typedef __bf16 bf16x2h __attribute__((ext_vector_type(2)));
__device__ __forceinline__ unsigned pk2h(float lo, float hi) { f32x2 v = {lo, hi}; bf16x2h b = __builtin_convertvector(v, bf16x2h); return __builtin_bit_cast(unsigned, b); }
__device__ __forceinline__ unsigned short f2bfh(float f) { return (unsigned short)(pk2h(f, f) & 0xffffu); }
__device__ __forceinline__ float wave_sum_dpp(float v) {
    v += __builtin_bit_cast(float, __builtin_amdgcn_update_dpp(0, __builtin_bit_cast(int, v), 0xB1, 0xF, 0xF, false));
    v += __builtin_bit_cast(float, __builtin_amdgcn_update_dpp(0, __builtin_bit_cast(int, v), 0x4E, 0xF, 0xF, false));
    v += __builtin_bit_cast(float, __builtin_amdgcn_update_dpp(0, __builtin_bit_cast(int, v), 0x141, 0xF, 0xF, false));
    v += __builtin_bit_cast(float, __builtin_amdgcn_update_dpp(0, __builtin_bit_cast(int, v), 0x140, 0xF, 0xF, false));
    v += __builtin_bit_cast(float, __builtin_amdgcn_update_dpp(0, __builtin_bit_cast(int, v), 0x142, 0xA, 0xF, false));
    v += __builtin_bit_cast(float, __builtin_amdgcn_update_dpp(0, __builtin_bit_cast(int, v), 0x143, 0xC, 0xF, false));
    return __builtin_bit_cast(float, __builtin_amdgcn_readlane(__builtin_bit_cast(int, v), 63));
}
__device__ __forceinline__ float tanh_fast(float x) { return 1.f - 2.f * __builtin_amdgcn_rcpf(1.f + __expf(2.f * x)); }
__device__ __forceinline__ float softplus_fast(float x) { return fmaxf(x, 0.f) + (__builtin_amdgcn_logf(1.f + __expf(-fabsf(x))) * 0.6931471805599453f)    ; }
__device__ __forceinline__ float wave_sum(float v) {
#pragma unroll
    for (int o = 1; o < 64; o <<= 1) v += __shfl_xor(v, o);
    return v;
}
__device__ __forceinline__ float sigmoidf_(float x) { return __builtin_amdgcn_rcpf(1.f + __expf(-x)); }
__device__ __forceinline__ float gelu_tanh(float x) {
    const float u = 0.7978845608028654f * (x + 0.044715f * x * x * x);
    return x * sigmoidf_(2.f * u);
}
__device__ __forceinline__ float sum_x16_x32(float s) {
    u32x2 r = __builtin_amdgcn_permlane16_swap(__float_as_uint(s), __float_as_uint(s), false, false); s = __uint_as_float(r.x) + __uint_as_float(r.y);
    r = __builtin_amdgcn_permlane32_swap(__float_as_uint(s), __float_as_uint(s), false, false); return __uint_as_float(r.x) + __uint_as_float(r.y);
}
__device__ __forceinline__ float rstd16(const float* ssq, int row, int fq) {
    const f32x4 a = *(const f32x4*)(ssq + (size_t)row * 16 + 4 * fq);
    float s = (a[0] + a[1]) + (a[2] + a[3]); s += __shfl_xor(s, 16); s += __shfl_xor(s, 32);
    return __builtin_amdgcn_rsqf(s * (1.f / DM) + EPS);
}

using pg8::Unit; using pg8::cvt_pk_bf16;
__device__ __forceinline__ void rstd16x8(const float* ssq, int row0, int fq, float (&rs)[2][4]) {
    f32x4 a[2][4];
#pragma unroll
    for (int ai = 0; ai < 2; ++ai)
#pragma unroll
        for (int m = 0; m < 4; ++m) a[ai][m] = *(const f32x4*)(ssq + (size_t)(row0 + ai * 128 + m * 16) * 16 + 4 * fq);
    __builtin_amdgcn_sched_barrier(0);
#pragma unroll
    for (int ai = 0; ai < 2; ++ai)
#pragma unroll
        for (int m = 0; m < 4; ++m) { float s = (a[ai][m][0] + a[ai][m][1]) + (a[ai][m][2] + a[ai][m][3]); s += __shfl_xor(s, 16); s += __shfl_xor(s, 32); rs[ai][m] = __builtin_amdgcn_rsqf(s * (1.f / DM) + EPS); }
}
__device__ __forceinline__ float rstd_of(const f32x4 v) { float s = (v[0] + v[1]) + (v[2] + v[3]); s += __shfl_xor(s, 16); s += __shfl_xor(s, 32); return __builtin_amdgcn_rsqf(s * (1.f / DM) + EPS); }
template <int N> __device__ __forceinline__ void rstd_batch(const f32x4 (&v)[N], float (&out)[N]) {
    float s[N], t[N];
#pragma unroll
    for (int i = 0; i < N; ++i) s[i] = (v[i][0] + v[i][1]) + (v[i][2] + v[i][3]);
#pragma unroll
    for (int i = 0; i < N; ++i) t[i] = __shfl_xor(s[i], 16);
    __builtin_amdgcn_sched_barrier(0);
#pragma unroll
    for (int i = 0; i < N; ++i) s[i] += t[i];
#pragma unroll
    for (int i = 0; i < N; ++i) t[i] = __shfl_xor(s[i], 32);
    __builtin_amdgcn_sched_barrier(0);
#pragma unroll
    for (int i = 0; i < N; ++i) out[i] = __builtin_amdgcn_rsqf((s[i] + t[i]) * (1.f / DM) + EPS);
}
#define EPI_PREFETCH_SSQ(ROW0) __device__ __forceinline__ void prefetch(const Unit& u, int wr, int wc, int fr, int fq, f32x4 (&pre)[2]) const { const int row0 = (ROW0); \
        _Pragma("unroll") for (int m = 0; m < 2; ++m) pre[m] = *(const f32x4*)(ssq + (size_t)(row0 + m * 16) * 16 + 4 * fq); }
#define EPI_PREFETCH_NONE __device__ __forceinline__ void prefetch(const Unit&, int, int, int, int, f32x4 (&)[2]) const {}
#define EPI_RS_DECL(ROW0) f32x4 pre1[6]; _Pragma("unroll") for (int q = 0; q < 6; ++q) pre1[q] = *(const f32x4*)(ssq + (size_t)((ROW0) + ((q + 2) >> 2) * 128 + ((q + 2) & 3) * 16) * 16 + 4 * fq); __builtin_amdgcn_sched_barrier(0);
struct EpiUp {
    static constexpr bool PERM = true;
    bf16_t* O; const float* ssq;
    EPI_PREFETCH_SSQ(u.pm * 256 + wr * 64 + fr)
    __device__ __forceinline__ void operator()(const f32x4 (&acc)[2][2][4][2], const Unit& u, int wr, int wc, int fr, int fq, const f32x4 (&pre)[2]) const {
        const int row0 = u.pm * 256 + wr * 64 + fr, col0 = u.pn * 128 + wc * 32 + 8 * fq;
        EPI_RS_DECL(row0)
        float rs[2][4];
        { float r2[2]; rstd_batch<2>(pre, r2); rs[0][0] = r2[0]; rs[0][1] = r2[1]; }
#pragma unroll
        for (int ai = 0; ai < 2; ++ai)
#pragma unroll
            for (int m = 0; m < 4; ++m) {
                if (ai == 0 && m == 2) { float r6[6]; rstd_batch<6>(pre1, r6);
#pragma unroll
                    for (int q = 0; q < 6; ++q) rs[(q + 2) >> 2][(q + 2) & 3] = r6[q]; }
                const int row = row0 + ai * 128 + m * 16; const float r_ = rs[ai][m];
                float o[8];
                const f32x2 nrl = {-r_ * 1.4426950408889634f, -r_ * 1.4426950408889634f}, rs2 = {r_ * r_, r_ * r_};
#pragma unroll
                for (int n = 0; n < 2; ++n)
#pragma unroll
                    for (int j = 0; j < 4; j += 2) { const f32x2 g2 = {acc[ai][0][m][n][j], acc[ai][0][m][n][j + 1]}, u2 = {acc[ai][1][m][n][j], acc[ai][1][m][n][j + 1]};
                        const f32x2 t2 = g2 * nrl; f32x2 d2 = {__builtin_amdgcn_exp2f(t2.x), __builtin_amdgcn_exp2f(t2.y)}; d2 = d2 + (f32x2){1.f, 1.f};
                        const f32x2 rr = {__builtin_amdgcn_rcpf(d2.x), __builtin_amdgcn_rcpf(d2.y)}; const f32x2 o2 = ((g2 * u2) * rs2) * rr;
                        o[n * 4 + j] = o2.x; o[n * 4 + j + 1] = o2.y; }
                u32x4 w; w.x = cvt_pk_bf16(o[0], o[1]); w.y = cvt_pk_bf16(o[2], o[3]); w.z = cvt_pk_bf16(o[4], o[5]); w.w = cvt_pk_bf16(o[6], o[7]);
                *(u32x4*)(O + (size_t)row * FF + col0) = w;
            }
    }
    __device__ __forceinline__ void half(const f32x4 (&a)[2][4][2], int pm, int hsel, int pn, int wr, int wc, int fr, int fq) const {
        const int row0 = pm * 256 + 128 * hsel + wr * 64 + fr, col0 = pn * 128 + wc * 32 + 8 * fq;
        f32x4 pq[4];
#pragma unroll
        for (int m = 0; m < 4; ++m) pq[m] = *(const f32x4*)(ssq + (size_t)(row0 + m * 16) * 16 + 4 * fq);
        __builtin_amdgcn_sched_barrier(0);
        float rs[4]; rstd_batch<4>(pq, rs);
#pragma unroll
        for (int m = 0; m < 4; ++m) { const int row = row0 + m * 16; const float r_ = rs[m]; float o[8];
            const f32x2 nrl = {-r_ * 1.4426950408889634f, -r_ * 1.4426950408889634f}, rs2 = {r_ * r_, r_ * r_};
#pragma unroll
            for (int n = 0; n < 2; ++n)
#pragma unroll
                for (int j = 0; j < 4; j += 2) { const f32x2 g2 = {a[0][m][n][j], a[0][m][n][j + 1]}, u2 = {a[1][m][n][j], a[1][m][n][j + 1]};
                    const f32x2 t2 = g2 * nrl; f32x2 d2 = {__builtin_amdgcn_exp2f(t2.x), __builtin_amdgcn_exp2f(t2.y)}; d2 = d2 + (f32x2){1.f, 1.f};
                    const f32x2 rr = {__builtin_amdgcn_rcpf(d2.x), __builtin_amdgcn_rcpf(d2.y)}; const f32x2 o2 = ((g2 * u2) * rs2) * rr;
                    o[n * 4 + j] = o2.x; o[n * 4 + j + 1] = o2.y; }
            u32x4 w; w.x = cvt_pk_bf16(o[0], o[1]); w.y = cvt_pk_bf16(o[2], o[3]); w.z = cvt_pk_bf16(o[4], o[5]); w.w = cvt_pk_bf16(o[6], o[7]);
            *(u32x4*)(O + (size_t)row * FF + col0) = w; }
    }
};
struct EpiRes {
    static constexpr bool PERM = true;
    bf16_t* hi; bf16_t* lo; float* ssq; float scale; float* outf;
    EPI_PREFETCH_NONE
    __device__ __forceinline__ void operator()(const f32x4 (&acc)[2][2][4][2], const Unit& u, int wr, int wc, int fr, int fq, const f32x4 (&)[2]) const {
        const int row0 = u.pm * 256 + wr * 64 + fr, col0 = u.pn * 256 + wc * 32 + 8 * fq;
#pragma unroll
        for (int aq = 0; aq < 4; ++aq) { const int ai = aq >> 1, m0 = 2 * (aq & 1);
            u32x4 wh[4][2], wl[4][2];
#pragma unroll
            for (int m = m0; m < m0 + 2; ++m)
#pragma unroll
                for (int bj = 0; bj < 2; ++bj) { const size_t off = (size_t)(row0 + ai * 128 + m * 16) * DM + col0 + bj * 128; wh[m][bj] = *(const u32x4*)(hi + off); wl[m][bj] = *(const u32x4*)(lo + off); }
            __builtin_amdgcn_sched_barrier(0);
#pragma unroll
            for (int m = m0; m < m0 + 2; ++m) {
                const int row = row0 + ai * 128 + m * 16; float ss = 0.f;
#pragma unroll
                for (int bj = 0; bj < 2; ++bj) {
                    const size_t off = (size_t)row * DM + col0 + bj * 128;
                    const u32x4 h_ = wh[m][bj], l_ = wl[m][bj];
                    f32x4 h0, h1;
                    h0[0] = bflo(h_.x) + bflo(l_.x); h0[1] = bfhi(h_.x) + bfhi(l_.x); h0[2] = bflo(h_.y) + bflo(l_.y); h0[3] = bfhi(h_.y) + bfhi(l_.y);
                    h1[0] = bflo(h_.z) + bflo(l_.z); h1[1] = bfhi(h_.z) + bfhi(l_.z); h1[2] = bflo(h_.w) + bflo(l_.w); h1[3] = bfhi(h_.w) + bfhi(l_.w);
                    h0 = h0 + acc[ai][bj][m][0] * scale; h1 = h1 + acc[ai][bj][m][1] * scale;
                    ss += ((h0[0] * h0[0] + h0[1] * h0[1]) + (h0[2] * h0[2] + h0[3] * h0[3])) + ((h1[0] * h1[0] + h1[1] * h1[1]) + (h1[2] * h1[2] + h1[3] * h1[3]));
                    if (outf) { *(f32x4*)(outf + off) = h0; *(f32x4*)(outf + off + 4) = h1; }
                    else {
                        u32x4 nh; nh.x = cvt_pk_bf16(h0[0], h0[1]); nh.y = cvt_pk_bf16(h0[2], h0[3]); nh.z = cvt_pk_bf16(h1[0], h1[1]); nh.w = cvt_pk_bf16(h1[2], h1[3]);
                        u32x4 nl; nl.x = cvt_pk_bf16(h0[0] - bflo(nh.x), h0[1] - bfhi(nh.x)); nl.y = cvt_pk_bf16(h0[2] - bflo(nh.y), h0[3] - bfhi(nh.y));
                        nl.z = cvt_pk_bf16(h1[0] - bflo(nh.z), h1[1] - bfhi(nh.z)); nl.w = cvt_pk_bf16(h1[2] - bflo(nh.w), h1[3] - bfhi(nh.w));
                        *(u32x4*)(hi + off) = nh; *(u32x4*)(lo + off) = nl;
                    }
                }
                ss += __shfl_xor(ss, 16); ss += __shfl_xor(ss, 32);
                if (fq == 0) ssq[(size_t)row * 16 + u.pn * 4 + wc] = ss;
            }
        }
    }
};
struct EpiP {
    static constexpr bool PERM = false;
    float* P; int ldp; const float* ssq;
    __device__ __forceinline__ void operator()(const f32x4 (&acc)[2][2][4][2], const Unit& u, int wr, int wc, int fr, int fq) const {
        const int row0 = u.pm * 256 + wr * 64 + fr, col0 = u.pn * 256 + wc * 32 + 4 * fq;
#pragma unroll
        for (int ai = 0; ai < 2; ++ai)
#pragma unroll
            for (int m = 0; m < 4; ++m) {
                const int row = row0 + ai * 128 + m * 16; const float rs = rstd16(ssq, row, fq);
#pragma unroll
                for (int bj = 0; bj < 2; ++bj)
#pragma unroll
                    for (int n = 0; n < 2; ++n) *(f32x4*)(P + (size_t)row * ldp + col0 + bj * 128 + n * 16) = acc[ai][bj][m][n] * rs;
            }
    }
};
struct EpiG {
    static constexpr bool PERM = true;
    bf16_t* G; const float* ssq;
    __device__ __forceinline__ void operator()(const f32x4 (&acc)[2][2][4][2], const Unit& u, int wr, int wc, int fr, int fq) const {
        const int row0 = u.pm * 256 + wr * 64 + fr, col0 = u.pn * 256 + wc * 32 + 8 * fq;
#pragma unroll
        for (int ai = 0; ai < 2; ++ai)
#pragma unroll
            for (int m = 0; m < 4; ++m) {
                const int row = row0 + ai * 128 + m * 16; const float rs = rstd16(ssq, row, fq);
#pragma unroll
                for (int bj = 0; bj < 2; ++bj) {
                    float o[8];
#pragma unroll
                    for (int n = 0; n < 2; ++n)
#pragma unroll
                        for (int j = 0; j < 4; ++j) o[n * 4 + j] = sigmoidf_(acc[ai][bj][m][n][j] * rs);
                    u32x4 w; w.x = cvt_pk_bf16(o[0], o[1]); w.y = cvt_pk_bf16(o[2], o[3]); w.z = cvt_pk_bf16(o[4], o[5]); w.w = cvt_pk_bf16(o[6], o[7]);
                    *(u32x4*)(G + (size_t)row * NGC + col0 + bj * 128) = w;
                }
            }
    }
};
constexpr size_t MF_STRIDE = (size_t)4096 * 1024;
struct EpiMerge {
    static constexpr bool PERM = true;
    const bf16_t* G; float* Mf; bf16_t* Mb; int mode;
    __device__ __forceinline__ void operator()(const f32x4 (&acc)[2][2][4][2], const Unit& u, int wr, int wc, int fr, int fq) const {
        const int row0 = u.pm * 256 + wr * 64 + fr, col0 = u.pn * 256 + wc * 32 + 8 * fq;
#pragma unroll
        for (int ai = 0; ai < 2; ++ai)
#pragma unroll
            for (int m = 0; m < 4; ++m) {
                const int row = row0 + ai * 128 + m * 16;
#pragma unroll
                for (int bj = 0; bj < 2; ++bj) {
                    const int col = col0 + bj * 128;
                    const u32x4 gw = *(const u32x4*)(G + (size_t)row * NGC + col);
                    f32x4 v0, v1;
                    v0[0] = bflo(gw.x) * acc[ai][bj][m][0][0]; v0[1] = bfhi(gw.x) * acc[ai][bj][m][0][1]; v0[2] = bflo(gw.y) * acc[ai][bj][m][0][2]; v0[3] = bfhi(gw.y) * acc[ai][bj][m][0][3];
                    v1[0] = bflo(gw.z) * acc[ai][bj][m][1][0]; v1[1] = bfhi(gw.z) * acc[ai][bj][m][1][1]; v1[2] = bflo(gw.w) * acc[ai][bj][m][1][2]; v1[3] = bfhi(gw.w) * acc[ai][bj][m][1][3];
                    float* mp = Mf + (size_t)row * DM + col;
                    if (mode > 0) { const float* rp = mp + (mode == 2 ? MF_STRIDE : 0); v0 = v0 + *(const f32x4*)rp; v1 = v1 + *(const f32x4*)(rp + 4); }
                    if (mode < 2) { float* wp = mp + (mode == 1 ? MF_STRIDE : 0); *(f32x4*)wp = v0; *(f32x4*)(wp + 4) = v1; }
                    else { u32x4 w; w.x = cvt_pk_bf16(v0[0], v0[1]); w.y = cvt_pk_bf16(v0[2], v0[3]); w.z = cvt_pk_bf16(v1[0], v1[1]); w.w = cvt_pk_bf16(v1[2], v1[3]);
                           *(u32x4*)(Mb + (size_t)row * DM + col) = w; }
                }
            }
    }
};

struct EpiWin {
    static constexpr bool PERM = true;
    bf16_t* PM; bf16_t* PS; bf16_t* PR; float* SGQ; const float* ssq;
    EPI_PREFETCH_SSQ(u.pm * 256 + wr * 64 + fr)
    __device__ __forceinline__ void operator()(const f32x4 (&acc)[2][2][4][2], const Unit& u, int wr, int wc, int fr, int fq, const f32x4 (&pre)[2]) const {
        const int row0 = u.pm * 256 + wr * 64 + fr, cw = wc * 32 + 8 * fq;
        const int kind = u.pn < 2 ? 0 : (u.pn < 6 ? 1 : 2);
        bf16_t* base; int ld, col0;
        if (kind == 0) { base = PM; ld = 512; col0 = u.pn * 256 + cw; } else if (kind == 1) { base = PS; ld = 1024; col0 = (u.pn - 2) * 256 + cw; } else { base = PR; ld = RWC; col0 = (u.pn - 6) * 256 + cw; }
        EPI_RS_DECL(row0)
        float rsv[2][4];
        { float r2[2]; rstd_batch<2>(pre, r2); rsv[0][0] = r2[0]; rsv[0][1] = r2[1]; }
#pragma unroll
        for (int ai = 0; ai < 2; ++ai)
#pragma unroll
            for (int m = 0; m < 4; ++m) {
                if (ai == 0 && m == 2) { float r6[6]; rstd_batch<6>(pre1, r6);
#pragma unroll
                    for (int q = 0; q < 6; ++q) rsv[(q + 2) >> 2][(q + 2) & 3] = r6[q]; }
                const int row = row0 + ai * 128 + m * 16; const float rs = rsv[ai][m]; float ss = 0.f;
#pragma unroll
                for (int bj = 0; bj < 2; ++bj) {
                    float o[8];
#pragma unroll
                    for (int n = 0; n < 2; ++n)
#pragma unroll
                        for (int j = 0; j < 4; ++j) { float v = acc[ai][bj][m][n][j] * rs; if (kind == 1) { v = gelu_tanh(v); ss += v * v; } o[n * 4 + j] = v; }
                    u32x4 w; w.x = cvt_pk_bf16(o[0], o[1]); w.y = cvt_pk_bf16(o[2], o[3]); w.z = cvt_pk_bf16(o[4], o[5]); w.w = cvt_pk_bf16(o[6], o[7]);
                    *(u32x4*)(base + (size_t)row * ld + col0 + bj * 128) = w;
                }
                if (u.pn == 4 || u.pn == 5) { ss += __shfl_xor(ss, 16); ss += __shfl_xor(ss, 32); if (fq == 0) SGQ[(size_t)row * 8 + (u.pn - 4) * 4 + wc] = ss; }
            }
    }
    __device__ __forceinline__ void half(const f32x4 (&a)[2][4][2], int pm, int hsel, int pn, int wr, int wc, int fr, int fq) const {
        const int row0 = pm * 256 + 128 * hsel + wr * 64 + fr, cw = wc * 32 + 8 * fq;
        const int kind = pn < 2 ? 0 : (pn < 6 ? 1 : 2);
        bf16_t* base; int ld, col0;
        if (kind == 0) { base = PM; ld = 512; col0 = pn * 256 + cw; } else if (kind == 1) { base = PS; ld = 1024; col0 = (pn - 2) * 256 + cw; } else { base = PR; ld = RWC; col0 = (pn - 6) * 256 + cw; }
        f32x4 pq[4];
#pragma unroll
        for (int m = 0; m < 4; ++m) pq[m] = *(const f32x4*)(ssq + (size_t)(row0 + m * 16) * 16 + 4 * fq);
        __builtin_amdgcn_sched_barrier(0);
        float rsv[4]; rstd_batch<4>(pq, rsv);
#pragma unroll
        for (int m = 0; m < 4; ++m) { const int row = row0 + m * 16; const float rs = rsv[m]; float ss = 0.f;
#pragma unroll
            for (int bj = 0; bj < 2; ++bj) { float o[8];
#pragma unroll
                for (int n = 0; n < 2; ++n)
#pragma unroll
                    for (int j = 0; j < 4; ++j) { float v = a[bj][m][n][j] * rs; if (kind == 1) { v = gelu_tanh(v); ss += v * v; } o[n * 4 + j] = v; }
                u32x4 w; w.x = cvt_pk_bf16(o[0], o[1]); w.y = cvt_pk_bf16(o[2], o[3]); w.z = cvt_pk_bf16(o[4], o[5]); w.w = cvt_pk_bf16(o[6], o[7]);
                *(u32x4*)(base + (size_t)row * ld + col0 + bj * 128) = w; }
            if (pn == 4 || pn == 5) { ss += __shfl_xor(ss, 16); ss += __shfl_xor(ss, 32); if (fq == 0) SGQ[(size_t)row * 8 + (pn - 4) * 4 + wc] = ss; } }
    }
};
struct EpiGateS {
    static constexpr bool PERM = true;
    bf16_t* S; const float* ssq;
    __device__ __forceinline__ void operator()(const f32x4 (&acc)[2][2][4][2], const Unit& u, int wr, int wc, int fr, int fq) const {
        const int row0 = u.pm * 256 + wr * 64 + fr, col0 = u.pn * 256 + wc * 32 + 8 * fq;
#pragma unroll
        for (int ai = 0; ai < 2; ++ai)
#pragma unroll
            for (int m = 0; m < 4; ++m) {
                const int row = row0 + ai * 128 + m * 16; const float rs = rstd16(ssq, row, fq);
#pragma unroll
                for (int bj = 0; bj < 2; ++bj) {
                    float o[8];
#pragma unroll
                    for (int n = 0; n < 2; ++n)
#pragma unroll
                        for (int j = 0; j < 4; ++j) o[n * 4 + j] = sigmoidf_(acc[ai][bj][m][n][j] * rs);
                    u32x4 w; w.x = cvt_pk_bf16(o[0], o[1]); w.y = cvt_pk_bf16(o[2], o[3]); w.z = cvt_pk_bf16(o[4], o[5]); w.w = cvt_pk_bf16(o[6], o[7]);
                    *(u32x4*)(S + (size_t)row * DM + col0 + bj * 128) = w;
                }
            }
    }
};
struct EpiMerge2 {
    static constexpr bool PERM = true;
    const bf16_t* S; bf16_t* M; int first;
    __device__ __forceinline__ void operator()(const f32x4 (&acc)[2][2][4][2], const Unit& u, int wr, int wc, int fr, int fq) const {
        __builtin_amdgcn_fence(__ATOMIC_ACQUIRE, "agent");
        const int row0 = u.pm * 256 + wr * 64 + fr, col0 = u.pn * 256 + wc * 32 + 8 * fq;
#pragma unroll
        for (int ai = 0; ai < 2; ++ai)
#pragma unroll
            for (int m = 0; m < 4; ++m) {
                const int row = row0 + ai * 128 + m * 16;
#pragma unroll
                for (int bj = 0; bj < 2; ++bj) {
                    const size_t off = (size_t)row * DM + col0 + bj * 128;
                    const u32x4 gw = *(const u32x4*)(S + off);
                    float o[8];
                    o[0] = bflo(gw.x) * acc[ai][bj][m][0][0]; o[1] = bfhi(gw.x) * acc[ai][bj][m][0][1]; o[2] = bflo(gw.y) * acc[ai][bj][m][0][2]; o[3] = bfhi(gw.y) * acc[ai][bj][m][0][3];
                    o[4] = bflo(gw.z) * acc[ai][bj][m][1][0]; o[5] = bfhi(gw.z) * acc[ai][bj][m][1][1]; o[6] = bflo(gw.w) * acc[ai][bj][m][1][2]; o[7] = bfhi(gw.w) * acc[ai][bj][m][1][3];
                    if (!first) { const u32x4 mw = *(const u32x4*)(M + off);
                        o[0] += bflo(mw.x); o[1] += bfhi(mw.x); o[2] += bflo(mw.y); o[3] += bfhi(mw.y); o[4] += bflo(mw.z); o[5] += bfhi(mw.z); o[6] += bflo(mw.w); o[7] += bfhi(mw.w); }
                    u32x4 w; w.x = cvt_pk_bf16(o[0], o[1]); w.y = cvt_pk_bf16(o[2], o[3]); w.z = cvt_pk_bf16(o[4], o[5]); w.w = cvt_pk_bf16(o[6], o[7]);
                    *(u32x4*)(M + off) = w;
                }
            }
    }
};

struct EpiGate3 {
    static constexpr bool PERM = true;
    bf16_t* G0; bf16_t* G1; bf16_t* G2; const float* ssq;
    EPI_PREFETCH_SSQ(u.pm * 256 + wr * 64 + fr)
    __device__ __forceinline__ void operator()(const f32x4 (&acc)[2][2][4][2], const Unit& u, int wr, int wc, int fr, int fq, const f32x4 (&pre)[2]) const {
        const int br = u.pn >> 2;
        const long long d1 = (const char*)G1 - (const char*)G0, d2 = (const char*)G2 - (const char*)G0;
        bf16_t* S = (bf16_t*)((char*)G0 + (br == 1 ? d1 : 0ll) + (br == 2 ? d2 : 0ll));
        const int row0 = u.pm * 256 + wr * 64 + fr, col0 = (u.pn & 3) * 256 + wc * 32 + 8 * fq;
        EPI_RS_DECL(row0)
        float rsv[2][4];
        { float r2[2]; rstd_batch<2>(pre, r2); rsv[0][0] = r2[0]; rsv[0][1] = r2[1]; }
#pragma unroll
        for (int ai = 0; ai < 2; ++ai)
#pragma unroll
            for (int m = 0; m < 4; ++m) {
                if (ai == 0 && m == 2) { float r6[6]; rstd_batch<6>(pre1, r6);
#pragma unroll
                    for (int q = 0; q < 6; ++q) rsv[(q + 2) >> 2][(q + 2) & 3] = r6[q]; }
                const int row = row0 + ai * 128 + m * 16; const float rs = rsv[ai][m];
#pragma unroll
                for (int bj = 0; bj < 2; ++bj) {
                    float o[8]; const f32x2 nrl = {-rs * 1.4426950408889634f, -rs * 1.4426950408889634f};
#pragma unroll
                    for (int n = 0; n < 2; ++n)
#pragma unroll
                        for (int j = 0; j < 4; j += 2) { const f32x2 a2 = {acc[ai][bj][m][n][j], acc[ai][bj][m][n][j + 1]}; const f32x2 t2 = a2 * nrl;
                            f32x2 d2 = {__builtin_amdgcn_exp2f(t2.x), __builtin_amdgcn_exp2f(t2.y)}; d2 = d2 + (f32x2){1.f, 1.f};
                            o[n * 4 + j] = __builtin_amdgcn_rcpf(d2.x); o[n * 4 + j + 1] = __builtin_amdgcn_rcpf(d2.y); }
                    u32x4 w; w.x = cvt_pk_bf16(o[0], o[1]); w.y = cvt_pk_bf16(o[2], o[3]); w.z = cvt_pk_bf16(o[4], o[5]); w.w = cvt_pk_bf16(o[6], o[7]);
                    *(u32x4*)(S + (size_t)row * DM + col0 + bj * 128) = w;
                }
            }
    }
};
constexpr size_t MiB = 1u << 20;
constexpr size_t WS_W = 0;
constexpr size_t WS_HHI = 52 * MiB, WS_HLO = 84 * MiB;
constexpr size_t WS_VF = 116 * MiB;
constexpr size_t WS_SSQ = 132 * MiB;
constexpr size_t WS_ROPE = 133 * MiB;
constexpr size_t WS_MISC = 135 * MiB;
constexpr size_t WS_T1 = 136 * MiB;
constexpr size_t WS_ACT = 138 * MiB;
constexpr size_t WS_A = 138 * MiB;
constexpr size_t WS_B = 154 * MiB;
constexpr size_t WS_C = 186 * MiB;
constexpr size_t WS_D = 242 * MiB;
constexpr size_t WS_END = 270 * MiB;
constexpr size_t DO_Q = 0, DO_K = 24 * MiB, DO_VT = 48 * MiB;
constexpr size_t DO_PCORR = 0, DO_HL = 16 * MiB, DO_GX = 32 * MiB;
constexpr size_t DO_S = 0, DO_M = 32 * MiB;
constexpr size_t OW_W1GU1 = 0, OW_W2_1 = OW_W1GU1 + (size_t)2 * FF * DM, OW_W1GU2 = OW_W2_1 + (size_t)DM * FF, OW_W2_2 = OW_W1GU2 + (size_t)2 * FF * DM,
                 OW_WIN = OW_W2_2 + (size_t)DM * FF, OW_WOUT = OW_WIN + (size_t)6400 * DM, OW_WO = OW_WOUT + (size_t)DM * 1536, OW_END = OW_WO + (size_t)DM * DM;
static_assert(OW_END * 2 <= 52 * MiB, "weights fit");
constexpr size_t OW_W2_2B = (258 * MiB - 0) / 2;
__device__ __forceinline__ size_t ow_w2_2(int L) { return (L & 1) ? OW_W2_2B : OW_W2_2; }
constexpr int TB = SEQ;

__device__ __forceinline__ void conv_load(f32x4 (&v)[8], const float* src, int ld_src, int sn0, int lane) {
    if (sn0 >= 0) { const int kr = lane >> 3, nc = (lane & 7) * 4;
#pragma unroll
        for (int i = 0; i < 8; ++i) v[i] = *(const f32x4*)(src + (size_t)(8 * i + kr) * ld_src + sn0 + nc); }
    else {
#pragma unroll
        for (int i = 0; i < 8; ++i) v[i] = (f32x4){0.f, 0.f, 0.f, 0.f}; }
}
__device__ __forceinline__ void conv_finish(const f32x4 (&v)[8], const float* scale, bf16_t* dst, int ldd, LAS float* scr, int lane) {
    const int kr = lane >> 3, nc = (lane & 7) * 4;
#pragma unroll
    for (int i = 0; i < 8; ++i) { const int kk = 8 * i + kr; const float sc = scale ? scale[kk] : 1.f;
        scr[kk * 33 + nc] = v[i][0] * sc; scr[kk * 33 + nc + 1] = v[i][1] * sc; scr[kk * 33 + nc + 2] = v[i][2] * sc; scr[kk * 33 + nc + 3] = v[i][3] * sc; }
    asm volatile("s_waitcnt lgkmcnt(0)" ::: "memory");
    const int c = lane & 7;
#pragma unroll
    for (int j = 0; j < 4; ++j) { const int n = (lane >> 3) + 8 * j; const LAS float* sp = scr + (8 * c) * 33 + n;
        u32x4 o; o.x = pk2h(sp[0 * 33], sp[1 * 33]); o.y = pk2h(sp[2 * 33], sp[3 * 33]); o.z = pk2h(sp[4 * 33], sp[5 * 33]); o.w = pk2h(sp[6 * 33], sp[7 * 33]);
        *(u32x4*)(dst + (size_t)n * ldd + 8 * c) = o; }
    asm volatile("s_waitcnt lgkmcnt(0)" ::: "memory");
}
__device__ __forceinline__ void conv_item(const float* src, int ld_src, int sn0, const float* scale, bf16_t* dst, int ldd, LAS float* scr, int lane) {
    f32x4 v[8]; conv_load(v, src, ld_src, sn0, lane); conv_finish(v, scale, dst, ldd, scr, lane);
}

struct Args { const void* in[39]; float* out; unsigned char* ws; int ph_lo, ph_hi; };
typedef __attribute__((address_space(4))) const Args CArgs;
struct LayerW {
    CArgs* ap; int L;
#define FI(i) ((const float*)ap->in[i])
#define ACC(name, expr) __device__ __forceinline__ const float* name() const { return expr; }
    ACC(n1, FI(2) + (size_t)L * DM) ACC(g1, FI(3) + (size_t)L * DM * FF) ACC(u1, FI(4) + (size_t)L * DM * FF) ACC(d1, FI(5) + (size_t)L * FF * DM)
    ACC(mixn, FI(6) + (size_t)L * DM) ACC(win, FI(7) + (size_t)L * DM * 6304)
    ACC(qan, FI(8) + L * 256) ACC(wuq, FI(9) + (size_t)L * 256 * 768) ACC(kvan, FI(10) + L * 128) ACC(wukv, FI(11) + (size_t)L * 128 * 1024)
    ACC(qn, FI(12) + L * 96) ACC(kn, FI(13) + L * 96) ACC(sgvn, FI(14) + L * 512) ACC(sgws, FI(15) + (size_t)L * 8 * 128 * 128) ACC(sgbs, FI(16) + L * 8 * 128)
    ACC(mu, FI(17) + L * RWC) ACC(w0, FI(18) + L * 512) ACC(w2, FI(19) + (size_t)L * 64 * 512) ACC(a0, FI(20) + L * 512) ACC(a2, FI(21) + (size_t)L * 64 * 512)
    ACC(g2, FI(22) + (size_t)L * 128 * 512) ACC(kk, FI(23) + L * 512) ACC(ka, FI(24) + L * 512) ACC(rk, FI(25) + L * 512) ACC(lng, FI(26) + L * 512) ACC(lnb, FI(27) + L * 512)
    ACC(v0, FI(28) + (L > 0 ? L - 1 : 0) * 512) ACC(v1, FI(29) + (size_t)(L > 0 ? L - 1 : 0) * 512 * 32) ACC(v2, FI(30) + (size_t)(L > 0 ? L - 1 : 0) * 32 * 512)
    ACC(womla, FI(31) + (size_t)L * 512 * DM) ACC(wosg, FI(32) + (size_t)L * 512 * DM) ACC(worw, FI(33) + (size_t)L * 512 * DM) ACC(wo, FI(34) + (size_t)L * DM * DM)
    ACC(n2, FI(35) + (size_t)L * DM) ACC(g2f, FI(36) + (size_t)L * DM * FF) ACC(u2, FI(37) + (size_t)L * DM * FF) ACC(d2, FI(38) + (size_t)L * FF * DM)
#undef ACC
#undef FI
};

struct CvItem { const float* src; const float* scale; bf16_t* dst; int ld_src, sn0, ldd; };
__device__ __forceinline__ bool conv_decode(const LayerW& w, bf16_t* W, int it, CvItem& c) {
    constexpr int I_GU = 16 * 176, I_D = 44 * 32, I_IN = 16 * 200, I_OUT = 24 * 32, I_O = 16 * 32;
    int r = it;
    if (r < 2 * I_GU) {
        const int f = r / I_GU; r -= f * I_GU; const int kb = r / 176, nb = r % 176, dn0 = 32 * nb, pn = dn0 >> 8, bj = (dn0 >> 7) & 1, cc = dn0 & 127;
        const float* g = f == 0 ? w.g1() : w.g2f(); const float* u = f == 0 ? w.u1() : w.u2();
        c.src = (bj ? u : g) + (size_t)(64 * kb) * FF; c.ld_src = FF; c.sn0 = 128 * pn + cc; c.scale = (f == 0 ? w.n1() : w.n2()) + 64 * kb;
        c.dst = W + (f == 0 ? OW_W1GU1 : OW_W1GU2) + (size_t)dn0 * DM + 64 * kb; c.ldd = DM; return true; }
    r -= 2 * I_GU;
    if (r < 2 * I_D) {
        const int f = r / I_D; r -= f * I_D; const int kb = r / 32, nb = r % 32;
        c.src = (f == 0 ? w.d1() : w.d2()) + (size_t)(64 * kb) * DM; c.ld_src = DM; c.sn0 = 32 * nb; c.scale = nullptr;
        c.dst = W + (f == 0 ? OW_W2_1 : ow_w2_2(w.L)) + (size_t)(32 * nb) * FF + 64 * kb; c.ldd = FF; return true; }
    r -= 2 * I_D;
    if (r < I_IN) {
        const int kb = r / 200, nb = r % 200, dn0 = 32 * nb;
        if (w.L > 0 && (dn0 == 416 || dn0 == 448)) return false;
        c.src = w.win() + (size_t)(64 * kb) * 6304; c.ld_src = 6304; c.sn0 = dn0 < 416 ? dn0 : (dn0 < 512 ? -1 : dn0 - 96); c.scale = w.mixn() + 64 * kb;
        c.dst = W + OW_WIN + (size_t)dn0 * DM + 64 * kb; c.ldd = DM; return true; }
    r -= I_IN;
    if (r < I_OUT) {
        const int kb = r / 32, nb = r % 32, br = kb >> 3, kl = kb & 7;
        const float* a = w.womla(); const float* b = w.wosg(); const float* d = w.worw();
        c.src = (br == 0 ? a : br == 1 ? b : d) + (size_t)(64 * kl) * DM; c.ld_src = DM; c.sn0 = 32 * nb; c.scale = nullptr;
        c.dst = W + OW_WOUT + ((size_t)br * DM + 32 * nb) * 512 + 64 * kl; c.ldd = 512; return true; }
    r -= I_OUT;
    { const int kb = r / 32, nb = r % 32;
      c.src = w.wo() + (size_t)(64 * kb) * DM; c.ld_src = DM; c.sn0 = 32 * nb; c.scale = nullptr; c.dst = W + OW_WO + (size_t)(32 * nb) * DM + 64 * kb; c.ldd = DM; return true; }
}
__device__ __forceinline__ void conv_weights(const LayerW& w, bf16_t* W, LAS float* scr, int gw, int NGW, int lane) {
    constexpr int NIT = 2 * 16 * 176 + 2 * 44 * 32 + 16 * 200 + 24 * 32 + 16 * 32;
    CvItem cur, nxt; f32x4 va[8], vb[8];
    int it = gw; bool hc = false;
    for (; it < NIT && !hc; it += NGW) hc = conv_decode(w, W, it, cur);
    if (!hc) return;
    conv_load(va, cur.src, cur.ld_src, cur.sn0, lane);
    for (;;) {
        bool hn = false;
        for (; it < NIT && !hn; it += NGW) hn = conv_decode(w, W, it, nxt);
        if (hn) conv_load(vb, nxt.src, nxt.ld_src, nxt.sn0, lane);
        conv_finish(va, cur.scale, cur.dst, cur.ldd, scr, lane);
        if (!hn) break;
#pragma unroll
        for (int i = 0; i < 8; ++i) va[i] = vb[i];
        cur = nxt;
    }
}

struct CvTile { const float* src; const float* scale; bf16_t* dst; int ld_src, ldd; };
__device__ __forceinline__ bool conv_decode128(const LayerW& w, bf16_t* W, int it, CvTile& c) {
    constexpr int T_GU = 16 * 44, T_D = 44 * 8, T_IN = 16 * 49, T_OUT = 24 * 8, T_O = 16 * 8;
    int r = it;
    if (r < 2 * T_GU) { const int f = r / T_GU; r -= f * T_GU; const int kb = r / 44, nb = r % 44, dn0 = 128 * nb, pn = dn0 >> 8, bj = (dn0 >> 7) & 1;
        const float* g = f == 0 ? w.g1() : w.g2f(); const float* u = f == 0 ? w.u1() : w.u2();
        c.src = (bj ? u : g) + (size_t)(64 * kb) * FF + 128 * pn; c.ld_src = FF; c.scale = (f == 0 ? w.n1() : w.n2()) + 64 * kb;
        c.dst = W + (f == 0 ? OW_W1GU1 : OW_W1GU2) + (size_t)dn0 * DM + 64 * kb; c.ldd = DM; return true; }
    r -= 2 * T_GU;
    if (r < 2 * T_D) { const int f = r / T_D; r -= f * T_D; const int kb = r / 8, nb = r % 8;
        c.src = (f == 0 ? w.d1() : w.d2()) + (size_t)(64 * kb) * DM + 128 * nb; c.ld_src = DM; c.scale = nullptr;
        c.dst = W + (f == 0 ? OW_W2_1 : ow_w2_2(w.L)) + (size_t)(128 * nb) * FF + 64 * kb; c.ldd = FF; return true; }
    r -= 2 * T_D;
    if (r < T_IN) { const int kb = r / 49; int nb = r % 49; if (nb >= 3) ++nb; const int dn0 = 128 * nb;
        c.src = w.win() + (size_t)(64 * kb) * 6304 + (dn0 < 384 ? dn0 : dn0 - 96); c.ld_src = 6304; c.scale = w.mixn() + 64 * kb;
        c.dst = W + OW_WIN + (size_t)dn0 * DM + 64 * kb; c.ldd = DM; return true; }
    r -= T_IN;
    if (r < T_OUT) { const int kb = r / 8, nb = r % 8, br = kb >> 3, kl = kb & 7;
        const float* a = w.womla(); const float* b = w.wosg(); const float* d = w.worw();
        c.src = (br == 0 ? a : br == 1 ? b : d) + (size_t)(64 * kl) * DM + 128 * nb; c.ld_src = DM; c.scale = nullptr;
        c.dst = W + OW_WOUT + ((size_t)br * DM + 128 * nb) * 512 + 64 * kl; c.ldd = 512; return true; }
    r -= T_OUT;
    if (r < T_O) { const int kb = r / 8, nb = r % 8;
        c.src = w.wo() + (size_t)(64 * kb) * DM + 128 * nb; c.ld_src = DM; c.scale = nullptr; c.dst = W + OW_WO + (size_t)(128 * nb) * DM + 64 * kb; c.ldd = DM; return true; }
    return false;
}
__device__ __forceinline__ void conv_weights_wg(const LayerW& w, bf16_t* W, LAS float* tile, int bid, int G, int tid) {
    constexpr int NIT = 2 * 16 * 44 + 2 * 44 * 8 + 16 * 49 + 24 * 8 + 16 * 8;
    CvTile c0, c1, c2; f32x4 v0[4], v1[4], v2[4];
    int it = bid; if (it >= NIT) return;
#define CV_LOAD(V, C) do { _Pragma("unroll") for (int i = 0; i < 4; ++i) { const int q = tid + 512 * i; V[i] = *(const f32x4*)(C.src + (size_t)(q >> 5) * C.ld_src + 4 * (q & 31)); } } while (0)
#define CV_PROC(V, C) do { \
        asm volatile("s_waitcnt lgkmcnt(0)\n\ts_barrier" ::: "memory");                                \
        _Pragma("unroll") for (int i = 0; i < 4; ++i) { const int q = tid + 512 * i, k = q >> 5, n4 = 4 * (q & 31); const float sc = C.scale ? C.scale[k] : 1.f; \
            *(LAS f32x4*)(tile + k * 128 + (n4 ^ (8 * ((k >> 3) & 3)))) = V[i] * sc; } \
        asm volatile("s_waitcnt lgkmcnt(0)\n\ts_barrier" ::: "memory"); \
        _Pragma("unroll") for (int j = 0; j < 2; ++j) { const int p2 = tid + 512 * j, n = p2 >> 3, k8 = 8 * (p2 & 7); const LAS float* tp = tile + k8 * 128 + (n ^ (8 * ((k8 >> 3) & 3))); \
            u32x4 o; o.x = pk2h(tp[0], tp[128]); o.y = pk2h(tp[256], tp[384]); o.z = pk2h(tp[512], tp[640]); o.w = pk2h(tp[768], tp[896]); \
            *(u32x4*)(C.dst + (size_t)n * C.ldd + k8) = o; } } while (0)
    conv_decode128(w, W, it, c0); CV_LOAD(v0, c0);
    if (it + G < NIT) { conv_decode128(w, W, it + G, c1); CV_LOAD(v1, c1); }
    for (;;) {
        if (it + 2 * G < NIT) { conv_decode128(w, W, it + 2 * G, c2); CV_LOAD(v2, c2); }
        CV_PROC(v0, c0); it += G; if (it >= NIT) break;
        if (it + 2 * G < NIT) { conv_decode128(w, W, it + 2 * G, c0); CV_LOAD(v0, c0); }
        CV_PROC(v1, c1); it += G; if (it >= NIT) break;
        if (it + 2 * G < NIT) { conv_decode128(w, W, it + 2 * G, c1); CV_LOAD(v1, c1); }
        CV_PROC(v2, c2); it += G; if (it >= NIT) break;
    }
#undef CV_LOAD
#undef CV_PROC
}
__device__ __forceinline__ void conv_win_block3(const LayerW& w, bf16_t* W, LAS float* scr, int gw, int NGW, int lane) {
    for (int it = gw; it < 64; it += NGW) { const int kb = it >> 2, nb = 12 + (it & 3); CvItem c;
        if (conv_decode(w, W, 2 * 16 * 176 + 2 * 44 * 32 + kb * 200 + nb, c)) conv_item(c.src, c.ld_src, c.sn0, c.scale, c.dst, c.ldd, scr, lane); }
}

__device__ __forceinline__ void init_rows(const float* x, bf16_t* hi, bf16_t* lo, float* ssq, int gw, int NGW, int lane) {
    for (int r0 = gw; r0 < T; r0 += 4 * NGW) {
        f32x4 v[4][4];
#pragma unroll
        for (int q = 0; q < 4; ++q) { const int r = r0 + q * NGW; const f32x4* xr = (const f32x4*)(x + (size_t)(r < T ? r : r0) * DM) + lane;
#pragma unroll
            for (int j = 0; j < 4; ++j) v[q][j] = xr[64 * j]; }
#pragma unroll
        for (int q = 0; q < 4; ++q) { const int r = r0 + q * NGW; if (r < T) { float s = 0.f;
#pragma unroll
            for (int j = 0; j < 4; ++j) { const f32x4 a = v[q][j]; s += (a[0] * a[0] + a[1] * a[1]) + (a[2] * a[2] + a[3] * a[3]);
                u32x2 h; h.x = pk2(a[0], a[1]); h.y = pk2(a[2], a[3]);
                u32x2 l; l.x = pk2(a[0] - bflo(h.x), a[1] - bfhi(h.x)); l.y = pk2(a[2] - bflo(h.y), a[3] - bfhi(h.y));
                const size_t off = (size_t)r * DM + 4 * (lane + 64 * j);
                *(u32x2*)(hi + off) = h; *(u32x2*)(lo + off) = l; }
            s = wave_sum_dpp(s);
            if (lane < 16) ssq[(size_t)r * 16 + lane] = lane == 0 ? s : 0.f; } }
    }
}
__device__ __forceinline__ void init_rope(const int* pos, float* cosT, float* sinT, int gtid, int NT) {
    for (int i = gtid; i < T * 16; i += NT) { const int t = i >> 4, f = i & 15;
        const float inv = powf(10000.f, -(float)f * (1.f / 16.f)); const float ang = (float)pos[t] * inv;
        cosT[i] = cosf(ang); sinT[i] = sinf(ang); }
}

constexpr float ATT_SC = 0.10206207261596577f * 1.4426950408889634f;

__device__ __forceinline__ void mla_unit(const LayerW& w, const float* P, const float* cosT, const float* sinT, bf16_t* Q, bf16_t* K, bf16_t* Vt, int tb, int rb, LAS float* sm) {
    const int tid = tid_opaque(), lane = tid & 63, wv = tid >> 6;
    LAS float* a = sm; LAS float* kpe = sm + 3072; LAS float* out = sm + 3328;
    __syncthreads();
    { const float* row = P + (size_t)(tb + wv) * NPC;
      const f32x4 v = *(const f32x4*)(row + lane * 4); float ss = wave_sum((v[0] * v[0] + v[1] * v[1]) + (v[2] * v[2] + v[3] * v[3]));
      float rs = __builtin_amdgcn_rsqf(ss * (1.f / 256.f) + EPS);
#pragma unroll
      for (int i = 0; i < 4; ++i) a[wv * 384 + lane * 4 + i] = v[i] * rs * w.qan()[lane * 4 + i];
      const f32x2 v2 = *(const f32x2*)(row + 256 + lane * 2); ss = wave_sum(v2[0] * v2[0] + v2[1] * v2[1]);
      rs = __builtin_amdgcn_rsqf(ss * (1.f / 128.f) + EPS);
      a[wv * 384 + 256 + lane * 2] = v2[0] * rs * w.kvan()[lane * 2]; a[wv * 384 + 256 + lane * 2 + 1] = v2[1] * rs * w.kvan()[lane * 2 + 1];
      if (lane < 32) kpe[wv * 32 + lane] = row[384 + lane]; }
    __syncthreads();
    for (int n = tid; n < 1792; n += 512) {
        float acc[8];
#pragma unroll
        for (int j = 0; j < 8; ++j) acc[j] = 0.f;
        if (n < 768) { for (int k = 0; k < 256; ++k) { const float ww = w.wuq()[(size_t)k * 768 + n];
#pragma unroll
                for (int j = 0; j < 8; ++j) acc[j] += a[j * 384 + k] * ww; } }
        else { for (int k = 0; k < 128; ++k) { const float ww = w.wukv()[(size_t)k * 1024 + (n - 768)];
#pragma unroll
                for (int j = 0; j < 8; ++j) acc[j] += a[j * 384 + 256 + k] * ww; } }
#pragma unroll
        for (int j = 0; j < 8; ++j) out[j * 1792 + n] = acc[j];
    }
    __syncthreads();
    if (tid < 64) {
        const int j = tid >> 3, h = tid & 7, t = tb + j; const size_t gr = (size_t)(rb + t);
        const LAS float* q = out + j * 1792 + h * 96; float ss = 0.f;
        for (int d = 0; d < 96; ++d) ss += q[d] * q[d];
        float rs = __builtin_amdgcn_rsqf(ss * (1.f / 96.f) + EPS);
        bf16_t* qo = Q + (size_t)t * 768 + h * 96;
        for (int d = 0; d < 64; ++d) qo[d] = (bf16_t)f2bf(q[d] * rs * w.qn()[d] * ATT_SC);
        for (int i = 0; i < 16; ++i) { const float x1 = q[64 + i] * rs * w.qn()[64 + i], x2 = q[80 + i] * rs * w.qn()[80 + i], c = cosT[gr * 16 + i], s = sinT[gr * 16 + i];
            qo[64 + i] = (bf16_t)f2bf((x1 * c - x2 * s) * ATT_SC); qo[80 + i] = (bf16_t)f2bf((x2 * c + x1 * s) * ATT_SC); }
        const LAS float* kn = out + j * 1792 + 768 + h * 128; const LAS float* kp = kpe + j * 32; ss = 0.f;
        for (int d = 0; d < 64; ++d) ss += kn[d] * kn[d];
        for (int i = 0; i < 32; ++i) ss += kp[i] * kp[i];
        rs = __builtin_amdgcn_rsqf(ss * (1.f / 96.f) + EPS);
        bf16_t* ko = K + (size_t)t * 768 + h * 96;
        for (int d = 0; d < 64; ++d) ko[d] = (bf16_t)f2bf(kn[d] * rs * w.kn()[d]);
        for (int i = 0; i < 16; ++i) { const float x1 = kp[i] * rs * w.kn()[64 + i], x2 = kp[16 + i] * rs * w.kn()[80 + i], c = cosT[gr * 16 + i], s = sinT[gr * 16 + i];
            ko[64 + i] = (bf16_t)f2bf(x1 * c - x2 * s); ko[80 + i] = (bf16_t)f2bf(x2 * c + x1 * s); }
        for (int d = 0; d < 64; ++d) Vt[(size_t)(h * 64 + d) * SEQ + t] = (bf16_t)f2bf(kn[64 + d]);
    }
}

__device__ __forceinline__ void attn_naive_unit(const float* Q, const float* K, const float* V, bf16_t* YA, int h, int qb, LAS float* sm) {
    const int tid = tid_opaque(); const int row = qb * 512 + tid; const int wmax = qb * 512 + (tid | 63);
    LAS float* Ks = sm; LAS float* Vs = sm + 6144;
    float q[96], o[64];
#pragma unroll
    for (int d = 0; d < 96; d += 4) { const f32x4 v = *(const f32x4*)(Q + (size_t)row * 768 + h * 96 + d); q[d] = v[0]; q[d + 1] = v[1]; q[d + 2] = v[2]; q[d + 3] = v[3]; }
#pragma unroll
    for (int d = 0; d < 64; ++d) o[d] = 0.f;
    float m = -INFINITY, l = 0.f;
    const int ntile = 8 * (qb + 1);
    for (int kt = 0; kt < ntile; ++kt) {
        __syncthreads();
        for (int i = tid; i < 6144; i += 512) { const int j = i / 96, d = i - j * 96; Ks[i] = K[(size_t)(kt * 64 + j) * 768 + h * 96 + d]; }
        for (int i = tid; i < 4096; i += 512) { const int j = i >> 6, d = i & 63; Vs[i] = V[(size_t)(kt * 64 + j) * 512 + h * 64 + d]; }
        __syncthreads();
        if (kt * 64 <= wmax) {
            for (int j = 0; j < 64; ++j) {
                const int key = kt * 64 + j; if (key > wmax) break;
                float s = 0.f;
#pragma unroll
                for (int d = 0; d < 96; d += 4) { const f32x4 kv = *(const LAS f32x4*)(Ks + j * 96 + d); s += q[d] * kv[0] + q[d + 1] * kv[1] + q[d + 2] * kv[2] + q[d + 3] * kv[3]; }
                if (key <= row) {
                    const float mn = fmaxf(m, s), c = exp2f(m - mn), p = exp2f(s - mn); l = l * c + p; m = mn;
#pragma unroll
                    for (int d = 0; d < 64; d += 4) { const f32x4 vv = *(const LAS f32x4*)(Vs + j * 64 + d);
                        o[d] = o[d] * c + p * vv[0]; o[d + 1] = o[d + 1] * c + p * vv[1]; o[d + 2] = o[d + 2] * c + p * vv[2]; o[d + 3] = o[d + 3] * c + p * vv[3]; }
                }
            }
        }
    }
    const float il = 1.f / l;
#pragma unroll
    for (int d = 0; d < 64; d += 8) { u32x4 wq; wq.x = pk2(o[d] * il, o[d + 1] * il); wq.y = pk2(o[d + 2] * il, o[d + 3] * il); wq.z = pk2(o[d + 4] * il, o[d + 5] * il); wq.w = pk2(o[d + 6] * il, o[d + 7] * il);
        *(u32x4*)(YA + (size_t)row * 512 + h * 64 + d) = wq; }
}

__device__ __forceinline__ void sg_rstd_rows(const float* P, float* SGR, int gw, int NGW, int lane) {
    for (int t = gw; t < TB; t += NGW) { const float* row = P + (size_t)t * NPC + 1024; float ss = 0.f;
#pragma unroll
        for (int j = 0; j < 8; ++j) { const float g = gelu_tanh(row[lane + 64 * j]); ss += g * g; }
        ss = wave_sum(ss); if (lane == 0) SGR[t] = __builtin_amdgcn_rsqf(ss * (1.f / 512.f) + EPS); }
}
__device__ __forceinline__ void sg_mix_unit(const LayerW& w, const float* P, const float* SGR, bf16_t* YB, int c, int g, LAS float* sm) {
    const int tid = tid_opaque(); LAS float* Wl = sm; LAS float* vn = sm + 16384;
    __syncthreads();
    for (int i = tid; i < 16384; i += 512) Wl[i] = w.sgws()[(size_t)g * 16384 + i];
    for (int i = tid; i < 8192; i += 512) { const int s = i >> 6, cc = i & 63; const int t = c * 128 + s;
        vn[i] = gelu_tanh(P[(size_t)t * NPC + 1024 + g * 64 + cc]) * SGR[t] * w.sgvn()[g * 64 + cc]; }
    __syncthreads();
    const int cc = tid & 63, tq = tid >> 6;
    for (int tt = 0; tt < 16; ++tt) { const int tl = tq + 8 * tt; float acc = 0.f;
        for (int s = 0; s <= tl; ++s) acc += Wl[tl * 128 + s] * vn[s * 64 + cc];
        const int t = c * 128 + tl; const float mixed = acc + w.sgbs()[g * 128 + tl]; const float uu = gelu_tanh(P[(size_t)t * NPC + 512 + g * 64 + cc]);
        YB[(size_t)t * 512 + g * 64 + cc] = (bf16_t)f2bf(uu * mixed); }
}

struct RwArr { float *R, *W, *KX, *VV, *A, *B, *GG, *BN; };
__device__ __forceinline__ void rw_prep_unit(const LayerW& w, int L, const float* P, float* VF, const RwArr& ar, int tb, int rb, LAS float* sm) {
    const int tid = tid_opaque();
    LAS float* xs = sm; LAS float* t1 = sm + 14336; LAS float* kkp = sm + 14592; LAS float* rkp = sm + 18688; LAS float* hs = sm + 22784;
    __syncthreads();
    for (int i = tid; i < 8 * RWC; i += 512) { const int j = i / RWC, c = i - j * RWC, t = tb + j;
        const float cur = P[(size_t)t * NPC + 1536 + c], prev = t > 0 ? P[(size_t)(t - 1) * NPC + 1536 + c] : 0.f;
        xs[i] = cur + (prev - cur) * w.mu()[c]; }
    __syncthreads();
    { const int j = tid >> 6, ii = tid & 63; xs[j * RWC + 1536 + ii] = tanhf(xs[j * RWC + 1536 + ii]);
      xs[j * RWC + 1664 + ii] = sigmoidf_(xs[j * RWC + 1664 + ii]); xs[j * RWC + 1728 + ii] = sigmoidf_(xs[j * RWC + 1728 + ii]); }
    if (L > 0 && tid < 256) { const int j = tid >> 5, r = tid & 31; float acc = 0.f;
        for (int c = 0; c < 512; ++c) acc += xs[j * RWC + 1024 + c] * w.v1()[c * 32 + r];
        t1[j * 32 + r] = acc; }
    __syncthreads();
    const int n = tid; float aw[8], aa[8], ag[8];
#pragma unroll
    for (int j = 0; j < 8; ++j) { aw[j] = 0.f; aa[j] = 0.f; ag[j] = 0.f; }
    for (int i = 0; i < 64; ++i) { const float x2 = w.w2()[i * 512 + n], y2 = w.a2()[i * 512 + n];
#pragma unroll
        for (int j = 0; j < 8; ++j) { aw[j] += xs[j * RWC + 1536 + i] * x2; aa[j] += xs[j * RWC + 1600 + i] * y2; } }
    for (int i = 0; i < 128; ++i) { const float z2 = w.g2()[i * 512 + n];
#pragma unroll
        for (int j = 0; j < 8; ++j) ag[j] += xs[j * RWC + 1664 + i] * z2; }
    float av[8], vv[8];
#pragma unroll
    for (int j = 0; j < 8; ++j) {
        const int t = tb + j; const size_t gr = (size_t)(rb + t), o = (size_t)t * 512 + n;
        const float wpre = w.w0()[n] + aw[j]; const float xn = -wpre; const float sp = fmaxf(xn, 0.f) + log1pf(__expf(-fabsf(xn)));
        const float wl = -sp - 0.5f; const float decay = __expf(-__expf(wl));
        const float a = sigmoidf_(w.a0()[n] + aa[j]);
        const float r = xs[j * RWC + n], k = xs[j * RWC + 512 + n]; float v = xs[j * RWC + 1024 + n];
        if (L == 0) VF[gr * 512 + n] = v;
        else { float acc = w.v0()[n];
#pragma unroll 8
            for (int q = 0; q < 32; ++q) acc += t1[j * 32 + q] * w.v2()[q * 512 + n];
            const float vf = VF[gr * 512 + n]; v = v + (vf - v) * sigmoidf_(acc); }
        const float kx = k * (1.f + (a - 1.f) * w.ka()[n]);
        kkp[j * 512 + n] = k * w.kk()[n]; rkp[j * 512 + n] = r * kx * w.rk()[n];
        ar.R[o] = r; ar.W[o] = decay; ar.KX[o] = kx; ar.VV[o] = v; ar.GG[o] = ag[j];
        av[j] = a; vv[j] = v;
    }
    __syncthreads();
    if (tid < 64) { const int j = tid >> 3, h = tid & 7; float s1 = 0.f, s2 = 0.f;
        for (int c = 0; c < 64; ++c) { const float x = kkp[j * 512 + h * 64 + c]; s1 += x * x; s2 += rkp[j * 512 + h * 64 + c]; }
        hs[(j * 8 + h) * 2] = s1; hs[(j * 8 + h) * 2 + 1] = s2; }
    __syncthreads();
#pragma unroll
    for (int j = 0; j < 8; ++j) { const int h = n >> 6; const size_t o = (size_t)(tb + j) * 512 + n;
        const float rinv = __builtin_amdgcn_rsqf(fmaxf(hs[(j * 8 + h) * 2], 1e-24f)); const float kk = kkp[j * 512 + n] * rinv;
        ar.A[o] = -kk; ar.B[o] = kk * av[j]; ar.BN[o] = hs[(j * 8 + h) * 2 + 1] * vv[j]; }
}

__device__ __forceinline__ void rw_scan_row(const RwArr& ar, float* YR, int h, int i, int lane) {
    float S = 0.f; const int cb = h * 64;
    for (int t0 = 0; t0 < TB; t0 += 8) {
        float a[8], b[8], wd[8], kx[8], r[8], v[8];
#pragma unroll
        for (int j = 0; j < 8; ++j) { const size_t o = (size_t)(t0 + j) * 512 + cb;
            a[j] = ar.A[o + lane]; b[j] = ar.B[o + lane]; wd[j] = ar.W[o + lane]; kx[j] = ar.KX[o + lane]; r[j] = ar.R[o + lane]; v[j] = ar.VV[o + i]; }
#pragma unroll
        for (int j = 0; j < 8; ++j) {
            const float sa = wave_sum(S * a[j]);
            S = S * wd[j] + sa * b[j] + v[j] * kx[j];
            const float y = wave_sum(S * r[j]);
            if (lane == 0) YR[(size_t)(t0 + j) * 512 + cb + i] = y;
        }
    }
}
__device__ __forceinline__ void rw_out_unit(const LayerW& w, const float* YR, const RwArr& ar, bf16_t* YC, int tb, LAS float* sm) {
    const int tid = tid_opaque(), n = tid;
    __syncthreads();
    for (int j = 0; j < 8; ++j) sm[j * 512 + n] = YR[(size_t)(tb + j) * 512 + n];
    __syncthreads();
    const int hb = n & ~63;
    for (int j = 0; j < 8; ++j) { float mean = 0.f;
        for (int c = 0; c < 64; ++c) mean += sm[j * 512 + hb + c];
        mean *= (1.f / 64.f); float var = 0.f;
        for (int c = 0; c < 64; ++c) { const float d = sm[j * 512 + hb + c] - mean; var += d * d; }
        var *= (1.f / 64.f);
        const size_t o = (size_t)(tb + j) * 512 + n;
        const float y = (sm[j * 512 + n] - mean) * __builtin_amdgcn_rsqf(var + 64e-5f) * w.lng()[n] + w.lnb()[n];
        YC[o] = (bf16_t)f2bf((y + ar.BN[o]) * ar.GG[o]); }
}

__device__ __forceinline__ void mla_unit_ab(const LayerW& w, const bf16_t* PM, const float* cosT, const float* sinT, bf16_t* Q, bf16_t* K, bf16_t* Vt, int t0, LAS float* sm) {
    const int tid = tid_opaque(), lane = tid & 63, wv = tid >> 6;
    LAS float* a = sm; LAS float* kpe = sm + 3072; LAS float* out = sm + 3328;
    __syncthreads();
    { const bf16_t* row = PM + (size_t)(t0 + wv) * 512;
      const u32x2 q4 = *(const u32x2*)(row + lane * 4); const float v0 = bflo(q4.x), v1 = bfhi(q4.x), v2 = bflo(q4.y), v3 = bfhi(q4.y);
      float ss = wave_sum((v0 * v0 + v1 * v1) + (v2 * v2 + v3 * v3)); float rs = __builtin_amdgcn_rsqf(ss * (1.f / 256.f) + EPS);
      a[wv * 384 + lane * 4] = v0 * rs * w.qan()[lane * 4]; a[wv * 384 + lane * 4 + 1] = v1 * rs * w.qan()[lane * 4 + 1]; a[wv * 384 + lane * 4 + 2] = v2 * rs * w.qan()[lane * 4 + 2]; a[wv * 384 + lane * 4 + 3] = v3 * rs * w.qan()[lane * 4 + 3];
      const unsigned k2 = *(const unsigned*)(row + 256 + lane * 2); const float c0 = bflo(k2), c1 = bfhi(k2);
      ss = wave_sum(c0 * c0 + c1 * c1); rs = __builtin_amdgcn_rsqf(ss * (1.f / 128.f) + EPS);
      a[wv * 384 + 256 + lane * 2] = c0 * rs * w.kvan()[lane * 2]; a[wv * 384 + 256 + lane * 2 + 1] = c1 * rs * w.kvan()[lane * 2 + 1];
      if (lane < 32) kpe[wv * 32 + lane] = bf2f(row[384 + lane]); }
    __syncthreads();
    for (int n = tid; n < 1792; n += 512) {
        float acc[8];
#pragma unroll
        for (int j = 0; j < 8; ++j) acc[j] = 0.f;
        if (n < 768) { for (int k = 0; k < 256; ++k) { const float ww = w.wuq()[(size_t)k * 768 + n];
#pragma unroll
                for (int j = 0; j < 8; ++j) acc[j] += a[j * 384 + k] * ww; } }
        else { for (int k = 0; k < 128; ++k) { const float ww = w.wukv()[(size_t)k * 1024 + (n - 768)];
#pragma unroll
                for (int j = 0; j < 8; ++j) acc[j] += a[j * 384 + 256 + k] * ww; } }
#pragma unroll
        for (int j = 0; j < 8; ++j) out[j * 1792 + n] = acc[j];
    }
    __syncthreads();
    if (tid < 64) {
        const int j = tid >> 3, h = tid & 7, t = t0 + j, b = t / SEQ, ts = t - b * SEQ;
        const LAS float* q = out + j * 1792 + h * 96; float ss = 0.f;
        for (int d = 0; d < 96; ++d) ss += q[d] * q[d];
        float rs = __builtin_amdgcn_rsqf(ss * (1.f / 96.f) + EPS);
        bf16_t* qo = Q + (size_t)t * 768 + h * 96;
        for (int d = 0; d < 64; ++d) qo[d] = (bf16_t)f2bf(q[d] * rs * w.qn()[d] * ATT_SC);
        for (int i = 0; i < 16; ++i) { const float x1 = q[64 + i] * rs * w.qn()[64 + i], x2 = q[80 + i] * rs * w.qn()[80 + i], c = cosT[(size_t)t * 16 + i], sn = sinT[(size_t)t * 16 + i];
            qo[64 + i] = (bf16_t)f2bf((x1 * c - x2 * sn) * ATT_SC); qo[80 + i] = (bf16_t)f2bf((x2 * c + x1 * sn) * ATT_SC); }
        const LAS float* kn = out + j * 1792 + 768 + h * 128; const LAS float* kp = kpe + j * 32; ss = 0.f;
        for (int d = 0; d < 64; ++d) ss += kn[d] * kn[d];
        for (int i = 0; i < 32; ++i) ss += kp[i] * kp[i];
        rs = __builtin_amdgcn_rsqf(ss * (1.f / 96.f) + EPS);
        bf16_t* ko = K + (size_t)t * 768 + h * 96;
        for (int d = 0; d < 64; ++d) ko[d] = (bf16_t)f2bf(kn[d] * rs * w.kn()[d]);
        for (int i = 0; i < 16; ++i) { const float x1 = kp[i] * rs * w.kn()[64 + i], x2 = kp[16 + i] * rs * w.kn()[80 + i], c = cosT[(size_t)t * 16 + i], sn = sinT[(size_t)t * 16 + i];
            ko[64 + i] = (bf16_t)f2bf(x1 * c - x2 * sn); ko[80 + i] = (bf16_t)f2bf(x2 * c + x1 * sn); }
        for (int d = 0; d < 64; ++d) Vt[((size_t)(b * 8 + h) * 64 + d) * SEQ + ts] = (bf16_t)f2bf(kn[64 + d]);
    }
}
__device__ __forceinline__ void sg_mix_ab(const LayerW& w, bf16_t* PS, const float* SGQ, int c, int g, LAS float* sm, bf16_t* dst = nullptr) {
    const int tid = tid_opaque(); LAS float* Wl = sm; LAS float* vn = sm + 16384;
    __syncthreads();
    for (int i = tid; i < 16384; i += 512) Wl[i] = w.sgws()[(size_t)g * 16384 + i];
    for (int i = tid; i < 8192; i += 512) { const int s = i >> 6, cc = i & 63; const int t = c * 128 + s;
        const f32x4 q0 = *(const f32x4*)(SGQ + (size_t)t * 8), q1 = *(const f32x4*)(SGQ + (size_t)t * 8 + 4);
        const float rs = __builtin_amdgcn_rsqf((((q0[0] + q0[1]) + (q0[2] + q0[3])) + ((q1[0] + q1[1]) + (q1[2] + q1[3]))) * (1.f / 512.f) + EPS);
        vn[i] = bf2f(PS[(size_t)t * 1024 + 512 + g * 64 + cc]) * rs * w.sgvn()[g * 64 + cc]; }
    __syncthreads();
    const int cc = tid & 63, tq = tid >> 6;
    for (int tt = 0; tt < 16; ++tt) { const int tl = tq + 8 * tt; float acc = 0.f;
        for (int s = 0; s <= tl; ++s) acc += Wl[tl * 128 + s] * vn[s * 64 + cc];
        const int t = c * 128 + tl; const float mixed = acc + w.sgbs()[g * 128 + tl]; bf16_t* up = PS + (size_t)t * 1024 + g * 64 + cc;
        const bf16_t o = (bf16_t)f2bf(bf2f(*up) * mixed); if (dst) dst[(size_t)t * 512 + g * 64 + cc] = o; else *up = o; }
}
typedef short bf16x8 __attribute__((ext_vector_type(8)));
typedef short s16x4 __attribute__((ext_vector_type(4)));
typedef float f32x16 __attribute__((ext_vector_type(16)));
typedef float f32x2v __attribute__((ext_vector_type(2)));
constexpr int AT_KSLOT = 12288, AT_VSLOT = 8192, AT_LK = 0, AT_LV = 4 * AT_KSLOT, AT_LDS = AT_LV + 3 * AT_VSLOT;
constexpr float AT_THR = 8.f;
__device__ __forceinline__ int crow(int r, int hi) { return (r & 3) + 8 * (r >> 2) + 4 * hi; }
#define AT_SBAR() __builtin_amdgcn_sched_barrier(0)
#define AT_PIN(x) asm volatile("" : "+v"(x))
#define AT_MFMA(a, b, c) __builtin_amdgcn_mfma_f32_32x32x16_bf16((a), (b), (c), 0, 0, 0)
#define AT_WB(N) asm volatile("s_waitcnt vmcnt(" #N ") lgkmcnt(0)\n\ts_barrier" ::: "memory")
__device__ __forceinline__ void at_glds16(const void* g, unsigned lds_base) {
    unsigned sv; asm volatile("s_mov_b32 %0, m0\n\ts_mov_b32 m0, %2\n\ts_nop 0\n\tglobal_load_lds_dwordx4 %1, off\n\ts_mov_b32 m0, %0" : "=&s"(sv) : "v"(g), "s"(lds_base) : "memory"); }
__device__ __forceinline__ void at_kload2(bf16x8* kf, const LAS unsigned char* kp, int d0) { kf[2 * d0] = *(const LAS bf16x8*)(kp + d0 * 2048); kf[2 * d0 + 1] = *(const LAS bf16x8*)(kp + d0 * 2048 + 512); }
__device__ __forceinline__ void at_scale(f32x16& c, float a) {
    const f32x2v aa = {a, a};
#pragma unroll
    for (int i = 0; i < 8; ++i) { f32x2v t = {c[2 * i], c[2 * i + 1]}; t = t * aa; c[2 * i] = t.x; c[2 * i + 1] = t.y; }
}
#define AT_MX3(a, b, c) __builtin_fmaxf(__builtin_fmaxf((a), (b)), (c))
__device__ __forceinline__ float at_rowmax(const f32x16& p0, const f32x16& p1) {
    float a = AT_MX3(p0[0], p0[1], p1[0]), b = AT_MX3(p0[2], p0[3], p1[1]); a = AT_MX3(a, p1[2], p1[3]);
#pragma unroll
    for (int r = 4; r < 16; r += 4) { a = AT_MX3(a, p0[r], p0[r + 1]); b = AT_MX3(b, p0[r + 2], p0[r + 3]); a = AT_MX3(a, p1[r], p1[r + 1]); b = AT_MX3(b, p1[r + 2], p1[r + 3]); }
    const float m = __builtin_fmaxf(a, b); const u32x2 rr = __builtin_amdgcn_permlane32_swap(__float_as_uint(m), __float_as_uint(m), false, false);
    return __builtin_fmaxf(__uint_as_float(rr.x), __uint_as_float(rr.y)); }
__device__ __forceinline__ void at_cmask(f32x16& p0, f32x16& p1, int jb, int qrel, int hi) {
    const int kb = 64 * jb + 4 * hi;
#pragma unroll
    for (int r = 0; r < 16; ++r) { const int kv = kb + (r & 3) + 8 * (r >> 2); if (kv > qrel) p0[r] = -INFINITY; if (kv + 32 > qrel) p1[r] = -INFINITY; } }

__device__ __forceinline__ void attn_unit(const bf16_t* Qb, const bf16_t* Kb, const bf16_t* Vt, bf16_t* YA, int ya_pitch, int tok0, int bh, int h, int qb, LAS unsigned char* sm) {
    const int tid = tid_opaque(), lane = tid & 63, wid = __builtin_amdgcn_readfirstlane(tid >> 6), r32 = lane & 31, hi = lane >> 5;
    const bool wlow = wid < 4;
    const int q0 = qb * 256, NT = 4 * (qb + 1), qrel = wid * 32 + r32, qrow = q0 + qrel;
    const unsigned lds0 = (unsigned)(uintptr_t)sm;
    const bf16_t* ksrc = Kb + (size_t)(tok0 + lane) * 768 + h * 96 + wid * 8;
    const bf16_t* vsrc = Vt + ((size_t)bh * 64 + lane) * SEQ + wid * 8;
    const unsigned kdst = lds0 + AT_LK + wid * 1024, vdst = lds0 + AT_LV + wid * 1024;
#define AT_DMA_K(t, sl) do { at_glds16(ksrc + (size_t)(t) * 64 * 768, (unsigned)__builtin_amdgcn_readfirstlane(kdst + (sl) * AT_KSLOT)); \
        if (wlow) at_glds16(ksrc + (size_t)(t) * 64 * 768 + 64, (unsigned)__builtin_amdgcn_readfirstlane(kdst + 8192 + (sl) * AT_KSLOT)); } while (0)
#define AT_DMA_V(t, sl) at_glds16(vsrc + (t) * 64, (unsigned)__builtin_amdgcn_readfirstlane(vdst + (sl) * AT_VSLOT))
#define AT_WAITB(NLO, NHI) do { if (wlow) { AT_WB(NLO); } else { AT_WB(NHI); } } while (0)
    const LAS unsigned char* vp0 = sm + AT_LV + hi * 1024 + r32 * 16;
    const LAS unsigned char* kp0 = sm + AT_LK + hi * 1024 + r32 * 16;
    AT_DMA_K(0, 0); AT_DMA_V(0, 0); AT_DMA_K(1, 1);
    bf16x8 qr[6];
    { const bf16_t* qp = Qb + (size_t)(tok0 + qrow) * 768 + h * 96 + hi * 8;
#pragma unroll
      for (int d0 = 0; d0 < 6; ++d0) qr[d0] = *(const bf16x8*)(qp + d0 * 16); }
    float mhat = 0.f, l_reg = 0.f, fsc = 1.f; f32x16 o0 = {}, o1 = {}; const f32x16 zero16 = {};
    bool resc = false;
    f32x16 pA0, pA1, pB0, pB1; bf16x8 kf[12], vf[8]; u32x4 pw0, pw1, pw2, pw3;
    int sl_prev = 0, sl_cur = 0, sl_next = 1;
#define AT_ROT() do { sl_prev = sl_cur; sl_cur = sl_next; sl_next = (sl_next == 2) ? 0 : sl_next + 1; } while (0)
#define AT_RESC() do { if (resc) { at_scale(o0, fsc); at_scale(o1, fsc); } } while (0)
    AT_DMA_K(2, 2); AT_DMA_K(3, 3);
    AT_WAITB(7, 4);
#pragma unroll
    for (int d0 = 0; d0 < 6; ++d0) at_kload2(kf, kp0, d0);
    pA0 = AT_MFMA(kf[0], qr[0], zero16); pA1 = AT_MFMA(kf[1], qr[0], zero16);
#pragma unroll
    for (int d0 = 1; d0 < 6; ++d0) { pA0 = AT_MFMA(kf[2 * d0], qr[d0], pA0); pA1 = AT_MFMA(kf[2 * d0 + 1], qr[d0], pA1); }
    if (NT == 4) at_cmask(pA0, pA1, 0, qrel, hi);
    { mhat = at_rowmax(pA0, pA1);
#pragma unroll
      for (int r = 0; r < 16; ++r) { pA0[r] = __builtin_amdgcn_exp2f(pA0[r] - mhat); pA1[r] = __builtin_amdgcn_exp2f(pA1[r] - mhat); } }
    AT_WB(0);
    AT_DMA_V(1, 1); AT_ROT();
#pragma unroll
    for (int d0 = 0; d0 < 4; ++d0) at_kload2(kf, kp0 + AT_KSLOT, d0);
    AT_WB(1);
#define AT_PKW(P, i) pg8::cvt_pk_bf16(P[i], P[i + 1])
#define AT_PB(k) __builtin_bit_cast(bf16x8, pw##k)
#define AT_VRD(i) do { vf[i] = *(const LAS bf16x8*)(vp_ + ((i) & 3) * 2048 + ((i) >> 2) * 512); } while (0)
#define AT_KRD(G, d0) do { if (G) { at_kload2(kf, kn_, d0); AT_SBAR(); } } while (0)
#define AT_GAPA(MF, P, i, PW, j) do { MF; sacc = sacc + (f32x2v){P[i], P[i + 1]}; sacc = sacc + (f32x2v){P[i + 2], P[i + 3]}; PW[j] = AT_PKW(P, i); PW[j + 1] = AT_PKW(P, i + 2); AT_PIN(PW); AT_PIN(sacc); AT_SBAR(); } while (0)
#define AT_GAPM(MF) do { MF; AT_SBAR(); } while (0)
#define AT_GAPB(MF, X, i) do { MF; { f32x2v t0_ = (f32x2v){X[i], X[i + 1]} + nmh2, t1_ = (f32x2v){X[i + 2], X[i + 3]} + nmh2; \
        X[i] = __builtin_amdgcn_exp2f(t0_.x); X[i + 1] = __builtin_amdgcn_exp2f(t0_.y); X[i + 2] = __builtin_amdgcn_exp2f(t1_.x); X[i + 3] = __builtin_amdgcn_exp2f(t1_.y); } AT_PIN(X); AT_SBAR(); } while (0)
#define AT_STEP(C0, C1, P0, P1, t, MASK, GK, GV, GL) do { AT_SBAR(); \
    const LAS unsigned char* vp_ = vp0 + sl_prev * AT_VSLOT; f32x2v sacc = {0.f, 0.f}; \
    const LAS unsigned char* kc_ = kp0 + ((t) & 3) * AT_KSLOT; const LAS unsigned char* kn_ = kp0 + (((t) + 1) & 3) * AT_KSLOT; \
    AT_VRD(0); at_kload2(kf, kc_, 4); AT_SBAR(); AT_GAPA(C0 = AT_MFMA(kf[0], qr[0], zero16), P0, 0,  pw0, 0); \
    AT_VRD(4); AT_SBAR(); AT_GAPA(C1 = AT_MFMA(kf[1], qr[0], zero16), P0, 4,  pw0, 2); \
    AT_VRD(1); at_kload2(kf, kc_, 5); AT_SBAR(); AT_GAPA(C0 = AT_MFMA(kf[2], qr[1], C0),     P0, 8,  pw1, 0); \
    AT_VRD(5); AT_SBAR(); AT_GAPA(C1 = AT_MFMA(kf[3], qr[1], C1),     P0, 12, pw1, 2); \
    AT_VRD(2); AT_SBAR(); AT_GAPA(C0 = AT_MFMA(kf[4], qr[2], C0),     P1, 0,  pw2, 0); \
    AT_VRD(6); AT_SBAR(); AT_GAPA(C1 = AT_MFMA(kf[5], qr[2], C1),     P1, 4,  pw2, 2); \
    AT_VRD(3); AT_SBAR(); AT_GAPA(C0 = AT_MFMA(kf[6], qr[3], C0),     P1, 8,  pw3, 0); \
    AT_VRD(7); AT_SBAR(); AT_GAPA(C1 = AT_MFMA(kf[7], qr[3], C1),     P1, 12, pw3, 2); \
    AT_GAPM(C0 = AT_MFMA(kf[8], qr[4], C0)); AT_GAPM(C1 = AT_MFMA(kf[9], qr[4], C1)); AT_GAPM(C0 = AT_MFMA(kf[10], qr[5], C0)); AT_GAPM(C1 = AT_MFMA(kf[11], qr[5], C1)); \
    l_reg += sacc.x + sacc.y; \
    if (GK) AT_DMA_K((t) + 3, ((t) + 3) & 3); if (GV) AT_DMA_V((t) + 1, sl_next);                             \
    if (MASK) at_cmask(C0, C1, (t) - (NT - 4), qrel, hi); \
    { const float rm = at_rowmax(C0, C1) - mhat; resc = false;                                                \
      if (__builtin_expect(__any(rm > AT_THR), 0)) { const float dl = __builtin_fmaxf(rm, 0.f); mhat += dl;     \
          fsc = __builtin_amdgcn_exp2f(-dl); l_reg *= fsc; resc = true; } } \
    const f32x2v nmh2 = {-mhat, -mhat}; AT_SBAR(); \
    AT_GAPB(o0 = AT_MFMA(vf[0], AT_PB(0), o0), C0, 0);                   AT_GAPB(o1 = AT_MFMA(vf[4], AT_PB(0), o1), C0, 4); \
    AT_KRD(GL, 0); AT_GAPB(o0 = AT_MFMA(vf[1], AT_PB(1), o0), C0, 8);    AT_KRD(GL, 1); AT_GAPB(o1 = AT_MFMA(vf[5], AT_PB(1), o1), C0, 12); \
    AT_KRD(GL, 2); AT_GAPB(o0 = AT_MFMA(vf[2], AT_PB(2), o0), C1, 0);    AT_KRD(GL, 3); AT_GAPB(o1 = AT_MFMA(vf[6], AT_PB(2), o1), C1, 4); \
    AT_GAPB(o0 = AT_MFMA(vf[3], AT_PB(3), o0), C1, 8);                   AT_GAPB(o1 = AT_MFMA(vf[7], AT_PB(3), o1), C1, 12); \
    } while (0)
    int t = 1;
    for (; t + 5 < NT; t += 2) {
        AT_STEP(pB0, pB1, pA0, pA1, t, false, true, true, true);     AT_WAITB(3, 2); AT_RESC(); AT_ROT();
        AT_STEP(pA0, pA1, pB0, pB1, t + 1, false, true, true, true); AT_WAITB(3, 2); AT_RESC(); AT_ROT();
    }
#define AT_ENDW(tt) do { if ((tt) + 3 < NT) { AT_WAITB(3, 2); } else if ((tt) + 2 < NT) { AT_WB(1); } else { AT_WB(0); } } while (0)
    for (; t + 1 < NT; t += 2) {
        AT_STEP(pB0, pB1, pA0, pA1, t, true, (t + 3 < NT), (t + 1 < NT), (t + 1 < NT));         AT_ENDW(t);     AT_RESC(); AT_ROT();
        AT_STEP(pA0, pA1, pB0, pB1, t + 1, true, (t + 4 < NT), (t + 2 < NT), (t + 2 < NT));     AT_ENDW(t + 1); AT_RESC(); AT_ROT();
    }
    AT_STEP(pB0, pB1, pA0, pA1, NT - 1, true, false, false, false); AT_RESC();
    { f32x2v sacc = {0.f, 0.f};
#pragma unroll
      for (int r = 0; r < 16; r += 2) { sacc = sacc + (f32x2v){pB0[r], pB0[r + 1]}; sacc = sacc + (f32x2v){pB1[r], pB1[r + 1]}; }
      l_reg += sacc.x + sacc.y;
      pw0 = (u32x4){AT_PKW(pB0, 0), AT_PKW(pB0, 2), AT_PKW(pB0, 4), AT_PKW(pB0, 6)}; pw1 = (u32x4){AT_PKW(pB0, 8), AT_PKW(pB0, 10), AT_PKW(pB0, 12), AT_PKW(pB0, 14)};
      pw2 = (u32x4){AT_PKW(pB1, 0), AT_PKW(pB1, 2), AT_PKW(pB1, 4), AT_PKW(pB1, 6)}; pw3 = (u32x4){AT_PKW(pB1, 8), AT_PKW(pB1, 10), AT_PKW(pB1, 12), AT_PKW(pB1, 14)};
      const LAS unsigned char* vp_ = vp0 + sl_cur * AT_VSLOT;
#pragma unroll
      for (int i = 0; i < 8; ++i) AT_VRD(i);
      o0 = AT_MFMA(vf[0], AT_PB(0), o0); o1 = AT_MFMA(vf[4], AT_PB(0), o1); o0 = AT_MFMA(vf[1], AT_PB(1), o0); o1 = AT_MFMA(vf[5], AT_PB(1), o1);
      o0 = AT_MFMA(vf[2], AT_PB(2), o0); o1 = AT_MFMA(vf[6], AT_PB(2), o1); o0 = AT_MFMA(vf[3], AT_PB(3), o0); o1 = AT_MFMA(vf[7], AT_PB(3), o1); }
    { const u32x2 rr = __builtin_amdgcn_permlane32_swap(__float_as_uint(l_reg), __float_as_uint(l_reg), false, false); l_reg = __uint_as_float(rr.x) + __uint_as_float(rr.y); }
    const float il = 1.f / l_reg;
    bf16_t* op = YA + (size_t)(tok0 + qrow) * ya_pitch + h * 64 + 4 * hi;
#pragma unroll
    for (int g = 0; g < 4; ++g) {
        u32x2 w0; w0.x = pg8::cvt_pk_bf16(o0[4 * g] * il, o0[4 * g + 1] * il); w0.y = pg8::cvt_pk_bf16(o0[4 * g + 2] * il, o0[4 * g + 3] * il);
        u32x2 w1; w1.x = pg8::cvt_pk_bf16(o1[4 * g] * il, o1[4 * g + 1] * il); w1.y = pg8::cvt_pk_bf16(o1[4 * g + 2] * il, o1[4 * g + 3] * il);
        *(u32x2*)(op + 8 * g) = w0; *(u32x2*)(op + 32 + 8 * g) = w1;
    }
    asm volatile("s_waitcnt lgkmcnt(0)\n\ts_barrier" ::: "memory");
#undef AT_DMA_K
#undef AT_DMA_V
#undef AT_WAITB
#undef AT_ROT
#undef AT_RESC
#undef AT_PKW
#undef AT_PB
#undef AT_VRD
#undef AT_KRD
#undef AT_GAPA
#undef AT_GAPM
#undef AT_GAPB
#undef AT_STEP
#undef AT_ENDW
}
constexpr int RW_C = 64, RW_NC = SEQ / RW_C;
constexpr int RP = 72;
constexpr int RPG = 136;
constexpr int RF = 68;
constexpr int RFR = 132;
constexpr size_t OW_W2T = OW_END, OW_A2T = OW_W2T + 512 * 64, OW_G2T = OW_A2T + 512 * 64, OW_XEND_RW = OW_G2T + 512 * 128, OW_XEND = OW_XEND_RW + 512 * 32;
static_assert(OW_XEND * 2 <= 52 * MiB, "weights fit");

__device__ __forceinline__ void conv_small(const LayerW& w, bf16_t* W, int gtid, int NT) {
    for (int i = gtid; i < 512 * 64; i += NT) { const int n = i >> 6, k = i & 63; W[OW_W2T + i] = (bf16_t)f2bf(w.w2()[k * 512 + n]); W[OW_A2T + i] = (bf16_t)f2bf(w.a2()[k * 512 + n]); }
    for (int i = gtid; i < 512 * 128; i += NT) { const int n = i >> 7, k = i & 127; W[OW_G2T + i] = (bf16_t)f2bf(w.g2()[k * 512 + n]); }
    if (w.L > 0) for (int i = gtid; i < 512 * 32; i += NT) { const int n = i >> 5, q = i & 31; W[OW_XEND_RW + i] = (bf16_t)f2bf(w.v2()[q * 512 + n]); }
}

template <class PL> __device__ __forceinline__ void rw_t1_rows(const LayerW& w, const PL& pl, float* T1, int ntok, int gw, int NGW, int lane) {
    for (int tp = gw; tp < ntok / 2; tp += NGW) { const int t = 2 * tp + (lane >> 5), r = lane & 31; const int ts = t & (SEQ - 1); float acc = 0.f;
        for (int c = 0; c < 512; ++c) { const float cur = pl.ld(t, 1024 + c), prev = ts > 0 ? pl.ld(t - 1, 1024 + c) : 0.f; acc += (cur + (prev - cur) * w.mu()[1024 + c]) * w.v1()[c * 32 + r]; }
        T1[(size_t)t * 32 + r] = acc; }
}

struct PLbf16 { const bf16_t* P; __device__ __forceinline__ float ld(int t, int c) const { return bf2f(P[(size_t)t * RWC + c]); } };
struct PLf32 { const float* P; __device__ __forceinline__ float ld(int t, int c) const { return P[(size_t)t * NPC + 1536 + c]; } };

struct RwBufs { bf16_t* PCORR; bf16_t* HL; float* GC; bf16_t* GX; };

__device__ __forceinline__ f32x16 zero16() { f32x16 z;
#pragma unroll
    for (int r = 0; r < 16; ++r) z[r] = 0.f; return z; }
template <int KS, class PA, class PB> __device__ __forceinline__ f32x16 mm32(PA a, PB b, f32x16 acc) {
#pragma unroll
    for (int s = 0; s < KS; ++s) acc = __builtin_amdgcn_mfma_f32_32x32x16_bf16(*(const bf16x8*)((const bf16_t*)a + 16 * s), *(const bf16x8*)((const bf16_t*)b + 16 * s), acc, 0, 0, 0);
    return acc;
}
template <int KS> __device__ __forceinline__ f32x16 mm32_ll(const LAS bf16_t* a, const LAS bf16_t* b, f32x16 acc) {
    bf16x8 fa[KS], fb[KS];
#pragma unroll
    for (int s = 0; s < KS; ++s) { fa[s] = *(const LAS bf16x8*)(a + 16 * s); fb[s] = *(const LAS bf16x8*)(b + 16 * s); }
    __builtin_amdgcn_sched_barrier(0);
#pragma unroll
    for (int s = 0; s < KS; ++s) acc = __builtin_amdgcn_mfma_f32_32x32x16_bf16(fa[s], fb[s], acc, 0, 0, 0);
    return acc;
}
template <int KS> __device__ __forceinline__ f32x16 mm32_lg(const LAS bf16_t* a, const bf16_t* b, f32x16 acc) {
#pragma unroll
    for (int s = 0; s < KS; ++s) acc = __builtin_amdgcn_mfma_f32_32x32x16_bf16(*(const LAS bf16x8*)(a + 16 * s), *(const bf16x8*)(b + 16 * s), acc, 0, 0, 0);
    return acc;
}

template <int KS> __device__ __forceinline__ f32x16 mm32_rr(const bf16x8 (&a)[KS], const bf16x8 (&b)[KS], f32x16 acc) {
#pragma unroll
    for (int s = 0; s < KS; ++s) acc = __builtin_amdgcn_mfma_f32_32x32x16_bf16(a[s], b[s], acc, 0, 0, 0);
    return acc;
}
template <int KS> __device__ __forceinline__ f32x16 mm32_lr(const LAS bf16_t* a, const bf16x8 (&b)[KS], f32x16 acc) {
    bf16x8 fa[KS];
#pragma unroll
    for (int s = 0; s < KS; ++s) fa[s] = *(const LAS bf16x8*)(a + 16 * s);
    __builtin_amdgcn_sched_barrier(0);
#pragma unroll
    for (int s = 0; s < KS; ++s) acc = __builtin_amdgcn_mfma_f32_32x32x16_bf16(fa[s], b[s], acc, 0, 0, 0);
    return acc;
}
#define LDS_BAR() asm volatile("s_waitcnt lgkmcnt(0)\n\ts_barrier" ::: "memory")
constexpr size_t OW_V2B = OW_XEND_RW;
__device__ __forceinline__ float group8_sum(float v) {
    v += __builtin_bit_cast(float, __builtin_amdgcn_update_dpp(0, __builtin_bit_cast(int, v), 0xB1, 0xF, 0xF, false));
    v += __builtin_bit_cast(float, __builtin_amdgcn_update_dpp(0, __builtin_bit_cast(int, v), 0x4E, 0xF, 0xF, false));
    v += __builtin_bit_cast(float, __builtin_amdgcn_update_dpp(0, __builtin_bit_cast(int, v), 0x141, 0xF, 0xF, false));
    return v;
}
__device__ __forceinline__ void unpack8(const u32x4 x, float (&e)[8]) { e[0] = bflo(x.x); e[1] = bfhi(x.x); e[2] = bflo(x.y); e[3] = bfhi(x.y); e[4] = bflo(x.z); e[5] = bfhi(x.z); e[6] = bflo(x.w); e[7] = bfhi(x.w); }
__device__ __forceinline__ u32x4 pack8(const float (&e)[8]) { u32x4 o; o.x = pk2h(e[0], e[1]); o.y = pk2h(e[2], e[3]); o.z = pk2h(e[4], e[5]); o.w = pk2h(e[6], e[7]); return o; }
__device__ __forceinline__ void ldc8(const LAS float* p, float (&e)[8]) { const f32x4 a = *(const LAS f32x4*)p, b = *(const LAS f32x4*)(p + 4); e[0] = a[0]; e[1] = a[1]; e[2] = a[2]; e[3] = a[3]; e[4] = b[0]; e[5] = b[1]; e[6] = b[2]; e[7] = b[3]; }
constexpr int CT_MR = 0, CT_MK = 64, CT_MV = 128, CT_MW = 192, CT_MA = 256, CT_MG = 320, CT_W0 = 448, CT_A0 = 512, CT_KK = 576, CT_KA = 640, CT_RK = 704, CT_V0 = 768, CT_LG = 832, CT_LB = 896;
__device__ __forceinline__ void rw_load_rows(const bf16_t* PR, int tok0, int h, int c, u32x4 (&cq)[7], u32x4 (&pq)[7]) {
    const int tid = tid_opaque(), lane = tid & 63, wv = __builtin_amdgcn_readfirstlane(tid >> 6);
    const int tq = 8 * wv + (lane >> 3), kc = 8 * (lane & 7), chn = h * 64 + kc;
    const bf16_t* rowc = PR + ((size_t)tok0 + c * RW_C + tq) * RWC; const bool hasp = (c > 0) || (tq > 0);
#pragma unroll
    for (int i = 0; i < 7; ++i) { const int col = i < 3 ? i * 512 + chn : 1536 + (i - 3) * 64 + kc;
        cq[i] = *(const u32x4*)(rowc + col); pq[i] = hasp ? *(const u32x4*)(rowc - RWC + col) : (u32x4){0u, 0u, 0u, 0u}; }
}
template <int PASS>
__device__ __forceinline__ void rw_chunk_unit(const LayerW& w, int L, const bf16_t* PR, const bf16_t* Wb, bf16_t* VF, const float* T1, const RwBufs& rb_, bf16_t* YC, int yc_pitch,
                                              int tok0, int bh, int h, int c, LAS unsigned char* sm, int cnext, bool first, u32x4 (&cq)[7], u32x4 (&pq)[7]) {
    const int tid = tid_opaque(), lane = tid & 63, wv = __builtin_amdgcn_readfirstlane(tid >> 6), r32 = lane & 31, hi = lane >> 5;
    LAS bf16_t* A_w = (LAS bf16_t*)(sm); LAS bf16_t* A_a = (LAS bf16_t*)(sm + 9216); LAS bf16_t* A_g = (LAS bf16_t*)(sm + 18432);
    LAS float* LPw = (LAS float*)(sm + 35840); LAS float* LPa = (LAS float*)(sm + 53248); LAS float* LPg = (LAS float*)(sm + 70656);
    LAS float* LPv = (LAS float*)(sm + 88064);
    LAS float* Aab = (LAS float*)(sm); LAS bf16_t* Aak = (LAS bf16_t*)(sm + 17408); LAS bf16_t* Arb = (LAS bf16_t*)(sm + 68608); LAS bf16_t* Ark = (LAS bf16_t*)(sm + 77824);
    LAS bf16_t* Xt = (LAS bf16_t*)(sm + 26624);
    LAS bf16_t* Lb = (LAS bf16_t*)(sm + 45056);
    LAS bf16_t* Tinv = (LAS bf16_t*)(sm + 54272);
    LAS float* Ylf = (LAS float*)(sm); LAS bf16_t* R2T = (LAS bf16_t*)(sm + 17408);
    LAS bf16_t* At = (LAS bf16_t*)(sm + 88064); LAS bf16_t* Bt = (LAS bf16_t*)(sm + 97280); LAS bf16_t* Kt = (LAS bf16_t*)(sm + 106496);
    LAS bf16_t* Rt = (LAS bf16_t*)(sm + 59392);
    LAS bf16_t* BtT = (LAS bf16_t*)(sm + 115712); LAS bf16_t* KtT = (LAS bf16_t*)(sm + 124928);
    LAS bf16_t* t1b = (LAS bf16_t*)(sm + 124928);
    LAS bf16_t* VtT = (LAS bf16_t*)(sm + 134144);
    LAS float* gC = (LAS float*)(sm + 143360); LAS float* tot = (LAS float*)(sm + 143616);
    LAS float* CT = (LAS float*)(sm + 145664);
    const int tq = 8 * wv + (lane >> 3), kc = 8 * (lane & 7), chn = h * 64 + kc;
    const size_t tok = (size_t)tok0 + c * RW_C + tq;
    const size_t chh = (size_t)bh * RW_NC + c;
    bf16x8 wf[4], gf[8], v2f[2]; f32x4 t1q = {0.f, 0.f, 0.f, 0.f}; u32x4 vfq = {0u, 0u, 0u, 0u};
    { const int pj = wv >> 2, cb = wv & 1; const bf16_t* bp = Wb + (pj ? OW_A2T : OW_W2T) + (size_t)(h * 64 + 32 * cb + r32) * 64 + 8 * hi;
#pragma unroll
      for (int s = 0; s < 4; ++s) wf[s] = *(const bf16x8*)(bp + 16 * s);
      if (wv < 4) { const bf16_t* bg = Wb + OW_G2T + (size_t)(h * 64 + 32 * cb + r32) * 128 + 8 * hi;
#pragma unroll
          for (int s = 0; s < 8; ++s) gf[s] = *(const bf16x8*)(bg + 16 * s); }
      if (L > 0) { if (wv < 4) { const bf16_t* vp = Wb + OW_V2B + (size_t)(h * 64 + 32 * cb + r32) * 32 + 8 * hi; v2f[0] = *(const bf16x8*)vp; v2f[1] = *(const bf16x8*)(vp + 16); }
                   t1q = *(const f32x4*)(T1 + tok * 32 + 4 * (lane & 7)); vfq = *(const u32x4*)(VF + tok * 512 + chn); } }
    if (first) {
        if (tid < 64) { CT[CT_MR + tid] = w.mu()[h * 64 + tid]; CT[CT_MK + tid] = w.mu()[512 + h * 64 + tid]; CT[CT_MV + tid] = w.mu()[1024 + h * 64 + tid]; CT[CT_MW + tid] = w.mu()[1536 + tid]; CT[CT_MA + tid] = w.mu()[1600 + tid]; }
        else if (tid < 192) CT[CT_MG + tid - 64] = w.mu()[1664 + tid - 64];
        else if (tid < 256) { const int q = tid - 192, n_ = h * 64 + q; CT[CT_W0 + q] = w.w0()[n_]; CT[CT_A0 + q] = w.a0()[n_]; CT[CT_KK + q] = w.kk()[n_]; CT[CT_KA + q] = w.ka()[n_]; }
        else if (tid < 320) { const int q = tid - 256, n_ = h * 64 + q; CT[CT_RK + q] = w.rk()[n_]; CT[CT_V0 + q] = L > 0 ? w.v0()[n_] : 0.f; CT[CT_LG + q] = w.lng()[n_]; CT[CT_LB + q] = w.lnb()[n_]; }
    }
    LDS_BAR();
    float rr[8], kq[8], vv[8];
    { float cu[8], pv_[8], mu[8], o[8];
      unpack8(cq[0], cu); unpack8(pq[0], pv_); ldc8(CT + CT_MR + kc, mu);
#pragma unroll
      for (int i = 0; i < 8; ++i) rr[i] = cu[i] + (pv_[i] - cu[i]) * mu[i];
      unpack8(cq[1], cu); unpack8(pq[1], pv_); ldc8(CT + CT_MK + kc, mu);
#pragma unroll
      for (int i = 0; i < 8; ++i) kq[i] = cu[i] + (pv_[i] - cu[i]) * mu[i];
      unpack8(cq[2], cu); unpack8(pq[2], pv_); ldc8(CT + CT_MV + kc, mu);
#pragma unroll
      for (int i = 0; i < 8; ++i) vv[i] = cu[i] + (pv_[i] - cu[i]) * mu[i];
      unpack8(cq[3], cu); unpack8(pq[3], pv_); ldc8(CT + CT_MW + kc, mu);
#pragma unroll
      for (int i = 0; i < 8; ++i) o[i] = tanh_fast(cu[i] + (pv_[i] - cu[i]) * mu[i]);
      *(LAS u32x4*)(A_w + tq * RP + kc) = pack8(o);
      unpack8(cq[4], cu); unpack8(pq[4], pv_); ldc8(CT + CT_MA + kc, mu);
#pragma unroll
      for (int i = 0; i < 8; ++i) o[i] = cu[i] + (pv_[i] - cu[i]) * mu[i];
      *(LAS u32x4*)(A_a + tq * RP + kc) = pack8(o);
      {
#pragma unroll
          for (int q = 0; q < 2; ++q) { unpack8(cq[5 + q], cu); unpack8(pq[5 + q], pv_); ldc8(CT + CT_MG + 64 * q + kc, mu);
#pragma unroll
              for (int i = 0; i < 8; ++i) o[i] = sigmoidf_(cu[i] + (pv_[i] - cu[i]) * mu[i]);
              *(LAS u32x4*)(A_g + tq * RPG + 64 * q + kc) = pack8(o); } }
      if (L > 0) { u32x2 t2; t2.x = pk2h(t1q[0], t1q[1]); t2.y = pk2h(t1q[2], t1q[3]); *(LAS u32x2*)(t1b + tq * 40 + 4 * (lane & 7)) = t2; } }
    LDS_BAR();
    { const int pj = wv >> 2, rb = (wv >> 1) & 1, cb = wv & 1;
      const LAS bf16_t* ap = (pj ? A_a : A_w) + (32 * rb + r32) * RP + 8 * hi;
      f32x16 acc = mm32_lr<4>(ap, wf, zero16());
      LAS float* lp = (pj ? LPa : LPw) + (32 * rb + 4 * hi) * RF + 32 * cb + r32;
#pragma unroll
      for (int r = 0; r < 16; ++r) lp[((r & 3) + 8 * (r >> 2)) * RF] = acc[r];
      if (wv < 4) { const LAS bf16_t* ag = A_g + (32 * rb + r32) * RPG + 8 * hi;
          f32x16 ag_ = mm32_lr<8>(ag, gf, zero16()); LAS float* lg = LPg + (32 * rb + 4 * hi) * RF + 32 * cb + r32;
#pragma unroll
          for (int r = 0; r < 16; ++r) lg[((r & 3) + 8 * (r >> 2)) * RF] = ag_[r]; }
      if (L > 0 && wv < 4) { f32x16 av_ = mm32_lr<2>(t1b + (32 * rb + r32) * 40 + 8 * hi, v2f, zero16()); LAS float* lv = LPv + (32 * rb + 4 * hi) * RF + 32 * cb + r32;
#pragma unroll
          for (int r = 0; r < 16; ++r) lv[((r & 3) + 8 * (r >> 2)) * RF] = av_[r]; } }
    LDS_BAR();
    float gg[8]; float bon = 0.f;
    { float lw[8], aa[8], kx[8], kkn[8], cl[8];
      { float lp[8], c0[8], c1[8]; float ssk = 0.f, sbn = 0.f;
        ldc8(LPw + tq * RF + kc, lp); ldc8(CT + CT_W0 + kc, c0);
#pragma unroll
        for (int i = 0; i < 8; ++i) lw[i] = -__expf(-softplus_fast(-(c0[i] + lp[i])) - 0.5f);
        ldc8(LPa + tq * RF + kc, lp); ldc8(CT + CT_A0 + kc, c0);
#pragma unroll
        for (int i = 0; i < 8; ++i) aa[i] = sigmoidf_(c0[i] + lp[i]);
        if (L > 0) { float vf[8]; unpack8(vfq, vf); ldc8(LPv + tq * RF + kc, lp); ldc8(CT + CT_V0 + kc, c0);
#pragma unroll
            for (int i = 0; i < 8; ++i) vv[i] = vv[i] + (vf[i] - vv[i]) * sigmoidf_(c0[i] + lp[i]); }
        else *(u32x4*)(VF + tok * 512 + chn) = pack8(vv);
        ldc8(CT + CT_KK + kc, c0); ldc8(CT + CT_KA + kc, c1);
#pragma unroll
        for (int i = 0; i < 8; ++i) { kkn[i] = kq[i] * c0[i]; ssk += kkn[i] * kkn[i]; kx[i] = kq[i] * (1.f + (aa[i] - 1.f) * c1[i]); }
        const float rinv = __builtin_amdgcn_rsqf(fmaxf(group8_sum(ssk), 1e-24f));
#pragma unroll
        for (int i = 0; i < 8; ++i) kkn[i] *= rinv;
        { ldc8(CT + CT_RK + kc, c0); ldc8(LPg + tq * RF + kc, gg);
#pragma unroll
            for (int i = 0; i < 8; ++i) sbn += rr[i] * kx[i] * c0[i];
            bon = group8_sum(sbn); } }
#pragma unroll
      for (int i = 0; i < 8; ++i) cl[i] = lw[i];
      { float t_[8];
#pragma unroll
        for (int i = 0; i < 8; ++i) t_[i] = __shfl_up(cl[i], 8);
        __builtin_amdgcn_sched_barrier(0);
#pragma unroll
        for (int i = 0; i < 8; ++i) if ((lane >> 3) >= 1) cl[i] += t_[i];
#pragma unroll
        for (int i = 0; i < 8; ++i) t_[i] = __shfl_up(cl[i], 16);
        __builtin_amdgcn_sched_barrier(0);
#pragma unroll
        for (int i = 0; i < 8; ++i) if ((lane >> 3) >= 2) cl[i] += t_[i];
#pragma unroll
        for (int i = 0; i < 8; ++i) t_[i] = __shfl_up(cl[i], 32);
        __builtin_amdgcn_sched_barrier(0);
#pragma unroll
        for (int i = 0; i < 8; ++i) if ((lane >> 3) >= 4) cl[i] += t_[i]; }
      if ((lane >> 3) == 7) { *(LAS f32x4*)(tot + wv * 64 + kc) = (f32x4){cl[0], cl[1], cl[2], cl[3]}; *(LAS f32x4*)(tot + wv * 64 + kc + 4) = (f32x4){cl[4], cl[5], cl[6], cl[7]}; }
      LDS_BAR();
      { float off[8];
#pragma unroll
        for (int i = 0; i < 8; ++i) off[i] = 0.f;
#pragma unroll
        for (int q = 0; q < 7; ++q) { float tq_[8]; ldc8(tot + q * 64 + kc, tq_);
#pragma unroll
            for (int i = 0; i < 8; ++i) off[i] += (q < wv) ? tq_[i] : 0.f; }
        float at[8], bt[8], kt[8], rt[8], gv[8];
#pragma unroll
        for (int i = 0; i < 8; ++i) { const float cj = off[i] + cl[i]; const float g = __expf(cj), gm1 = __expf(cj - lw[i]), gi = __expf(-cj);
            at[i] = -kkn[i] * gm1; bt[i] = kkn[i] * aa[i] * gi; kt[i] = kx[i] * gi; rt[i] = rr[i] * g; gv[i] = g; }
        const u32x4 pb_ = pack8(bt), pk_ = pack8(kt), pv_ = pack8(vv);
        *(LAS u32x4*)(Bt + tq * RP + kc) = pb_; *(LAS u32x4*)(Kt + tq * RP + kc) = pk_;
        *(LAS u32x4*)(Rt + tq * RP + kc) = pack8(rt);
        if (tq == 63) { *(LAS f32x4*)(gC + kc) = (f32x4){gv[0], gv[1], gv[2], gv[3]}; *(LAS f32x4*)(gC + kc + 4) = (f32x4){gv[4], gv[5], gv[6], gv[7]}; }
#pragma unroll
        for (int i = 0; i < 8; ++i) { const unsigned wv_ = (i & 1) ? (pv_[i >> 1] >> 16) : (pv_[i >> 1] & 0xffffu); VtT[(kc + i) * RP + tq] = (bf16_t)wv_; }
        { const u32x4 pa_ = pack8(at); *(LAS u32x4*)(At + tq * RP + kc) = pa_;
#pragma unroll
            for (int i = 0; i < 8; ++i) { const int sh = (i & 1) * 16; Xt[(kc + i) * RP + tq] = (bf16_t)((pa_[i >> 1] >> sh) & 0xffffu); BtT[(kc + i) * RP + tq] = (bf16_t)((pb_[i >> 1] >> sh) & 0xffffu); KtT[(kc + i) * RP + tq] = (bf16_t)((pk_[i >> 1] >> sh) & 0xffffu); } } } }
    LDS_BAR();
#pragma unroll
    for (int it = 0; it < 2; ++it) {
        const int blk = wv + 8 * it, rbk = blk >> 2, cbk = blk & 3;
        const LAS bf16_t* ap = (cbk < 2 ? Bt : Kt) + (32 * (cbk & 1) + r32) * RP + 8 * hi; const LAS bf16_t* bp = (rbk < 2 ? At : Rt) + (32 * (rbk & 1) + r32) * RP + 8 * hi;
        const f32x16 acc = mm32_ll<4>(ap, bp, zero16());
        const int t = 32 * (rbk & 1) + r32, sb0 = 32 * (cbk & 1) + 4 * hi;
        const int lim = rbk < 2 ? t : t + 1;
        if (rbk < 2 && cbk < 2) {
#pragma unroll
            for (int g = 0; g < 4; ++g) { const int s0 = sb0 + 8 * g; f32x4 v; v[0] = s0 < lim ? acc[4 * g] : 0.f; v[1] = s0 + 1 < lim ? acc[4 * g + 1] : 0.f; v[2] = s0 + 2 < lim ? acc[4 * g + 2] : 0.f; v[3] = s0 + 3 < lim ? acc[4 * g + 3] : 0.f;
                *(LAS f32x4*)(Aab + t * RF + s0) = v; u32x2 o; o.x = pk2h(v[0], v[1]); o.y = pk2h(v[2], v[3]); *(LAS u32x2*)(Lb + t * RP + s0) = o; }
        } else {
            LAS bf16_t* dst = rbk < 2 ? Aak : (cbk < 2 ? Arb : Ark);
#pragma unroll
            for (int g = 0; g < 4; ++g) { const int s0 = sb0 + 8 * g; u32x2 o; o.x = pk2h(s0 < lim ? acc[4 * g] : 0.f, s0 + 1 < lim ? acc[4 * g + 1] : 0.f); o.y = pk2h(s0 + 2 < lim ? acc[4 * g + 2] : 0.f, s0 + 3 < lim ? acc[4 * g + 3] : 0.f);
                *(LAS u32x2*)(dst + t * RP + s0) = o; }
        }
    }
    LDS_BAR();
    if (cnext >= 0) rw_load_rows(PR, tok0, h, cnext, cq, pq);
    {
        if (wv < 4) { const int rbk = wv >> 1, cbk = wv & 1;
            f32x16 acc = mm32_ll<4>(Aak + (32 * rbk + r32) * RP + 8 * hi, VtT + (32 * cbk + r32) * RP + 8 * hi, zero16());
                    LAS bf16_t* rp = Xt + (64 + 32 * cbk + r32) * RP + 32 * rbk + 4 * hi;
    #pragma unroll
            for (int g = 0; g < 4; ++g) { u32x2 o; o.x = pk2h(acc[4 * g], acc[4 * g + 1]); o.y = pk2h(acc[4 * g + 2], acc[4 * g + 3]); *(LAS u32x2*)(rp + 8 * g) = o; }
        } else if (wv == 4) {
            float x[32]; const LAS float* lb = Aab + (32 * hi) * RF + 32 * hi;
            f32x4 lv[2][8];
    #pragma unroll
            for (int t = 0; t < 32; ++t) {
                if (t + 1 < 32) {
    #pragma unroll
                    for (int s4 = 0; s4 < (t + 4) / 4; ++s4) lv[(t + 1) & 1][s4] = *(const LAS f32x4*)(lb + (t + 1) * RF + 4 * s4); }
                __builtin_amdgcn_sched_barrier(0);
                float a0_ = (t == r32) ? 1.f : 0.f, a1_ = 0.f;
    #pragma unroll
                for (int s4 = 0; s4 < (t + 3) / 4; ++s4) { const f32x4 l_ = lv[t & 1][s4];
                    if (4 * s4 < t) a0_ += l_[0] * x[4 * s4]; if (4 * s4 + 1 < t) a1_ += l_[1] * x[4 * s4 + 1]; if (4 * s4 + 2 < t) a0_ += l_[2] * x[4 * s4 + 2]; if (4 * s4 + 3 < t) a1_ += l_[3] * x[4 * s4 + 3]; }
                x[t] = a0_ + a1_;
                __builtin_amdgcn_sched_barrier(0); }
    #pragma unroll
            for (int t = 0; t < 32; ++t) Tinv[(32 * hi + t) * 40 + r32] = f2bfh(x[t]);
        }
        LDS_BAR();
        if (wv < 4) {
            LAS bf16_t* xc = Xt + (32 * wv + r32) * RP;
            f32x16 x0 = mm32_ll<2>(Tinv + r32 * 40 + 8 * hi, xc + 8 * hi, zero16());
            f32x16 z;
    #pragma unroll
            for (int g = 0; g < 4; ++g) { const u32x2 rw = *(const LAS u32x2*)(xc + 32 + 4 * hi + 8 * g); z[4 * g] = bflo(rw.x); z[4 * g + 1] = bfhi(rw.x); z[4 * g + 2] = bflo(rw.y); z[4 * g + 3] = bfhi(rw.y); }
    #pragma unroll
            for (int g = 0; g < 4; ++g) { u32x2 o; o.x = pk2h(x0[4 * g], x0[4 * g + 1]); o.y = pk2h(x0[4 * g + 2], x0[4 * g + 3]); *(LAS u32x2*)(xc + 4 * hi + 8 * g) = o; }
            z = mm32_ll<2>(Lb + (32 + r32) * RP + 8 * hi, xc + 8 * hi, z);
    #pragma unroll
            for (int g = 0; g < 4; ++g) { u32x2 o; o.x = pk2h(z[4 * g], z[4 * g + 1]); o.y = pk2h(z[4 * g + 2], z[4 * g + 3]); *(LAS u32x2*)(xc + 32 + 4 * hi + 8 * g) = o; }
            const f32x16 x1 = mm32_ll<2>(Tinv + (32 + r32) * 40 + 8 * hi, xc + 32 + 8 * hi, zero16());
    #pragma unroll
            for (int g = 0; g < 4; ++g) { u32x2 o; o.x = pk2h(x1[4 * g], x1[4 * g + 1]); o.y = pk2h(x1[4 * g + 2], x1[4 * g + 3]); *(LAS u32x2*)(xc + 32 + 4 * hi + 8 * g) = o; }
        }
        LDS_BAR();

    }
    {
        const int rbk = (wv >> 1) & 1, cbk = wv & 1;
        if (wv < 4) { const f32x16 acc = mm32_ll<4>(Xt + (32 * cbk + r32) * RP + 8 * hi, BtT + (32 * rbk + r32) * RP + 8 * hi, zero16());
            const float gk = gC[32 * rbk + r32]; bf16_t* pc = rb_.PCORR + chh * 4096 + (size_t)(32 * rbk + r32) * 64 + 32 * cbk + 4 * hi;
#pragma unroll
            for (int g = 0; g < 4; ++g) { u32x2 o; o.x = pk2h(acc[4 * g] * gk, acc[4 * g + 1] * gk); o.y = pk2h(acc[4 * g + 2] * gk, acc[4 * g + 3] * gk); *(u32x2*)(pc + 16 * (g >> 1) + 4 * (g & 1) + 4 * hi) = o; } }
        else { f32x16 acc = mm32_ll<4>(BtT + (32 * rbk + r32) * RP + 8 * hi, Xt + (64 + 32 * cbk + r32) * RP + 8 * hi, zero16());
            acc = mm32_ll<4>(KtT + (32 * rbk + r32) * RP + 8 * hi, VtT + (32 * cbk + r32) * RP + 8 * hi, acc);
            bf16_t* hp = rb_.HL + chh * 4096 + (size_t)(32 * cbk + r32) * 64 + 32 * rbk + 4 * hi;
#pragma unroll
            for (int g = 0; g < 4; ++g) { const int k0 = 32 * rbk + 4 * hi + 8 * g; u32x2 o; o.x = pk2h(acc[4 * g] * gC[k0], acc[4 * g + 1] * gC[k0 + 1]); o.y = pk2h(acc[4 * g + 2] * gC[k0 + 2], acc[4 * g + 3] * gC[k0 + 3]);
                *(u32x2*)(hp + 16 * (g >> 1) + 4 * (g & 1) + 4 * hi) = o; } }
        if (tid < 64) rb_.GC[chh * 64 + tid] = gC[tid];
        if (wv < 4) { f32x16 acc = mm32_ll<4>(Arb + (32 * rbk + r32) * RP + 8 * hi, Xt + (64 + 32 * cbk + r32) * RP + 8 * hi, zero16());
            acc = mm32_ll<4>(Ark + (32 * rbk + r32) * RP + 8 * hi, VtT + (32 * cbk + r32) * RP + 8 * hi, acc);
            LAS float* yp = Ylf + (32 * rbk + 4 * hi) * RF + 32 * cbk + r32;
#pragma unroll
            for (int r = 0; r < 16; ++r) yp[((r & 3) + 8 * (r >> 2)) * RF] = acc[r]; }
        else { f32x16 acc; const LAS bf16_t* rp_ = Rt + (32 * rbk + 4 * hi) * RP + 32 * cbk + r32;
#pragma unroll
            for (int r = 0; r < 16; ++r) acc[r] = bf2f(rp_[((r & 3) + 8 * (r >> 2)) * RP]);
            acc = mm32_ll<4>(Arb + (32 * rbk + r32) * RP + 8 * hi, Xt + (32 * cbk + r32) * RP + 8 * hi, acc);
            LAS bf16_t* op_ = R2T + (32 * cbk + r32) * RP + 32 * rbk + 4 * hi;
#pragma unroll
            for (int g = 0; g < 4; ++g) { u32x2 o; o.x = pk2h(acc[4 * g], acc[4 * g + 1]); o.y = pk2h(acc[4 * g + 2], acc[4 * g + 3]); *(LAS u32x2*)(op_ + 8 * g) = o; } }
        LDS_BAR();
        { float yl[8], o[8]; ldc8(Ylf + tq * RF + kc, yl);
          bf16_t* base = tq == 63 ? rb_.GX + chh * 8192 + 4096 + kc : (bf16_t*)PR + tok * RWC + chn; const int stride = tq == 63 ? 64 : 512;
          *(u32x4*)base = pack8(gg);
#pragma unroll
          for (int i = 0; i < 8; ++i) o[i] = bon * vv[i] * gg[i];
          *(u32x4*)(base + stride) = pack8(o); *(u32x4*)(base + 2 * stride) = pack8(yl);
          const LAS bf16_t* xp = R2T + ((kc & ~15) + ((kc & 8) >> 1)) * RP + tq; u32x4 gq;
          gq.x = (unsigned)xp[0] | ((unsigned)xp[RP] << 16); gq.y = (unsigned)xp[2 * RP] | ((unsigned)xp[3 * RP] << 16); gq.z = (unsigned)xp[8 * RP] | ((unsigned)xp[9 * RP] << 16); gq.w = (unsigned)xp[10 * RP] | ((unsigned)xp[11 * RP] << 16);
          *(u32x4*)(rb_.GX + chh * 8192 + (size_t)tq * 64 + kc) = gq; }
    }
}

__device__ __forceinline__ void rw_passb_phase(const LayerW& w, const bf16_t* PR, const RwBufs& rb_, bf16_t* YC, int yc_pitch, int bid, int G, LAS unsigned char* sm) {
    const int tid = tid_opaque(), lane = tid & 63, wv = __builtin_amdgcn_readfirstlane(tid >> 6), r32 = lane & 31, hi = lane >> 5;
    LAS float* Yf = (LAS float*)(sm); LAS float* CT = (LAS float*)(sm + 145664);
    const int tq = 8 * wv + (lane >> 3), kc = 8 * (lane & 7), rbk = wv >> 1, cbk = wv & 1;
    if (bid >= 2048) return;
    const int bh = bid & 31, h = bh & 7, chn = h * 64 + kc, tok0 = (bh >> 3) * SEQ;
    if (tid < 64) { CT[CT_LG + tid] = w.lng()[h * 64 + tid]; CT[CT_LB + tid] = w.lnb()[h * 64 + tid]; }
    bf16x8 r2a[4], hfa[4], r2b[4], hfb[4]; u32x4 qga, qba, qla, qgb, qbb, qlb;
#define PB_LOAD(R2, HF, QG, QB, QL, u_) do { const int c_ = (u_) >> 5; const size_t chh_ = (size_t)bh * RW_NC + c_, tok_ = (size_t)tok0 + c_ * RW_C + tq; \
        if (wv < 4) { const bf16_t* r2p = rb_.GX + chh_ * 8192 + (size_t)(32 * rbk + r32) * 64 + 8 * hi; const bf16_t* hp = rb_.HL + chh_ * 4096 + (size_t)(32 * cbk + r32) * 64 + 8 * hi; \
            _Pragma("unroll") for (int s = 0; s < 4; ++s) { R2[s] = *(const bf16x8*)(r2p + 16 * s); HF[s] = *(const bf16x8*)(hp + 16 * s); } } \
        const bf16_t* base_ = tq == 63 ? rb_.GX + chh_ * 8192 + 4096 + kc : PR + tok_ * RWC + chn; const int stride_ = tq == 63 ? 64 : 512; \
        QG = *(const u32x4*)base_; QB = *(const u32x4*)(base_ + stride_); QL = *(const u32x4*)(base_ + 2 * stride_); } while (0)
#define PB_PROC(R2, HF, QG, QB, QL, u_) do { const size_t tok_ = (size_t)tok0 + ((u_) >> 5) * RW_C + tq; \
        LDS_BAR();                                                      \
        if (wv < 4) { const f32x16 acc = mm32_rr<4>(R2, HF, zero16()); LAS float* yp = Yf + (32 * rbk + 4 * hi) * RF + 32 * cbk + r32; \
            _Pragma("unroll") for (int r = 0; r < 16; ++r) yp[((r & 3) + 8 * (r >> 2)) * RF] = acc[r]; } \
        LDS_BAR(); \
        { float y[8], yl[8], gg[8], bg[8], lg_[8], lb_[8], o[8]; ldc8(Yf + tq * RF + kc, y); ldc8(CT + CT_LG + kc, lg_); ldc8(CT + CT_LB + kc, lb_); unpack8(QL, yl); unpack8(QG, gg); unpack8(QB, bg); \
          float sy = 0.f; \
          _Pragma("unroll") for (int i = 0; i < 8; ++i) { y[i] += yl[i]; sy += y[i]; } \
          const float mean = group8_sum(sy) * (1.f / 64.f); float sd = 0.f; \
          _Pragma("unroll") for (int i = 0; i < 8; ++i) { y[i] -= mean; sd += y[i] * y[i]; } \
          const float rs = __builtin_amdgcn_rsqf(group8_sum(sd) * (1.f / 64.f) + 64e-5f); \
          _Pragma("unroll") for (int i = 0; i < 8; ++i) o[i] = (y[i] * rs * lg_[i] + lb_[i]) * gg[i] + bg[i]; \
          *(u32x4*)(YC + tok_ * yc_pitch + chn) = pack8(o); } } while (0)
    int u = bid;
    PB_LOAD(r2a, hfa, qga, qba, qla, u);
    for (;;) {
        if (u + G < 2048) PB_LOAD(r2b, hfb, qgb, qbb, qlb, u + G);
        PB_PROC(r2a, hfa, qga, qba, qla, u); u += G; if (u >= 2048) break;
        if (u + G < 2048) PB_LOAD(r2a, hfa, qga, qba, qla, u + G);
        PB_PROC(r2b, hfb, qgb, qbb, qlb, u); u += G; if (u >= 2048) break;
    }
#undef PB_LOAD
#undef PB_PROC
}

#undef LDS_BAR
#ifndef SEQ_HILO
#define SEQ_HILO 0
#endif
struct SeqLd { u32x4 pa[2][4]; u32x4 hw[2][2]; };
__device__ __forceinline__ void rw_seq_load(SeqLd& d, const RwBufs& rb_, size_t chh, int v, int r32, int hi) {
    const bf16_t* hl = rb_.HL + chh * 4096 + (size_t)v * 64 + 8 * hi; const bf16_t* pc = rb_.PCORR + chh * 4096 + (size_t)r32 * 64 + 8 * hi;
#pragma unroll
    for (int rb = 0; rb < 2; ++rb) {
#pragma unroll
        for (int q = 0; q < 2; ++q) d.hw[rb][q] = *(const u32x4*)(hl + 32 * rb + 16 * q);
#pragma unroll
        for (int s = 0; s < 4; ++s) d.pa[rb][s] = *(const u32x4*)(pc + (size_t)32 * rb * 64 + 16 * s); }
}
__device__ __forceinline__ void rw_seq_step(const SeqLd& cur, f32x16 (&st)[2], bf16_t* hl, const LAS float* gc) {
    bf16x8 bh_[4], bl_[4];
#pragma unroll
    for (int s = 0; s < 4; ++s) { u32x4 wh, wl;
#pragma unroll
        for (int q = 0; q < 4; ++q) { const float x0 = st[s >> 1][8 * (s & 1) + 2 * q], x1 = st[s >> 1][8 * (s & 1) + 2 * q + 1]; const unsigned ph = pk2h(x0, x1); wh[q] = ph; if (SEQ_HILO) wl[q] = pk2h(x0 - bflo(ph), x1 - bfhi(ph)); }
        bh_[s] = __builtin_bit_cast(bf16x8, wh); if (SEQ_HILO) bl_[s] = __builtin_bit_cast(bf16x8, wl);
        *(u32x4*)(hl + 32 * (s >> 1) + 16 * (s & 1)) = wh; }
    f32x16 nw[2], nl[2], ad[2]; nw[0] = zero16(); nw[1] = zero16(); nl[0] = zero16(); nl[1] = zero16();
#pragma unroll
    for (int rb = 0; rb < 2; ++rb)
#pragma unroll
        for (int s = 0; s < 4; ++s) { const bf16x8 af = __builtin_bit_cast(bf16x8, cur.pa[rb][s]);
            nw[rb] = __builtin_amdgcn_mfma_f32_32x32x16_bf16(af, bh_[s], nw[rb], 0, 0, 0);
            if (SEQ_HILO) nl[rb] = __builtin_amdgcn_mfma_f32_32x32x16_bf16(af, bl_[s], nl[rb], 0, 0, 0); }
#pragma unroll
    for (int rb = 0; rb < 2; ++rb)
#pragma unroll
        for (int g = 0; g < 4; ++g) { const f32x4 gv = *(const LAS f32x4*)(gc + 32 * rb + 8 * g); const u32x4 hq = cur.hw[rb][g >> 1]; const unsigned h0 = (g & 1) ? hq.z : hq.x, h1 = (g & 1) ? hq.w : hq.y;
            ad[rb][4 * g] = gv[0] * st[rb][4 * g] + bflo(h0); ad[rb][4 * g + 1] = gv[1] * st[rb][4 * g + 1] + bfhi(h0);
            ad[rb][4 * g + 2] = gv[2] * st[rb][4 * g + 2] + bflo(h1); ad[rb][4 * g + 3] = gv[3] * st[rb][4 * g + 3] + bfhi(h1); }
    if (SEQ_HILO) { st[0] = (nw[0] + nl[0]) + ad[0]; st[1] = (nw[1] + nl[1]) + ad[1]; } else { st[0] = nw[0] + ad[0]; st[1] = nw[1] + ad[1]; }
}
__device__ __forceinline__ void rw_seq_wave(const RwBufs& rb_, int bh, int vs, int lane, LAS float* gcl) {
    const int r32 = lane & 31, hi = lane >> 5, v = 32 * vs + r32;
    for (int i = lane; i < RW_NC * 16; i += 64) *(LAS f32x4*)(gcl + 4 * i) = *(const f32x4*)(rb_.GC + (size_t)bh * RW_NC * 64 + 4 * i);
    asm volatile("s_waitcnt vmcnt(0) lgkmcnt(0)" ::: "memory");
    f32x16 st[2]; st[0] = zero16(); st[1] = zero16();
    SeqLd la, lb;
    const size_t ch0 = (size_t)bh * RW_NC;
    rw_seq_load(la, rb_, ch0, v, r32, hi);
    for (int c = 0; c < RW_NC; c += 2) {
        rw_seq_load(lb, rb_, ch0 + c + 1, v, r32, hi);
        rw_seq_step(la, st, rb_.HL + (ch0 + c) * 4096 + (size_t)v * 64 + 8 * hi, gcl + c * 64 + 4 * hi);
        if (c + 2 < RW_NC) rw_seq_load(la, rb_, ch0 + c + 2, v, r32, hi);
        rw_seq_step(lb, st, rb_.HL + (ch0 + c + 1) * 4096 + (size_t)v * 64 + 8 * hi, gcl + (c + 1) * 64 + 4 * hi);
    }
}
constexpr size_t OW_WUQ = OW_XEND, OW_WUKV = OW_WUQ + (size_t)768 * 256, OW_YEND = OW_WUKV + (size_t)1024 * 128;
static_assert(OW_YEND * 2 <= 52 * MiB, "weights fit");
constexpr int MP = 392;

__device__ __forceinline__ void conv_mla(const LayerW& w, bf16_t* W, int gtid, int NT) {
    for (int i = gtid; i < 24576 + 16384; i += NT) {
        float v[8]; bf16_t* dst;
        if (i < 24576) { const int lane = i & 63, ks = (i >> 6) & 15, hn = i >> 10; const int h = hn / 3, nb = hn - 3 * h; const int n = h * 96 + 32 * nb + (lane & 31), k0 = 16 * ks + 8 * (lane >> 5);
#pragma unroll
            for (int j = 0; j < 8; ++j) v[j] = w.wuq()[(size_t)(k0 + j) * 768 + n] * w.qan()[k0 + j];
            dst = W + OW_WUQ + (size_t)i * 8; }
        else { const int r = i - 24576; const int lane = r & 63, ks = (r >> 6) & 7, q = r >> 9; const int nb = q & 1, part = (q >> 1) & 1, h = q >> 2; const int n = h * 128 + 64 * part + 32 * nb + (lane & 31), k0 = 16 * ks + 8 * (lane >> 5);
#pragma unroll
            for (int j = 0; j < 8; ++j) v[j] = w.wukv()[(size_t)(k0 + j) * 1024 + n] * w.kvan()[k0 + j];
            dst = W + OW_WUKV + (size_t)r * 8; }
        u32x4 o; o.x = pk2h(v[0], v[1]); o.y = pk2h(v[2], v[3]); o.z = pk2h(v[4], v[5]); o.w = pk2h(v[6], v[7]); *(u32x4*)dst = o;
    }
}
__device__ __forceinline__ void conv_t1(const LayerW& w, bf16_t* W, int gtid, int NT) {
    for (int i = gtid; i < 1024 * 32 * 4; i += NT) { const int cs = i & 3, r = (i >> 2) & 31, k = i >> 7;
        const f32x4* wr4 = (const f32x4*)(w.win() + (size_t)k * 6304 + 2464 + 128 * cs); const f32x4* mu4 = (const f32x4*)(w.mu() + 1024 + 128 * cs); const float* v1p = w.v1() + (size_t)(128 * cs) * 32 + r;
        float sa = 0.f, sb = 0.f;
#pragma unroll 1
        for (int c8 = 0; c8 < 4; ++c8) {
            f32x4 x[8], mm[8]; float vv_[32];
#pragma unroll
            for (int q = 0; q < 8; ++q) { x[q] = wr4[8 * c8 + q]; mm[q] = mu4[8 * c8 + q]; }
#pragma unroll
            for (int q = 0; q < 32; ++q) vv_[q] = v1p[(32 * c8 + q) * 32];
            __builtin_amdgcn_sched_barrier(0);
#pragma unroll
            for (int q = 0; q < 8; ++q)
#pragma unroll
                for (int j = 0; j < 4; ++j) { const float xv = x[q][j] * vv_[4 * q + j]; sa += xv * (1.f - mm[q][j]); sb += xv * mm[q][j]; } }
        sa += __shfl_xor(sa, 1); sb += __shfl_xor(sb, 1); sa += __shfl_xor(sa, 2); sb += __shfl_xor(sb, 2);
        if (cs == 0) { const float g = w.mixn()[k];
            W[OW_WIN + (size_t)(416 + r) * DM + k] = f2bfh(sa * g); W[OW_WIN + (size_t)(448 + r) * DM + k] = f2bfh(sb * g); } }
}

__device__ __forceinline__ void mla_unit_mfma(const LayerW& w, int L, const bf16_t* PM, const bf16_t* Wb, const float* cosT, const float* sinT, bf16_t* Q, bf16_t* K, bf16_t* Vt, float* T1, int t0, LAS unsigned char* sm) {
    const int tid = tid_opaque(), lane = tid & 63, wv = __builtin_amdgcn_readfirstlane(tid >> 6), r32 = lane & 31, hi = lane >> 5;
    LAS bf16_t* An = (LAS bf16_t*)sm; LAS float* kpe = (LAS float*)(sm + 64 * MP * 2); LAS float* kpss = kpe + 64 * 32;
    __syncthreads();
    { u32x2 q4[8]; unsigned k2[8]; float pe_[8], ta[8], tb_[8];
#pragma unroll
      for (int j = 0; j < 8; ++j) { const int tl = 8 * wv + j; const bf16_t* row = PM + (size_t)(t0 + tl) * 512;
          q4[j] = *(const u32x2*)(row + lane * 4); k2[j] = *(const unsigned*)(row + 256 + lane * 2);
          pe_[j] = lane < 32 ? bf2f(row[384 + lane]) : 0.f;
          ta[j] = 0.f; tb_[j] = 0.f;
          if (L > 0 && lane < 32) { const int t = t0 + tl; ta[j] = bf2f(row[416 + lane]); tb_[j] = (t & (SEQ - 1)) ? bf2f(*(row - 512 + 448 + lane)) : 0.f; } }
      __builtin_amdgcn_sched_barrier(0);
#pragma unroll
      for (int j = 0; j < 8; ++j) { const int tl = 8 * wv + j;
          const float v0 = bflo(q4[j].x), v1 = bfhi(q4[j].x), v2 = bflo(q4[j].y), v3 = bfhi(q4[j].y);
          const float c0 = bflo(k2[j]), c1 = bfhi(k2[j]); const float pe = pe_[j];
          const float rq = __builtin_amdgcn_rsqf(wave_sum_dpp((v0 * v0 + v1 * v1) + (v2 * v2 + v3 * v3)) * (1.f / 256.f) + EPS);
          const float rk = __builtin_amdgcn_rsqf(wave_sum_dpp(c0 * c0 + c1 * c1) * (1.f / 128.f) + EPS);
          const float ps = wave_sum_dpp(pe * pe);
          u32x2 o; o.x = pk2h(v0 * rq, v1 * rq); o.y = pk2h(v2 * rq, v3 * rq); *(LAS u32x2*)(An + tl * MP + lane * 4) = o;
          *(LAS unsigned*)(An + tl * MP + 256 + lane * 2) = pk2h(c0 * rk, c1 * rk);
          if (lane < 32) kpe[tl * 32 + lane] = pe;
          if (lane == 0) kpss[tl] = ps;
          if (L > 0 && lane < 32) T1[(size_t)(t0 + tl) * 32 + lane] = ta[j] + tb_[j]; } }
    __syncthreads();
    const int h = wv; const int b_ = t0 / SEQ, ts0 = t0 - b_ * SEQ;
    { f32x16 acc[3][2];
#pragma unroll
      for (int nb = 0; nb < 3; ++nb) { acc[nb][0] = zero16(); acc[nb][1] = zero16(); }
      const bf16_t* wq = Wb + OW_WUQ + ((size_t)(h * 3) * 16 * 64 + lane) * 8; const LAS bf16_t* an = An + r32 * MP + 8 * hi;
#pragma unroll
      for (int half = 0; half < 2; ++half) {
          bf16x8 wf[8][3];
#pragma unroll
          for (int s8 = 0; s8 < 8; ++s8)
#pragma unroll
              for (int nb = 0; nb < 3; ++nb) wf[s8][nb] = *(const bf16x8*)(wq + (size_t)(nb * 16 + 8 * half + s8) * 512);
          __builtin_amdgcn_sched_barrier(0);
#pragma unroll
          for (int s8 = 0; s8 < 8; ++s8) { const int s = 8 * half + s8; const bf16x8 b0 = *(const LAS bf16x8*)(an + 16 * s), b1 = *(const LAS bf16x8*)(an + 32 * MP + 16 * s);
#pragma unroll
              for (int nb = 0; nb < 3; ++nb) { acc[nb][0] = __builtin_amdgcn_mfma_f32_32x32x16_bf16(wf[s8][nb], b0, acc[nb][0], 0, 0, 0); acc[nb][1] = __builtin_amdgcn_mfma_f32_32x32x16_bf16(wf[s8][nb], b1, acc[nb][1], 0, 0, 0); } } }
      f32x4 gnq[2][4], g1q[2], g2q[2], csq[2][2], snq[2][2];
#pragma unroll
      for (int nb = 0; nb < 2; ++nb)
#pragma unroll
          for (int g = 0; g < 4; ++g) gnq[nb][g] = *(const f32x4*)(w.qn() + 32 * nb + 8 * g + 4 * hi);
#pragma unroll
      for (int g = 0; g < 2; ++g) { const int i0 = 8 * g + 4 * hi; g1q[g] = *(const f32x4*)(w.qn() + 64 + i0); g2q[g] = *(const f32x4*)(w.qn() + 80 + i0);
#pragma unroll
          for (int tb = 0; tb < 2; ++tb) { const int t = t0 + 32 * tb + r32; csq[tb][g] = *(const f32x4*)(cosT + (size_t)t * 16 + i0); snq[tb][g] = *(const f32x4*)(sinT + (size_t)t * 16 + i0); } }
      __builtin_amdgcn_sched_barrier(0);
#pragma unroll
      for (int tb = 0; tb < 2; ++tb) { const int t = t0 + 32 * tb + r32; float ss = 0.f;
#pragma unroll
          for (int nb = 0; nb < 3; ++nb)
#pragma unroll
              for (int r = 0; r < 16; ++r) ss += acc[nb][tb][r] * acc[nb][tb][r];
          ss += __shfl_xor(ss, 32); const float rs = __builtin_amdgcn_rsqf(ss * (1.f / 96.f) + EPS) * ATT_SC;
          bf16_t* qo = Q + (size_t)t * 768 + h * 96 + 4 * hi;
#pragma unroll
          for (int nb = 0; nb < 2; ++nb)
#pragma unroll
              for (int g = 0; g < 4; ++g) { const f32x4 gn = gnq[nb][g];
                  u32x2 o; o.x = pk2h(acc[nb][tb][4 * g] * rs * gn[0], acc[nb][tb][4 * g + 1] * rs * gn[1]); o.y = pk2h(acc[nb][tb][4 * g + 2] * rs * gn[2], acc[nb][tb][4 * g + 3] * rs * gn[3]);
                  *(u32x2*)(qo + 32 * nb + 8 * g) = o; }
#pragma unroll
          for (int g = 0; g < 2; ++g) { const f32x4 g1 = g1q[g], g2 = g2q[g];
              const f32x4 cs = csq[tb][g], sn = snq[tb][g]; float o1[4], o2[4];
#pragma unroll
              for (int i = 0; i < 4; ++i) { const float x1 = acc[2][tb][4 * g + i] * rs * g1[i], x2 = acc[2][tb][8 + 4 * g + i] * rs * g2[i]; o1[i] = x1 * cs[i] - x2 * sn[i]; o2[i] = x2 * cs[i] + x1 * sn[i]; }
              u32x2 a; a.x = pk2h(o1[0], o1[1]); a.y = pk2h(o1[2], o1[3]); u32x2 b; b.x = pk2h(o2[0], o2[1]); b.y = pk2h(o2[2], o2[3]);
              *(u32x2*)(qo + 64 + 8 * g) = a; *(u32x2*)(qo + 80 + 8 * g) = b; } } }
#pragma unroll
    for (int part = 0; part < 2; ++part) {
        f32x16 acc[2][2]; acc[0][0] = zero16(); acc[0][1] = zero16(); acc[1][0] = zero16(); acc[1][1] = zero16();
        const bf16_t* wk = Wb + OW_WUKV + ((size_t)((h * 2 + part) * 2) * 8 * 64 + lane) * 8; const LAS bf16_t* an = An + r32 * MP + 256 + 8 * hi;
        { bf16x8 wf[8][2];
#pragma unroll
          for (int s = 0; s < 8; ++s)
#pragma unroll
              for (int nb = 0; nb < 2; ++nb) wf[s][nb] = *(const bf16x8*)(wk + (size_t)(nb * 8 + s) * 512);
          __builtin_amdgcn_sched_barrier(0);
#pragma unroll
          for (int s = 0; s < 8; ++s) { const bf16x8 b0 = *(const LAS bf16x8*)(an + 16 * s), b1 = *(const LAS bf16x8*)(an + 32 * MP + 16 * s);
#pragma unroll
              for (int nb = 0; nb < 2; ++nb) { acc[nb][0] = __builtin_amdgcn_mfma_f32_32x32x16_bf16(wf[s][nb], b0, acc[nb][0], 0, 0, 0); acc[nb][1] = __builtin_amdgcn_mfma_f32_32x32x16_bf16(wf[s][nb], b1, acc[nb][1], 0, 0, 0); } } }
        f32x4 gnk[2][4], g1k[2], g2k[2], csk[2][2], snk[2][2];
        if (part == 0) {
#pragma unroll
            for (int nb = 0; nb < 2; ++nb)
#pragma unroll
                for (int g = 0; g < 4; ++g) gnk[nb][g] = *(const f32x4*)(w.kn() + 32 * nb + 8 * g + 4 * hi);
#pragma unroll
            for (int g = 0; g < 2; ++g) { const int i0 = 8 * g + 4 * hi; g1k[g] = *(const f32x4*)(w.kn() + 64 + i0); g2k[g] = *(const f32x4*)(w.kn() + 80 + i0);
#pragma unroll
                for (int tb = 0; tb < 2; ++tb) { const int t = t0 + 32 * tb + r32; csk[tb][g] = *(const f32x4*)(cosT + (size_t)t * 16 + i0); snk[tb][g] = *(const f32x4*)(sinT + (size_t)t * 16 + i0); } }
            __builtin_amdgcn_sched_barrier(0); }
#pragma unroll
        for (int tb = 0; tb < 2; ++tb) { const int tl = 32 * tb + r32, t = t0 + tl;
            if (part == 0) { float ss = 0.f;
#pragma unroll
                for (int nb = 0; nb < 2; ++nb)
#pragma unroll
                    for (int r = 0; r < 16; ++r) ss += acc[nb][tb][r] * acc[nb][tb][r];
                ss += __shfl_xor(ss, 32); const float rs = __builtin_amdgcn_rsqf((ss + kpss[tl]) * (1.f / 96.f) + EPS);
                bf16_t* ko = K + (size_t)t * 768 + h * 96 + 4 * hi;
#pragma unroll
                for (int nb = 0; nb < 2; ++nb)
#pragma unroll
                    for (int g = 0; g < 4; ++g) { const f32x4 gn = gnk[nb][g];
                        u32x2 o; o.x = pk2h(acc[nb][tb][4 * g] * rs * gn[0], acc[nb][tb][4 * g + 1] * rs * gn[1]); o.y = pk2h(acc[nb][tb][4 * g + 2] * rs * gn[2], acc[nb][tb][4 * g + 3] * rs * gn[3]);
                        *(u32x2*)(ko + 32 * nb + 8 * g) = o; }
#pragma unroll
                for (int g = 0; g < 2; ++g) { const int i0 = 8 * g + 4 * hi; const f32x4 g1 = g1k[g], g2 = g2k[g];
                    const f32x4 cs = csk[tb][g], sn = snk[tb][g];
                    const f32x4 p1 = *(const LAS f32x4*)(kpe + tl * 32 + i0), p2 = *(const LAS f32x4*)(kpe + tl * 32 + 16 + i0); float o1[4], o2[4];
#pragma unroll
                    for (int i = 0; i < 4; ++i) { const float x1 = p1[i] * rs * g1[i], x2 = p2[i] * rs * g2[i]; o1[i] = x1 * cs[i] - x2 * sn[i]; o2[i] = x2 * cs[i] + x1 * sn[i]; }
                    u32x2 a; a.x = pk2h(o1[0], o1[1]); a.y = pk2h(o1[2], o1[3]); u32x2 b; b.x = pk2h(o2[0], o2[1]); b.y = pk2h(o2[2], o2[3]);
                    *(u32x2*)(ko + 64 + 8 * g) = a; *(u32x2*)(ko + 80 + 8 * g) = b; }
            } else {
                LAS bf16_t* vt_ = (LAS bf16_t*)(sm + 65536 + wv * 9216) + (4 * hi) * 72 + ((tl & ~12) | ((tl & 4) << 1) | ((tl & 8) >> 1));
#pragma unroll
                for (int nb = 0; nb < 2; ++nb)
#pragma unroll
                    for (int r = 0; r < 16; ++r) vt_[(32 * nb + (r & 3) + 8 * (r >> 2)) * 72] = f2bfh(acc[nb][tb][r]);
            } }
        if (part == 1) { asm volatile("s_waitcnt lgkmcnt(0)" ::: "memory");
            const LAS bf16_t* vt_ = (const LAS bf16_t*)(sm + 65536 + wv * 9216);
#pragma unroll
            for (int it = 0; it < 8; ++it) { const int row = 8 * it + (lane >> 3), ch = lane & 7;
                *(u32x4*)(Vt + ((size_t)(b_ * 8 + h) * 64 + row) * SEQ + ts0 + 8 * ch) = *(const LAS u32x4*)(vt_ + row * 72 + 8 * ch); } }
    }
}
constexpr size_t OW_WS = OW_YEND, OW_ZEND = OW_WS + (size_t)8 * 128 * 128;
static_assert(OW_ZEND * 2 <= 52 * MiB, "weights fit");
constexpr int SVP = 136;
__device__ __forceinline__ void conv_sgu(const LayerW& w, bf16_t* W, int gtid, int NT) {
    for (int i = gtid; i < 8 * 128 * 128; i += NT) { const int t = (i >> 7) & 127, s = i & 127; W[OW_WS + i] = (bf16_t)(s <= t ? f2bf(w.sgws()[i]) : 0u); }
}
__device__ __forceinline__ void sg_mix_mfma(const LayerW& w, const bf16_t* PS, bf16_t* YB, const float* SGQ, const bf16_t* Wb, int c, int g, LAS unsigned char* sm) {
    const int tid = tid_opaque(), lane = tid & 63, wv = __builtin_amdgcn_readfirstlane(tid >> 6), r32 = lane & 31, hi = lane >> 5;
    LAS bf16_t* vnT = (LAS bf16_t*)sm;
    __syncthreads();
    { const float gn = w.sgvn()[g * 64 + lane];
#pragma unroll
      for (int q = 0; q < 2; ++q) { unsigned pv[8];
#pragma unroll
          for (int j = 0; j < 8; ++j) { const int t = c * 128 + 16 * wv + 8 * q + j;
              const f32x4 q0 = *(const f32x4*)(SGQ + (size_t)t * 8), q1 = *(const f32x4*)(SGQ + (size_t)t * 8 + 4);
              const float rs = __builtin_amdgcn_rsqf((((q0[0] + q0[1]) + (q0[2] + q0[3])) + ((q1[0] + q1[1]) + (q1[2] + q1[3]))) * (1.f / 512.f) + EPS);
              pv[j] = (unsigned)f2bfh(bf2f(PS[(size_t)t * 1024 + 512 + g * 64 + lane]) * rs * gn); }
          u32x4 o; o.x = pv[0] | (pv[1] << 16); o.y = pv[2] | (pv[3] << 16); o.z = pv[4] | (pv[5] << 16); o.w = pv[6] | (pv[7] << 16);
          *(LAS u32x4*)(vnT + lane * SVP + 16 * wv + 8 * q) = o; } }
    __syncthreads();
    const int rb = wv >> 1, cb = wv & 1;
    f32x16 acc = zero16();
    const bf16_t* ap_ = Wb + OW_WS + (size_t)g * 16384 + (size_t)(32 * rb + r32) * 128 + 8 * hi; const LAS bf16_t* bp = vnT + (32 * cb + r32) * SVP + 8 * hi;
    { bf16x8 wa[8], vb[8];
      const int nks = 2 * (rb + 1);
#pragma unroll
      for (int ks = 0; ks < 8; ++ks) if (ks < nks) { wa[ks] = *(const bf16x8*)(ap_ + 16 * ks); vb[ks] = *(const LAS bf16x8*)(bp + 16 * ks); }
      __builtin_amdgcn_sched_barrier(0);
#pragma unroll
      for (int ks = 0; ks < 8; ++ks) if (ks < nks) acc = __builtin_amdgcn_mfma_f32_32x32x16_bf16(wa[ks], vb[ks], acc, 0, 0, 0); }
    const int cc = g * 64 + 32 * cb + r32;
    { float uv[16], bs[16];
#pragma unroll
      for (int r = 0; r < 16; ++r) { const int tl = 32 * rb + 4 * hi + (r & 3) + 8 * (r >> 2); const size_t t = (size_t)(c * 128 + tl); uv[r] = bf2f(PS[t * 1024 + cc]); bs[r] = w.sgbs()[g * 128 + tl]; }
      __builtin_amdgcn_sched_barrier(0);
#pragma unroll
      for (int r = 0; r < 16; ++r) { const int tl = 32 * rb + 4 * hi + (r & 3) + 8 * (r >> 2); const size_t t = (size_t)(c * 128 + tl);
          YB[t * 512 + cc] = f2bfh(uv[r] * (acc[r] + bs[r])); } }
}
constexpr int LDS_BYTES = 151552;
constexpr int PH_PER_LAYER = 14, N_PHASES = DEPTH * PH_PER_LAYER;

struct MergeSched {
    int pm, pn; const char* ws;
    __device__ __forceinline__ bool next(int i, pg8::MUnit& u) const { if (pm < 0 || i >= 6) return false; u.pm = pm; u.pn = pn; u.kind = i; return true; }
    __device__ __forceinline__ pg8::MDesc desc(int kind) const { const int i = kind >> 1, br = kind & 1;
        const size_t ya = WS_A + (i == 1 ? WS_B - WS_A : 0) + (i == 2 ? WS_D - WS_A : 0);
        const size_t ao = br ? ya : WS_HHI, bo = br ? WS_W + (OW_WOUT + (size_t)i * 512) * 2 : WS_W + (OW_WIN + (size_t)(NPC + i * DM) * DM) * 2;
        pg8::MDesc d; d.A = (const bf16_t*)(ws + ao); d.Bt = (const bf16_t*)(ws + bo);
        d.lda = br ? (i == 1 ? 1024 : 512) : DM; d.ldb = br ? 1536 : DM; d.nt = br ? 8 : 16; return d; }
    __device__ __forceinline__ void a_ready(const pg8::MUnit&) const {}
    __device__ __forceinline__ void done(const pg8::MUnit&) const {}
};
struct EpiMergeM {
    static constexpr bool PERM = true;
    bf16_t* S; bf16_t* M; const float* ssq;
    __device__ __forceinline__ void operator()(const f32x4 (&acc)[2][2][4][2], const pg8::MUnit& u, int wr, int wc, int fr, int fq) const {
        Unit uu; uu.pm = u.pm; uu.pn = u.pn;
        if (!(u.kind & 1)) { EpiGateS e{S, ssq}; e(acc, uu, wr, wc, fr, fq); }
        else { EpiMerge2 e{S, M, u.kind == 1}; e(acc, uu, wr, wc, fr, fq); }
    }
};


constexpr int YOFF1 = (int)((WS_D - WS_A) / (256 * 512 * 2)), YOFF2 = (int)((WS_B - WS_A) / (256 * 512 * 2));
static_assert((WS_D - WS_A) % (256 * 512 * 2) == 0 && (WS_B - WS_A) % (256 * 512 * 2) == 0, "branch bases are whole row tiles apart");
struct MergeOrder {
    pg8::StaticOrder so; bool has; pg8::Unit u0;
    __device__ __forceinline__ void init(int G, int c) { so.init(T, DM, G, c); has = so.next(0, u0); }
    __device__ __forceinline__ bool next(int j, pg8::Unit& u) const { if (!has || j >= 3) return false; const int i = j == 0 ? 2 : j - 1;
        u.pm = u0.pm + (i == 1 ? YOFF1 : 0) + (i == 2 ? YOFF2 : 0); u.pn = u0.pn + 4 * i; return true; }
    __device__ __forceinline__ void a_ready(const pg8::Unit&) const {}
    __device__ __forceinline__ void done(const pg8::Unit&) const {}
};
struct EpiMerge3 {
    static constexpr bool PERM = true;
    const bf16_t* G0; const bf16_t* G1; bf16_t* M;
    __device__ __forceinline__ void prefetch(const pg8::Unit&, int, int, int, int, f32x4 (&)[2]) const {}
    __device__ __forceinline__ void operator()(const f32x4 (&acc)[2][2][4][2], const pg8::Unit& u, int wr, int wc, int fr, int fq, const f32x4 (&)[2]) const {
        __builtin_amdgcn_fence(__ATOMIC_ACQUIRE, "agent");
        const int i = u.pn >> 2, pm = u.pm - (i == 1 ? YOFF1 : 0) - (i == 2 ? YOFF2 : 0);
        const long long d1 = (const char*)G1 - (const char*)G0, d2 = (const char*)M - (const char*)G0;
        const bf16_t* S = (const bf16_t*)((const char*)G0 + (i == 1 ? d1 : 0ll) + (i == 2 ? d2 : 0ll));
        const int row0 = pm * 256 + wr * 64 + fr, col0 = (u.pn & 3) * 256 + wc * 32 + 8 * fq;
#pragma unroll
        for (int aq = 0; aq < 4; ++aq) { const int ai = aq >> 1, m0 = 2 * (aq & 1);
            u32x4 gw[4][2], mw[4][2];
#pragma unroll
            for (int m = m0; m < m0 + 2; ++m)
#pragma unroll
                for (int bj = 0; bj < 2; ++bj) { const size_t off = (size_t)(row0 + ai * 128 + m * 16) * DM + col0 + bj * 128; gw[m][bj] = *(const u32x4*)(S + off); mw[m][bj] = (i != 2) ? *(const u32x4*)(M + off) : (u32x4){0u, 0u, 0u, 0u}; }
            __builtin_amdgcn_sched_barrier(0);
#pragma unroll
            for (int m = m0; m < m0 + 2; ++m) {
                const int row = row0 + ai * 128 + m * 16;
#pragma unroll
                for (int bj = 0; bj < 2; ++bj) {
                    const size_t off = (size_t)row * DM + col0 + bj * 128;
                    const u32x4 g_ = gw[m][bj], m_ = mw[m][bj];
                    float o[8];
                    o[0] = bflo(g_.x) * acc[ai][bj][m][0][0]; o[1] = bfhi(g_.x) * acc[ai][bj][m][0][1]; o[2] = bflo(g_.y) * acc[ai][bj][m][0][2]; o[3] = bfhi(g_.y) * acc[ai][bj][m][0][3];
                    o[4] = bflo(g_.z) * acc[ai][bj][m][1][0]; o[5] = bfhi(g_.z) * acc[ai][bj][m][1][1]; o[6] = bflo(g_.w) * acc[ai][bj][m][1][2]; o[7] = bfhi(g_.w) * acc[ai][bj][m][1][3];
                    o[0] += bflo(m_.x); o[1] += bfhi(m_.x); o[2] += bflo(m_.y); o[3] += bfhi(m_.y); o[4] += bflo(m_.z); o[5] += bfhi(m_.z); o[6] += bflo(m_.w); o[7] += bfhi(m_.w);
                    u32x4 w; w.x = cvt_pk_bf16(o[0], o[1]); w.y = cvt_pk_bf16(o[2], o[3]); w.z = cvt_pk_bf16(o[4], o[5]); w.w = cvt_pk_bf16(o[6], o[7]);
                    *(u32x4*)(M + off) = w;
                }
            }
        }
    }
};

#define WSP(T_, off) ((T_*)(ap->ws + (off)))
#define DOP(T_, off) ((T_*)((unsigned char*)ap->out + (off)))
__device__ __forceinline__ RwBufs rw_bufs(CArgs* ap) { RwBufs b; b.PCORR = DOP(bf16_t, DO_PCORR); b.HL = DOP(bf16_t, DO_HL); b.GC = WSP(float, WS_MISC + 512 * 1024); b.GX = DOP(bf16_t, DO_GX); return b; }
__device__ __forceinline__ void phase0_body(CArgs* ap, int L, unsigned char* lds_g) {
    LAS float* smf = (LAS float*)lds_g;
    const int tid = tid_opaque(), lane = tid & 63, wave = __builtin_amdgcn_readfirstlane(tid >> 6);
    int G = gridDim.x, bid = blockIdx.x; asm volatile("" : "+s"(G), "+s"(bid));
    const int gw = bid * 8 + wave, NGW = G * 8;
    {
        const LayerW w{ap, L};
        const int gt = bid * 512 + tid, gtr = (G - 1 - bid) * 512 + tid; const bool fastp = (G == 256);
        float s_w2 = 0.f, s_a2 = 0.f, s_g2 = 0.f, s_v2 = 0.f, s_sg = 0.f, s_mv[8];
#pragma unroll
        for (int j = 0; j < 8; ++j) s_mv[j] = 0.f;
        if (fastp) {
            if (gt < 512 * 64) { const int n = gt >> 6, k = gt & 63; s_w2 = w.w2()[k * 512 + n]; s_a2 = w.a2()[k * 512 + n]; }
            if (gt < 512 * 128) { const int n = gt >> 7, k = gt & 127; s_g2 = w.g2()[k * 512 + n]; }
            if (L > 0 && gt < 512 * 32) { const int n = gt >> 5, q = gt & 31; s_v2 = w.v2()[q * 512 + n]; }
            s_sg = w.sgws()[gt];
            if (gtr < 24576) { const int ln = gtr & 63, ks = (gtr >> 6) & 15, hn = gtr >> 10; const int h = hn / 3, nb = hn - 3 * h; const int n = h * 96 + 32 * nb + (ln & 31), k0 = 16 * ks + 8 * (ln >> 5);
#pragma unroll
                for (int j = 0; j < 8; ++j) s_mv[j] = w.wuq()[(size_t)(k0 + j) * 768 + n] * w.qan()[k0 + j]; }
            else if (gtr < 24576 + 16384) { const int r = gtr - 24576; const int ln = r & 63, ks = (r >> 6) & 7, q = r >> 9; const int nb = q & 1, part = (q >> 1) & 1, h = q >> 2; const int n = h * 128 + 64 * part + 32 * nb + (ln & 31), k0 = 16 * ks + 8 * (ln >> 5);
#pragma unroll
                for (int j = 0; j < 8; ++j) s_mv[j] = w.wukv()[(size_t)(k0 + j) * 1024 + n] * w.kvan()[k0 + j]; }
        }
        conv_weights_wg(w, WSP(bf16_t, WS_W), smf, bid, G, tid);
        __syncthreads();
        conv_win_block3(w, WSP(bf16_t, WS_W), smf + wave * 2112, NGW - 1 - gw, NGW, lane);
        if (fastp) { bf16_t* W = WSP(bf16_t, WS_W);
            if (gt < 512 * 64) { W[OW_W2T + gt] = (bf16_t)f2bf(s_w2); W[OW_A2T + gt] = (bf16_t)f2bf(s_a2); }
            if (gt < 512 * 128) W[OW_G2T + gt] = (bf16_t)f2bf(s_g2);
            if (L > 0 && gt < 512 * 32) W[OW_XEND_RW + gt] = (bf16_t)f2bf(s_v2);
            { const int t = (gt >> 7) & 127, sx = gt & 127; W[OW_WS + gt] = (bf16_t)(sx <= t ? f2bf(s_sg) : 0u); }
            if (gtr < 24576 + 16384) { u32x4 o; o.x = pk2h(s_mv[0], s_mv[1]); o.y = pk2h(s_mv[2], s_mv[3]); o.z = pk2h(s_mv[4], s_mv[5]); o.w = pk2h(s_mv[6], s_mv[7]);
                *(u32x4*)(W + (gtr < 24576 ? OW_WUQ + (size_t)gtr * 8 : OW_WUKV + (size_t)(gtr - 24576) * 8)) = o; }
        } else {
            { int nt_ = G * 512; asm volatile("" : "+s"(nt_)); conv_small(w, WSP(bf16_t, WS_W), bid * 512 + tid, nt_); }
            conv_mla(w, WSP(bf16_t, WS_W), (G - 1 - bid) * 512 + tid, G * 512);
            conv_sgu(w, WSP(bf16_t, WS_W), bid * 512 + tid, G * 512);
        }
        if (L > 0) conv_t1(w, WSP(bf16_t, WS_W), bid * 512 + tid, G * 512);
        if (L == 0) { init_rows((const float*)ap->in[0], WSP(bf16_t, WS_HHI), WSP(bf16_t, WS_HLO), WSP(float, WS_SSQ), gw, NGW, lane);
                      init_rope((const int*)ap->in[1], WSP(float, WS_ROPE), WSP(float, WS_ROPE) + (size_t)T * 16, bid * 512 + tid, G * 512); }
    }
}
__device__ __forceinline__ void run_phase(CArgs* ap, int ph, unsigned char* lds_g) {
    LAS unsigned char* lds = (LAS unsigned char*)lds_g; LAS float* smf = (LAS float*)lds_g;
    const int tid = tid_opaque(), lane = tid & 63, wave = __builtin_amdgcn_readfirstlane(tid >> 6);
    int G = gridDim.x, bid = blockIdx.x; asm volatile("" : "+s"(G), "+s"(bid));
    const int gw = bid * 8 + wave, NGW = G * 8;
    const int L = ph / PH_PER_LAYER, s = ph % PH_PER_LAYER;
    pg8::StaticOrder S;
    if (s == 0) {
        phase0_body(ap, L, lds_g);
    } else if (s == 1 || s == 12) {
        pg8::Gemm g{WSP(bf16_t, WS_HHI), WSP(bf16_t, WS_W) + (s == 1 ? OW_W1GU1 : OW_W1GU2), DM, DM, T, 2 * FF, DM}; S.init(T, 2 * FF, G, bid);
        EpiUp E{WSP(bf16_t, WS_ACT), WSP(float, WS_SSQ)};
        if (G == 256) {
            S.imax = 5; pg8::gemm_phase<EpiUp, pg8::StaticOrder, true, true>(lds, g, S, E);
            __syncthreads();
            S.init(T, 2 * FF, G, bid >> 1); pg8::Unit uh; const bool hh = S.next(5, uh); pg8::gemm_half<EpiUp>(lds, g, uh.pm, bid & 1, uh.pn, hh, E);
        } else pg8::gemm_phase<EpiUp, pg8::StaticOrder, true, true>(lds, g, S, E);
    } else if (s == 2 || s == 13) {
        const bool merged = (s == 13 && L + 1 < DEPTH); const bool convfirst = false;
#pragma nounroll
        for (int part = 0; part < 2; ++part) {
            if (merged && ((part == 0) == convfirst)) { phase0_body(ap, L + 1, lds_g); __syncthreads(); }
            else if ((part == 0) != convfirst) {
                pg8::Gemm g{WSP(bf16_t, WS_ACT), WSP(bf16_t, WS_W) + (s == 2 ? OW_W2_1 : ow_w2_2(L)), FF, FF, T, DM, FF}; S.init(T, DM, G, bid);
                EpiRes E{WSP(bf16_t, WS_HHI), WSP(bf16_t, WS_HLO), WSP(float, WS_SSQ), 0.5f, (s == 13 && L == DEPTH - 1) ? ap->out : nullptr}; pg8::gemm_phase<EpiRes, pg8::StaticOrder, true, true>(lds, g, S, E);
                __syncthreads(); }
        }
    } else if (s == 3) {
        pg8::Gemm g{WSP(bf16_t, WS_HHI), WSP(bf16_t, WS_W) + OW_WIN, DM, DM, T, NPC, DM}; S.init(T, NPC, G, bid);
        EpiWin E{WSP(bf16_t, WS_A), WSP(bf16_t, WS_B), WSP(bf16_t, WS_C), WSP(float, WS_MISC), WSP(float, WS_SSQ)}; if (G == 256) {
            S.imax = 3; pg8::gemm_phase<EpiWin, pg8::StaticOrder, true, true>(lds, g, S, E);
            __syncthreads();
            S.init(T, NPC, G, bid >> 1); pg8::Unit uh; const bool hh = S.next(3, uh); pg8::gemm_half<EpiWin>(lds, g, uh.pm, bid & 1, uh.pn, hh, E);
        } else pg8::gemm_phase<EpiWin, pg8::StaticOrder, true, true>(lds, g, S, E);
    } else if (s == 4) {
        const LayerW w{ap, L};
        for (int u = bid; u < T / 64; u += G) mla_unit_mfma(w, L, WSP(bf16_t, WS_A), WSP(bf16_t, WS_W), WSP(float, WS_ROPE), WSP(float, WS_ROPE) + (size_t)T * 16, DOP(bf16_t, DO_Q), DOP(bf16_t, DO_K), DOP(bf16_t, DO_VT), WSP(float, WS_T1), u * 64, lds);
    } else if (s == 5) {
#ifdef PROBE_DUP_ATTN
        for (int rep = 0; rep < 2; ++rep)
#endif
        int ub = bid; asm volatile("" : "+s"(ub));
        for (int u = ub; u < 256; u += G) { const int bh = u >> 3, sx = u & 7;
            attn_unit(DOP(bf16_t, DO_Q), DOP(bf16_t, DO_K), DOP(bf16_t, DO_VT), WSP(bf16_t, WS_A), 512, (bh >> 3) * SEQ, bh, bh & 7, 15 - sx, lds);
            attn_unit(DOP(bf16_t, DO_Q), DOP(bf16_t, DO_K), DOP(bf16_t, DO_VT), WSP(bf16_t, WS_A), 512, (bh >> 3) * SEQ, bh, bh & 7, sx, lds); }
#ifdef PROBE_ATTN_SHADOW
        for (int u = bid; u < 256; u += G) { const int bh = u >> 3, sx = u & 7;
            attn_unit<PROBE_ATTN_SHADOW>(DOP(bf16_t, DO_Q), DOP(bf16_t, DO_K), DOP(bf16_t, DO_VT), WSP(bf16_t, WS_D), 512, (bh >> 3) * SEQ, bh, bh & 7, 15 - sx, lds);
            attn_unit<PROBE_ATTN_SHADOW>(DOP(bf16_t, DO_Q), DOP(bf16_t, DO_K), DOP(bf16_t, DO_VT), WSP(bf16_t, WS_D), 512, (bh >> 3) * SEQ, bh, bh & 7, sx, lds); }
#endif
    } else if (s == 6 || s == 8) {
        const LayerW w{ap, L}; const RwBufs rbuf = rw_bufs(ap);
        if (s == 6) { u32x4 cq[7], pq[7];
            rw_load_rows(WSP(bf16_t, WS_C), ((bid & 31) >> 3) * SEQ, bid & 7, (bid >> 5) & (RW_NC - 1), cq, pq);
            for (int u = bid; u < 2048; u += G) { const int bh = u & 31, c = u >> 5; const int cn = u + G < 2048 ? c + (G >> 5) : -1;
                rw_chunk_unit<0>(w, L, WSP(bf16_t, WS_C), WSP(bf16_t, WS_W), WSP(bf16_t, WS_VF), WSP(float, WS_T1), rbuf, nullptr, 0, (bh >> 3) * SEQ, bh, bh & 7, c, lds, cn, u == bid, cq, pq); } }
        else rw_passb_phase(w, WSP(bf16_t, WS_C), rbuf, WSP(bf16_t, WS_B), 512, bid, G, lds);
    } else if (s == 7) {
        const RwBufs rbuf = rw_bufs(ap);
        if (wave == 0 && bid < 64) rw_seq_wave(rbuf, bid >> 1, bid & 1, lane, smf);
        if (bid >= 64) { const LayerW w{ap, L};
            for (int u = bid - 64; u < 1024; u += G - 64) sg_mix_mfma(w, WSP(bf16_t, WS_B), WSP(bf16_t, WS_D), WSP(float, WS_MISC), WSP(bf16_t, WS_W), u >> 3, u & 7, lds); }
    } else if (s == 9) {
        pg8::Gemm g{WSP(bf16_t, WS_HHI), WSP(bf16_t, WS_W) + OW_WIN + (size_t)NPC * DM, DM, DM, T, NGC, DM}; S.init(T, NGC, G, bid);
        EpiGate3 E{DOP(bf16_t, DO_S), DOP(bf16_t, DO_M), WSP(bf16_t, WS_C), WSP(float, WS_SSQ)}; pg8::gemm_phase<EpiGate3, pg8::StaticOrder, true, true>(lds, g, S, E);
    } else if (s == 10) {
        MergeOrder MO; MO.init(G, bid);
        pg8::Gemm g{WSP(bf16_t, WS_A), WSP(bf16_t, WS_W) + OW_WOUT, 512, 512, T, DM, 512};
        EpiMerge3 E{DOP(bf16_t, DO_S), DOP(bf16_t, DO_M), WSP(bf16_t, WS_C)}; pg8::gemm_phase<EpiMerge3, MergeOrder, true, true>(lds, g, MO, E);
    } else if (s == 11) {
        pg8::Gemm g{WSP(bf16_t, WS_C), WSP(bf16_t, WS_W) + OW_WO, DM, DM, T, DM, DM}; S.init(T, DM, G, bid);
        EpiRes E{WSP(bf16_t, WS_HHI), WSP(bf16_t, WS_HLO), WSP(float, WS_SSQ), 1.0f, nullptr}; pg8::gemm_phase<EpiRes, pg8::StaticOrder, true, true>(lds, g, S, E);
    }
}


#define XB_TMO      128
#define XB_XCNT(j)  (256  + 64 * (j))
#define XB_XSUB(j)  (1280 + 64 * (j))
#define XB_XGEN(j)  (2304 + 64 * (j))
#define XB_TOP      3328
#define XB_TOPGEN   3392
#define XCD_BAR_WORDS 3456
#define XB_SPIN_CAP (1u << 18)
constexpr size_t WS_CTL = WS_W + 52 * MiB - 16384;
static_assert(OW_ZEND * 2 <= 52 * MiB - 16384, "barrier words fit behind the weights");
__device__ __forceinline__ unsigned xb_ld(unsigned* p)              { return __hip_atomic_load(p, __ATOMIC_RELAXED, __HIP_MEMORY_SCOPE_AGENT); }
__device__ __forceinline__ unsigned xb_add(unsigned* p, unsigned v) { return __hip_atomic_fetch_add(p, v, __ATOMIC_RELAXED, __HIP_MEMORY_SCOPE_AGENT); }
__device__ __forceinline__ unsigned xb_xcc_id() { return (unsigned)__builtin_amdgcn_s_getreg((3 << 11) | 20) & 0xFu; }
#define XB_SPIN(cond, bar) do { unsigned _sp = 0; while (cond) { __builtin_amdgcn_s_sleep(1); \
    if ((++_sp & 255u) == 0u) { if (xb_ld(&(bar)[XB_TMO])) break; if (_sp > XB_SPIN_CAP) { atomicAdd(&(bar)[XB_TMO], 1u); break; } } } } while (0)
struct XcdBarrier { unsigned* bar; unsigned x; volatile LAS unsigned* st; };
__device__ __forceinline__ XcdBarrier xcd_barrier_post(unsigned* bar, volatile LAS unsigned* st) {
    XcdBarrier b; b.bar = bar; b.x = xb_xcc_id(); b.st = st;
    if (threadIdx.x == 0) (void)xb_add(&bar[XB_XCNT(b.x)], 1u);
    return b;
}
__device__ __forceinline__ void xcd_barrier_complete(unsigned* bar, unsigned x, unsigned& nloc, unsigned& nx) {
    const unsigned G = gridDim.x * gridDim.y * gridDim.z;
    unsigned sum, cnt, mine, sp = 0u;
    for (;;) {
        sum = 0u; cnt = 0u; mine = 0u;
        unsigned cv[16];
#pragma unroll
        for (unsigned j = 0; j < 16; ++j) cv[j] = xb_ld(&bar[XB_XCNT(j)]);
        __builtin_amdgcn_sched_barrier(0);
#pragma unroll
        for (unsigned j = 0; j < 16; ++j) { const unsigned c = cv[j]; sum += c; cnt += (c > 0u) ? 1u : 0u; mine = (j == x) ? c : mine; }
        if (sum == G) break;
        __builtin_amdgcn_s_sleep(1);
        if ((++sp & 255u) == 0u) { if (xb_ld(&bar[XB_TMO])) break; if (sp > XB_SPIN_CAP) { atomicAdd(&bar[XB_TMO], 1u); break; } }
    }
    nloc = mine > 0u ? mine : 1u; nx = cnt > 0u ? cnt : 1u;
}
__device__ __forceinline__ void xcd_barrier(const XcdBarrier& b) {
    asm volatile("s_waitcnt vmcnt(0)" ::: "memory");
    __syncthreads();
    if (threadIdx.x == 0) {
        unsigned* bar = b.bar; asm volatile("" : "+s"(bar)); unsigned bx = b.x; asm volatile("" : "+s"(bx));
        __builtin_amdgcn_s_waitcnt(0);
        unsigned nloc = b.st[0], nx = b.st[1];
        if (nloc == 0u) { xcd_barrier_complete(bar, bx, nloc, nx); b.st[0] = nloc; b.st[1] = nx; }
        const unsigned old = xb_add(&bar[XB_XSUB(bx)], 1u);
        const unsigned gen = old / nloc;
        if (old + 1u == (gen + 1u) * nloc) {
            __builtin_amdgcn_fence(__ATOMIC_RELEASE, "agent");
            asm volatile("s_waitcnt vmcnt(0)" ::: "memory");
            const unsigned og = xb_add(&bar[XB_TOP], 1u);
            const unsigned tg = og / nx;
            if (og + 1u == (tg + 1u) * nx) xb_add(&bar[XB_TOPGEN], 1u);
            else XB_SPIN(xb_ld(&bar[XB_TOPGEN]) == tg, bar);
            __builtin_amdgcn_fence(__ATOMIC_ACQUIRE, "agent");
            xb_add(&bar[XB_XGEN(bx)], 1u);
            asm volatile("s_waitcnt vmcnt(0)" ::: "memory");
        } else {
            XB_SPIN(xb_ld(&bar[XB_XGEN(bx)]) == gen, bar);
            __builtin_amdgcn_fence(__ATOMIC_ACQUIRE, "agent");
            asm volatile("s_waitcnt vmcnt(0)" ::: "memory");
        }
    }
    __syncthreads();
}

__global__ void __launch_bounds__(512, 2) mk_fwd(Args a) {
    extern __shared__ __attribute__((aligned(16))) unsigned char lds[];
    cg::grid_group grid = cg::this_grid();
    CArgs* ap0 = (CArgs*)__builtin_amdgcn_kernarg_segment_ptr();
    const int ph_lo = ap0->ph_lo, ph_hi = ap0->ph_hi;
    volatile LAS unsigned* bst = (volatile LAS unsigned*)((LAS unsigned char*)lds + LDS_BYTES - 16);
    if (threadIdx.x < 4) bst[threadIdx.x] = 0u;
    __syncthreads();
    const XcdBarrier xbar = xcd_barrier_post((unsigned*)(ap0->ws + WS_CTL), bst);
    grid.sync();
    for (int ph = ph_lo; ph < ph_hi; ++ph) {
        if (ph > 0 && ph % PH_PER_LAYER == 0) continue;
        CArgs* ap = ap0; asm volatile("" : "+s"(ap));
        run_phase(ap, ph, lds);
#ifdef PROBE_DUP_MASK
        if ((PROBE_DUP_MASK >> (ph % PH_PER_LAYER)) & 1) { xcd_barrier(xbar); CArgs* ap2 = ap0; asm volatile("" : "+s"(ap2)); run_phase(ap2, ph, lds); }
#endif
        if (ph + 1 < ph_hi) xcd_barrier(xbar);
#ifdef PROBE_EXTRA_SYNC
        if (ph < PROBE_EXTRA_SYNC) { xcd_barrier(xbar); xcd_barrier(xbar); }
#endif
    }
}

#ifndef MK_ONE_LAUNCH
#define MK_ONE_LAUNCH 1
#endif
extern "C" void kernel_launch(void* const* d_in, const int* in_sizes, int n_in, void* d_out, int out_size, void* d_ws, size_t ws_size, hipStream_t stream) {
    static int grid = 0;
    if (grid == 0) {
        if (n_in != 39 || out_size != T * DM || ws_size < WS_END) { fprintf(stderr, "kernel_launch: unexpected shapes (n_in %d out %d ws %zu)\n", n_in, out_size, ws_size); grid = -1; return; }
        int dev = 0, cus = 0, per_cu = 0;
        hipGetDevice(&dev); hipDeviceGetAttribute(&cus, hipDeviceAttributeMultiprocessorCount, dev);
        hipFuncSetAttribute((const void*)mk_fwd, hipFuncAttributeMaxDynamicSharedMemorySize, LDS_BYTES);
        hipOccupancyMaxActiveBlocksPerMultiprocessor(&per_cu, (const void*)mk_fwd, 512, LDS_BYTES);
        if (per_cu < 1) { fprintf(stderr, "kernel_launch: occupancy query says %d blocks per CU\n", per_cu); per_cu = 1; }
        (void)hipGetLastError();
        grid = cus * 1;
    }
    if (grid < 0) return;
    Args a{};
    for (int i = 0; i < 39; ++i) a.in[i] = d_in[i];
    a.out = (float*)d_out; a.ws = (unsigned char*)d_ws;
#if MK_ONE_LAUNCH
    hipMemsetAsync((unsigned char*)d_ws + WS_CTL, 0, 16384, stream);
    a.ph_lo = 0; a.ph_hi = N_PHASES;
    void* args[] = {&a};
    hipError_t e = hipLaunchCooperativeKernel((const void*)mk_fwd, dim3(grid), dim3(512), args, LDS_BYTES, stream);
    if (e != hipSuccess) fprintf(stderr, "cooperative launch failed: %s (grid %d)\n", hipGetErrorString(e), grid);
#else
    for (int ph = 0; ph < N_PHASES; ++ph) { a.ph_lo = ph; a.ph_hi = ph + 1; hipLaunchKernelGGL(mk_fwd, dim3(grid), dim3(512), LDS_BYTES, stream, a); }
#endif
}
```
